# Optimizing an MI355X kernel written in HIP

```python
import jax, jax.numpy as jnp
from jax import lax
import numpy as np

D_MODEL = 1024
BATCH = 4
SEQ = 8192
DEPTH = 1

ATT_HEADS = 16
ATT_KV_HEADS = 4
ATT_HEAD_DIM = 64
ATT_WINDOW = 128
ATT_BLOCK = 128
ROPE_THETA = 10000.0
MLSTM_HEADS = 4
MLSTM_V_DIM = D_MODEL // MLSTM_HEADS
MLSTM_QK_DIM = MLSTM_V_DIM // 2
MLSTM_CHUNK = 128
MLSTM_CONV = 4
D_FF = 2816
RMS_EPS = 1e-5

ATT_Q_W = ATT_HEADS * ATT_HEAD_DIM
ATT_KV_W = ATT_KV_HEADS * ATT_HEAD_DIM
ML_QK_W = MLSTM_HEADS * MLSTM_QK_DIM
ML_V_W = MLSTM_HEADS * MLSTM_V_DIM
SPLITS = (ATT_Q_W, ATT_KV_W, ATT_KV_W, ML_QK_W, ML_QK_W, ML_V_W, ML_V_W,
          MLSTM_HEADS, MLSTM_HEADS, D_MODEL, D_MODEL)
IN_PROJ_W = sum(SPLITS)

kernel_name = "hybrid_swa_sink_mlstm_macaron"


def rms_norm(x, g):
    xf = x.astype(jnp.float32)
    y = xf * lax.rsqrt(jnp.mean(xf * xf, axis=-1, keepdims=True) + RMS_EPS)
    return (y * g.astype(jnp.float32)).astype(x.dtype)


def swiglu(h, w_gate, w_up, w_down):
    return (jax.nn.silu(h @ w_gate) * (h @ w_up)) @ w_down


def rope(x):
    half = x.shape[-1] // 2
    pos = jnp.arange(x.shape[1], dtype=jnp.float32)
    inv_freq = ROPE_THETA ** (-jnp.arange(half, dtype=jnp.float32) / half)
    ang = pos[:, None] * inv_freq[None, :]
    cos = jnp.cos(ang)[None, :, None, :]
    sin = jnp.sin(ang)[None, :, None, :]
    xf = x.astype(jnp.float32)
    x1, x2 = xf[..., :half], xf[..., half:]
    return jnp.concatenate([x1 * cos - x2 * sin, x2 * cos + x1 * sin], axis=-1).astype(x.dtype)


def sliding_window_attention(q, k, v, sinks):
    B, S = q.shape[0], q.shape[1]
    nb = S // ATT_BLOCK
    G = ATT_HEADS // ATT_KV_HEADS
    qb = q.reshape(B, nb, ATT_BLOCK, ATT_KV_HEADS, G, ATT_HEAD_DIM)

    def with_prev(t):
        tb = t.reshape(B, nb, ATT_BLOCK, ATT_KV_HEADS, ATT_HEAD_DIM)
        prev = jnp.pad(tb[:, :-1], ((0, 0), (1, 0), (0, 0), (0, 0), (0, 0)))
        return jnp.concatenate([prev, tb], axis=2)

    kb, vb = with_prev(k), with_prev(v)
    scores = jnp.einsum('bnqhgd,bnkhd->bnhgqk', qb, kb,
                        preferred_element_type=jnp.float32) * (ATT_HEAD_DIM ** -0.5)
    qi = jnp.arange(ATT_BLOCK)[:, None]
    kj = jnp.arange(2 * ATT_BLOCK)[None, :]
    rel = qi + ATT_BLOCK - kj
    band = (rel >= 0) & (rel < ATT_WINDOW)
    key_pos = jnp.arange(nb)[:, None, None] * ATT_BLOCK + kj[None] - ATT_BLOCK
    mask = band[None] & (key_pos >= 0)
    scores = jnp.where(mask[None, :, None, None], scores, -jnp.inf)
    sink = sinks.astype(jnp.float32).reshape(ATT_KV_HEADS, G)[None, None, :, :, None, None]
    m = jnp.maximum(scores.max(axis=-1, keepdims=True), sink)
    p = jnp.exp(scores - m)
    denom = p.sum(axis=-1, keepdims=True) + jnp.exp(sink - m)
    p = (p / denom).astype(v.dtype)
    out = jnp.einsum('bnhgqk,bnkhd->bnqhgd', p, vb)
    return out.reshape(B, S, ATT_Q_W)


def causal_depthwise_conv(x, w, b):
    K, C = w.shape
    y = lax.conv_general_dilated(x, w[:, None, :].astype(x.dtype), window_strides=(1,),
                                 padding=[(K - 1, 0)],
                                 dimension_numbers=('NWC', 'WIO', 'NWC'),
                                 feature_group_count=C)
    return y + b


def mlstm_chunkwise(q, k, v, i_pre, f_pre):
    B, S, H, Dk = q.shape
    Dv = v.shape[-1]
    L = MLSTM_CHUNK
    nc = S // L
    f32 = jnp.float32

    def chunks(t):
        return jnp.moveaxis(t.astype(f32).reshape(B, nc, L, H, -1), 3, 1)

    qc = chunks(q)
    kc = chunks(k) * (Dk ** -0.5)
    vc = chunks(v)
    ig = jnp.moveaxis(i_pre.astype(f32).reshape(B, nc, L, H), 3, 1)
    logf = jax.nn.log_sigmoid(jnp.moveaxis(f_pre.astype(f32).reshape(B, nc, L, H), 3, 1))
    b = jnp.cumsum(logf, axis=-1)
    b_end = b[..., -1]

    w_end = b_end[..., None] - b + ig
    m_loc = w_end.max(axis=-1)
    a = jnp.exp(w_end - m_loc[..., None])
    dC = jnp.einsum('bhclv,bhcld->bhcvd', a[..., None] * vc, kc)
    dn = jnp.einsum('bhcl,bhcld->bhcd', a, kc)

    def step(carry, inp):
        C, n, m = carry
        dC_c, dn_c, m_loc_c, b_end_c = inp
        m_new = jnp.maximum(b_end_c + m, m_loc_c)
        s_old = jnp.exp(b_end_c + m - m_new)
        s_new = jnp.exp(m_loc_c - m_new)
        C_new = s_old[..., None, None] * C + s_new[..., None, None] * dC_c
        n_new = s_old[..., None] * n + s_new[..., None] * dn_c
        return (C_new, n_new, m_new), (C, n, m)

    init = (jnp.zeros((B, H, Dv, Dk), f32), jnp.zeros((B, H, Dk), f32), jnp.zeros((B, H), f32))
    xs = (jnp.moveaxis(dC, 2, 0), jnp.moveaxis(dn, 2, 0),
          jnp.moveaxis(m_loc, 2, 0), jnp.moveaxis(b_end, 2, 0))
    _, (C_prev, n_prev, m_prev) = lax.scan(step, init, xs)
    C_prev = jnp.moveaxis(C_prev, 0, 2)
    n_prev = jnp.moveaxis(n_prev, 0, 2)
    m_prev = jnp.moveaxis(m_prev, 0, 2)

    causal = jnp.tril(jnp.ones((L, L), dtype=bool))
    log_d = jnp.where(causal, b[..., :, None] - b[..., None, :] + ig[..., None, :], -jnp.inf)
    log_inter = b + m_prev[..., None]
    m_t = jnp.maximum(log_d.max(axis=-1), log_inter)
    s = jnp.einsum('bhcld,bhcsd->bhcls', qc, kc) * jnp.exp(log_d - m_t[..., None])
    inter = jnp.exp(log_inter - m_t)
    num = (jnp.einsum('bhcls,bhcsv->bhclv', s, vc)
           + inter[..., None] * jnp.einsum('bhcld,bhcvd->bhclv', qc, C_prev))
    den = s.sum(axis=-1) + inter * jnp.einsum('bhcld,bhcd->bhcl', qc, n_prev)
    h = num / jnp.maximum(jnp.abs(den), jnp.exp(-m_t))[..., None]
    return jnp.moveaxis(h, 1, 3).reshape(B, S, H * Dv).astype(q.dtype)


def hybrid_mixer(h, w_in, b_i, b_f, attn_sinks, conv_w, conv_b, head_norm,
                 w_att, w_mlstm, w_out):
    B, S, _ = h.shape
    z = h @ w_in
    idx = np.cumsum(SPLITS)[:-1].tolist()
    q_a, k_a, v_a, q_m, k_m, v_m, o_m, i_m, f_m, g_a, g_m = jnp.split(z, idx, axis=-1)

    q_a = rope(q_a.reshape(B, S, ATT_HEADS, ATT_HEAD_DIM))
    k_a = rope(k_a.reshape(B, S, ATT_KV_HEADS, ATT_HEAD_DIM))
    v_a = v_a.reshape(B, S, ATT_KV_HEADS, ATT_HEAD_DIM)
    y_a = sliding_window_attention(q_a, k_a, v_a, attn_sinks) @ w_att

    qk = jax.nn.silu(causal_depthwise_conv(jnp.concatenate([q_m, k_m], axis=-1), conv_w, conv_b))
    q_m, k_m = qk[..., :ML_QK_W], qk[..., ML_QK_W:]
    h_m = mlstm_chunkwise(q_m.reshape(B, S, MLSTM_HEADS, MLSTM_QK_DIM),
                          k_m.reshape(B, S, MLSTM_HEADS, MLSTM_QK_DIM),
                          v_m.reshape(B, S, MLSTM_HEADS, MLSTM_V_DIM),
                          i_m + b_i, f_m + b_f)
    h_m = rms_norm(h_m.reshape(B, S, MLSTM_HEADS, MLSTM_V_DIM),
                   head_norm.reshape(MLSTM_HEADS, MLSTM_V_DIM)).reshape(B, S, ML_V_W)
    y_m = (jax.nn.sigmoid(o_m) * h_m) @ w_mlstm

    y = jax.nn.sigmoid(g_a) * y_a + jax.nn.sigmoid(g_m) * y_m
    return y @ w_out


def setup_inputs(seed: int = 0) -> dict:
    key = jax.random.key(seed)
    ks = jax.random.split(key, 24)
    f32 = jnp.float32

    def nrm(k, shape, scale):
        return jax.random.normal(k, shape, f32) * scale

    def gain(k, shape):
        return 1.0 + 0.02 * jax.random.normal(k, shape, f32)

    L = DEPTH
    return {
        "x": jax.random.normal(ks[0], (BATCH, SEQ, D_MODEL), f32),
        "ffn1_norm": gain(ks[1], (L, D_MODEL)),
        "ffn1_w_gate": nrm(ks[2], (L, D_MODEL, D_FF), D_MODEL ** -0.5),
        "ffn1_w_up": nrm(ks[3], (L, D_MODEL, D_FF), D_MODEL ** -0.5),
        "ffn1_w_down": nrm(ks[4], (L, D_FF, D_MODEL), D_FF ** -0.5),
        "mix_norm": gain(ks[5], (L, D_MODEL)),
        "w_in": nrm(ks[6], (L, D_MODEL, IN_PROJ_W), D_MODEL ** -0.5),
        "b_i": nrm(ks[7], (L, MLSTM_HEADS), 0.1),
        "b_f": jnp.linspace(3.0, 6.0, MLSTM_HEADS, dtype=f32)[None, :] + nrm(ks[8], (L, MLSTM_HEADS), 0.1),
        "attn_sinks": nrm(ks[9], (L, ATT_HEADS), 1.0),
        "conv_w": nrm(ks[10], (L, MLSTM_CONV, 2 * ML_QK_W), MLSTM_CONV ** -0.5),
        "conv_b": nrm(ks[11], (L, 2 * ML_QK_W), 0.01),
        "head_norm": gain(ks[12], (L, ML_V_W)),
        "w_att": nrm(ks[13], (L, ATT_Q_W, D_MODEL), ATT_Q_W ** -0.5),
        "w_mlstm": nrm(ks[14], (L, ML_V_W, D_MODEL), ML_V_W ** -0.5),
        "w_out": nrm(ks[15], (L, D_MODEL, D_MODEL), D_MODEL ** -0.5),
        "ffn2_norm": gain(ks[16], (L, D_MODEL)),
        "ffn2_w_gate": nrm(ks[17], (L, D_MODEL, D_FF), D_MODEL ** -0.5),
        "ffn2_w_up": nrm(ks[18], (L, D_MODEL, D_FF), D_MODEL ** -0.5),
        "ffn2_w_down": nrm(ks[19], (L, D_FF, D_MODEL), D_FF ** -0.5),
        "final_norm": gain(ks[20], (D_MODEL,)),
    }


def reference(x, ffn1_norm, ffn1_w_gate, ffn1_w_up, ffn1_w_down, mix_norm, w_in, b_i, b_f,
              attn_sinks, conv_w, conv_b, head_norm, w_att, w_mlstm, w_out,
              ffn2_norm, ffn2_w_gate, ffn2_w_up, ffn2_w_down, final_norm):
    for l in range(DEPTH):
        x = x + 0.5 * swiglu(rms_norm(x, ffn1_norm[l]), ffn1_w_gate[l], ffn1_w_up[l], ffn1_w_down[l])
        x = x + hybrid_mixer(rms_norm(x, mix_norm[l]), w_in[l], b_i[l], b_f[l], attn_sinks[l],
                             conv_w[l], conv_b[l], head_norm[l], w_att[l], w_mlstm[l], w_out[l])
        x = x + 0.5 * swiglu(rms_norm(x, ffn2_norm[l]), ffn2_w_gate[l], ffn2_w_up[l], ffn2_w_down[l])
    return rms_norm(x, final_norm)
```

```cpp
#include <hip/hip_runtime.h>
#include <hip/hip_cooperative_groups.h>
#include <cstdio>
#include <cstdint>
#include <cmath>
namespace cg = cooperative_groups;

#ifndef MK_PER_PHASE_LAUNCH
#define MK_PER_PHASE_LAUNCH 0
#endif

namespace pg8 {
#define PG8_LAS __attribute__((address_space(3)))
typedef unsigned short bf16_t;
typedef short bf16x8 __attribute__((ext_vector_type(8)));
typedef float f32x4 __attribute__((ext_vector_type(4)));
typedef unsigned u32x4 __attribute__((ext_vector_type(4)));
constexpr int BM = 256, BK = 64, HALF = 128, HTB = HALF * BK * 2, STAGE_BYTES = 8 * HTB, NXCD = 8, WGM = 8;

__host__ __device__ __forceinline__ int lds_byte(int r, int c) { const int st = (r >> 4) * 2 + (c >> 5), rr = r & 15, cc = c & 31, ob = rr * 64 + cc * 2; return st * 1024 + (ob ^ (((ob >> 9) & 1) << 5)); }
__host__ __device__ __forceinline__ void stage_rc(int b, int& R, int& C) { const int st = b / 1024, sb = b % 1024, swz = sb ^ (((sb >> 9) & 1) << 5); R = (st >> 1) * 16 + swz / 64; C = (st & 1) * 32 + (swz % 64) / 2; }
__host__ __device__ __forceinline__ int perm32(int rho) { const int n = rho >> 4, i = rho & 15; return 8 * (i >> 2) + 4 * n + (i & 3); }

struct Unit { int pm, pn, kind; };
struct Gemm { const bf16_t* A0; const bf16_t* A1; const bf16_t* B0; const bf16_t* B1; int lda, K; };

struct StaticOrder {
    int nM, nN, nwg, G, c;
    __host__ __device__ void init(int M, int N, int G_, int c_) { nM = M / BM; nN = N / BM; nwg = nM * nN; G = G_; c = c_; }
    __host__ __device__ bool next(int i, Unit& u) const {
        const long L = (long)i * G + c; if (L >= nwg) return false;
        int wgid = (int)L; { const int q = nwg / NXCD, r = nwg % NXCD, xcd = wgid % NXCD, off = wgid / NXCD; wgid = (xcd < r ? xcd * (q + 1) : r * (q + 1) + (xcd - r) * q) + off; }
        const int nig = WGM * nN, gid = wgid / nig, fm = gid * WGM, gsz = (nM - fm) < WGM ? (nM - fm) : WGM;
        u.pm = fm + ((wgid % nig) % gsz); u.pn = (wgid % nig) / gsz; u.kind = 0; return true;
    }
};
struct PairOrder {
    StaticOrder so;
    __host__ __device__ bool next(int i, Unit& u) const { if (!so.next(i >> 1, u)) return false; u.kind = i & 1; return true; }
};

__device__ __forceinline__ unsigned cvt_pk_bf16(float lo, float hi) { unsigned r; asm volatile("v_cvt_pk_bf16_f32 %0, %1, %2" : "=v"(r) : "v"(lo), "v"(hi)); return r; }
__device__ __forceinline__ float bf_lo(unsigned w) { return __uint_as_float(w << 16); }
__device__ __forceinline__ float bf_hi(unsigned w) { return __uint_as_float(w & 0xffff0000u); }
__device__ __forceinline__ float sigmoid_den(float x) { return 1.0f + __expf(-x); }


struct EpiBf16 {
    bf16_t* O; int ldc;
    __device__ __forceinline__ bool operator()(f32x4 (&acc)[2][2][4][2], const Unit& u, int wr, int wc, int fr, int fq) const {
        const int row0 = u.pm * BM + wr * 64 + fr, col0 = u.pn * BM + wc * 32 + 8 * fq;
#pragma unroll
        for (int ai = 0; ai < 2; ++ai)
#pragma unroll
            for (int m = 0; m < 4; ++m) { bf16_t* rowp = O + (size_t)(row0 + ai * HALF + m * 16) * ldc + col0;
#pragma unroll
                for (int bj = 0; bj < 2; ++bj) { const f32x4 v0 = acc[ai][bj][m][0], v1 = acc[ai][bj][m][1];
                    u32x4 w; w.x = cvt_pk_bf16(v0[0], v0[1]); w.y = cvt_pk_bf16(v0[2], v0[3]); w.z = cvt_pk_bf16(v1[0], v1[1]); w.w = cvt_pk_bf16(v1[2], v1[3]);
                    *(u32x4*)(rowp + bj * HALF) = w; } }
        return true;
    }
};
struct EpiSwiGLU {
    bf16_t* O; int ldc;
    __device__ __forceinline__ bool operator()(f32x4 (&acc)[2][2][4][2], const Unit& u, int wr, int wc, int fr, int fq) const {
        const int row0 = u.pm * BM + wr * 64 + fr, col0 = u.pn * HALF + wc * 32 + 8 * fq;
#pragma unroll
        for (int ai = 0; ai < 2; ++ai)
#pragma unroll
            for (int m = 0; m < 4; ++m) { bf16_t* rowp = O + (size_t)(row0 + ai * HALF + m * 16) * ldc + col0;
                float r[8];
#pragma unroll
                for (int n = 0; n < 2; ++n)
#pragma unroll
                    for (int e = 0; e < 4; ++e) { const float g = acc[ai][0][m][n][e], up = acc[ai][1][m][n][e]; r[4 * n + e] = g * __builtin_amdgcn_rcpf(1.0f + __expf(-g)) * up; }
                u32x4 w; w.x = cvt_pk_bf16(r[0], r[1]); w.y = cvt_pk_bf16(r[2], r[3]); w.z = cvt_pk_bf16(r[4], r[5]); w.w = cvt_pk_bf16(r[6], r[7]);
                *(u32x4*)rowp = w; }
        return true;
    }
};
struct EpiResid {
    const float* base; float* out; int ldc; float alpha;
    __device__ __forceinline__ bool operator()(f32x4 (&acc)[2][2][4][2], const Unit& u, int wr, int wc, int fr, int fq) const {
        const int row0 = u.pm * BM + wr * 64 + fr, col0 = u.pn * BM + wc * 32 + 8 * fq;
#pragma unroll
        for (int ai = 0; ai < 2; ++ai)
#pragma unroll
            for (int m = 0; m < 4; ++m) { const size_t off = (size_t)(row0 + ai * HALF + m * 16) * ldc + col0;
#pragma unroll
                for (int bj = 0; bj < 2; ++bj)
#pragma unroll
                    for (int n = 0; n < 2; ++n) { const f32x4 b = *(const f32x4*)(base + off + bj * HALF + 4 * n); *(f32x4*)(out + off + bj * HALF + 4 * n) = b + acc[ai][bj][m][n] * alpha; } }
        return true;
    }
};
struct EpiMix {
    const bf16_t* Z; bf16_t* Y; int ldz; int cga, cgm;
    __device__ __forceinline__ bool operator()(f32x4 (&acc)[2][2][4][2], const Unit& u, int wr, int wc, int fr, int fq) const {
        const int row0 = u.pm * BM + wr * 64 + fr, col0 = u.pn * BM + wc * 32 + 8 * fq;
#pragma unroll
        for (int ai = 0; ai < 2; ++ai)
#pragma unroll
            for (int m = 0; m < 4; ++m) { const size_t off = (size_t)(row0 + ai * HALF + m * 16) * ldz + col0;
#pragma unroll
                for (int bj = 0; bj < 2; ++bj) {
                    const u32x4 gm = *(const u32x4*)(Z + off + cgm + bj * HALF);
                    float dm[8] = {sigmoid_den(bf_lo(gm.x)), sigmoid_den(bf_hi(gm.x)), sigmoid_den(bf_lo(gm.y)), sigmoid_den(bf_hi(gm.y)), sigmoid_den(bf_lo(gm.z)), sigmoid_den(bf_hi(gm.z)), sigmoid_den(bf_lo(gm.w)), sigmoid_den(bf_hi(gm.w))};
                    if (u.kind == 0) {
                        const u32x4 ga = *(const u32x4*)(Z + off + cga + bj * HALF);
                        float da[8] = {sigmoid_den(bf_lo(ga.x)), sigmoid_den(bf_hi(ga.x)), sigmoid_den(bf_lo(ga.y)), sigmoid_den(bf_hi(ga.y)), sigmoid_den(bf_lo(ga.z)), sigmoid_den(bf_hi(ga.z)), sigmoid_den(bf_lo(ga.w)), sigmoid_den(bf_hi(ga.w))};
#pragma unroll
                        for (int n = 0; n < 2; ++n)
#pragma unroll
                            for (int e = 0; e < 4; ++e) acc[ai][bj][m][n][e] *= dm[4 * n + e] / da[4 * n + e];
                    } else {
                        float r[8];
#pragma unroll
                        for (int n = 0; n < 2; ++n)
#pragma unroll
                            for (int e = 0; e < 4; ++e) r[4 * n + e] = acc[ai][bj][m][n][e] / dm[4 * n + e];
                        u32x4 w; w.x = cvt_pk_bf16(r[0], r[1]); w.y = cvt_pk_bf16(r[2], r[3]); w.z = cvt_pk_bf16(r[4], r[5]); w.w = cvt_pk_bf16(r[6], r[7]);
                        *(u32x4*)(Y + off + bj * HALF) = w;
                    }
                } }
        return u.kind != 0;
    }
};

template <class Epi, class Sched>
__device__ __forceinline__ void gemm_phase(PG8_LAS unsigned char* lds, const Gemm g, const Sched& S, const Epi& E) {
    const int tid = threadIdx.x, wid = __builtin_amdgcn_readfirstlane(tid >> 6), lane = tid & 63, wr = wid >> 2, wc = wid & 3, fr = lane & 15, fq = lane >> 4;
    const int K = g.K, nt = K / BK, lda = g.lda;
    unsigned voffA[2], voffB[2];
#pragma unroll
    for (int i = 0; i < 2; ++i) { int R, C; stage_rc(tid * 16 + i * 8192, R, C); const int Rb = (R & ~31) + perm32(R & 31);
        voffA[i] = (unsigned)(R * lda + C) * 2u; voffB[i] = (unsigned)(Rb * K + C) * 2u; }
    const size_t kstep = (size_t)(BK * 2);
    const size_t hstepA = (size_t)HALF * lda * 2, hstepB = (size_t)HALF * K * 2;
    const size_t tstepA = 2 * hstepA, tstepB = 2 * hstepB;
    const unsigned ldsw = (unsigned)wid * 1024u;
    const int aoff = lds_byte(wr * 64 + fr, fq * 8), boff = lds_byte(wc * 32 + fr, fq * 8);
#define PG8_SA(b, h) (((b) * 2 + (h)) * HTB)
#define PG8_SB(b, h) ((4 + (b) * 2 + (h)) * HTB)
#define PG8_STAGE(bufoff, gbase, voff) do { _Pragma("unroll") for (int _i = 0; _i < 2; ++_i) \
        __builtin_amdgcn_global_load_lds((const unsigned*)((const char*)(gbase) + (voff)[_i]), (PG8_LAS unsigned*)(lds + (bufoff) + ldsw + _i * 8192), 16, 0, 0); } while (0)
#define PG8_LDA(dst, b, h) do { _Pragma("unroll") for (int m = 0; m < 4; ++m) _Pragma("unroll") for (int k = 0; k < 2; ++k) dst[m][k] = *(const PG8_LAS bf16x8*)(lds + PG8_SA(b, h) + aoff + m * 2048 + k * 1024); } while (0)
#define PG8_LDB(dst, b, h) do { _Pragma("unroll") for (int n = 0; n < 2; ++n) _Pragma("unroll") for (int k = 0; k < 2; ++k) dst[n][k] = *(const PG8_LAS bf16x8*)(lds + PG8_SB(b, h) + boff + n * 2048 + k * 1024); } while (0)
#define PG8_MMA(ai, bj, At, Bt) do { __builtin_amdgcn_s_setprio(1); _Pragma("unroll") for (int m = 0; m < 4; ++m) _Pragma("unroll") for (int n = 0; n < 2; ++n) _Pragma("unroll") for (int k = 0; k < 2; ++k) \
        acc[ai][bj][m][n] = __builtin_amdgcn_mfma_f32_16x16x32_bf16(Bt[n][k], At[m][k], acc[ai][bj][m][n], 0, 0, 0); __builtin_amdgcn_s_setprio(0); } while (0)
#define PG8_WAIT_V(n) asm volatile("s_waitcnt vmcnt(" #n ")" ::: "memory")
#define PG8_WAIT_L(n) asm volatile("s_waitcnt lgkmcnt(" #n ")" ::: "memory")
#define PG8_BAR __builtin_amdgcn_s_barrier()
#define PG8_SCHED __builtin_amdgcn_sched_barrier(0)
    Unit cur, nxt; int ui = 0;
    if (!S.next(0, cur)) return;
    f32x4 acc[2][2][4][2];
#pragma unroll
    for (int a = 0; a < 2; ++a)
#pragma unroll
        for (int b = 0; b < 2; ++b)
#pragma unroll
            for (int m = 0; m < 4; ++m)
#pragma unroll
                for (int n = 0; n < 2; ++n) acc[a][b][m][n] = (f32x4){0.f, 0.f, 0.f, 0.f};
    bf16x8 At[4][2], B0[2][2], B1[2][2];
    const char* cA = (const char*)(cur.kind ? g.A1 : g.A0) + (size_t)cur.pm * tstepA; const char* cB = (const char*)(cur.kind ? g.B1 : g.B0) + (size_t)cur.pn * tstepB;
    PG8_STAGE(PG8_SB(0, 0), cB, voffB); PG8_STAGE(PG8_SB(0, 1), cB + hstepB, voffB); PG8_STAGE(PG8_SA(0, 0), cA, voffA); PG8_STAGE(PG8_SA(0, 1), cA + hstepA, voffA);
    if (wr == 1) PG8_BAR;
    PG8_WAIT_V(2); PG8_BAR;
    PG8_STAGE(PG8_SB(1, 0), cB + kstep, voffB); PG8_STAGE(PG8_SA(1, 0), cA + kstep, voffA); PG8_STAGE(PG8_SB(1, 1), cB + hstepB + kstep, voffB);
    PG8_WAIT_V(6); PG8_BAR;
    for (;;) {
        const bool has_next = S.next(ui + 1, nxt);
        const char* nA = has_next ? (const char*)(nxt.kind ? g.A1 : g.A0) + (size_t)nxt.pm * tstepA : cA; const char* nB = has_next ? (const char*)(nxt.kind ? g.B1 : g.B0) + (size_t)nxt.pn * tstepB : cB;
        for (int t = 0; t < nt; t += 2) {
            const bool last = (t == nt - 2);
            const char* a1 = cA + (size_t)(t + 1) * kstep;
            const char* a2 = last ? nA : cA + (size_t)(t + 2) * kstep; const char* b2 = last ? nB : cB + (size_t)(t + 2) * kstep;
            const char* a3 = a2 + kstep; const char* b3 = b2 + kstep;
            PG8_LDB(B0, 0, 0); PG8_LDB(B1, 0, 1); PG8_SCHED; PG8_LDA(At, 0, 0); PG8_STAGE(PG8_SA(1, 1), a1 + hstepA, voffA);
            PG8_WAIT_V(8); PG8_WAIT_L(0); PG8_BAR; PG8_MMA(0, 0, At, B0); PG8_MMA(0, 1, At, B1); PG8_BAR; PG8_SCHED;
            PG8_LDA(At, 0, 1); PG8_STAGE(PG8_SB(0, 0), b2, voffB); PG8_STAGE(PG8_SB(0, 1), b2 + hstepB, voffB); PG8_STAGE(PG8_SA(0, 0), a2, voffA);
            PG8_WAIT_V(8); PG8_WAIT_L(0); PG8_BAR; PG8_MMA(1, 0, At, B0); PG8_MMA(1, 1, At, B1); PG8_BAR; PG8_SCHED;
            PG8_LDB(B0, 1, 0); PG8_LDB(B1, 1, 1); PG8_SCHED; PG8_LDA(At, 1, 0); PG8_STAGE(PG8_SA(0, 1), a2 + hstepA, voffA);
            PG8_WAIT_V(8); PG8_WAIT_L(0); PG8_BAR; PG8_MMA(0, 0, At, B0); PG8_MMA(0, 1, At, B1); PG8_BAR; PG8_SCHED;
            PG8_LDA(At, 1, 1); PG8_STAGE(PG8_SB(1, 0), b3, voffB); PG8_STAGE(PG8_SB(1, 1), b3 + hstepB, voffB); PG8_STAGE(PG8_SA(1, 0), a3, voffA);
            PG8_WAIT_V(8); PG8_WAIT_L(0); PG8_BAR; PG8_MMA(1, 0, At, B0); PG8_MMA(1, 1, At, B1); PG8_BAR; PG8_SCHED;
        }
        if (wr == 0) PG8_BAR;
        const bool zero = E(acc, cur, wr, wc, fr, fq);
        if (!has_next) break;
        if (zero) {
#pragma unroll
            for (int a = 0; a < 2; ++a)
#pragma unroll
                for (int b = 0; b < 2; ++b)
#pragma unroll
                    for (int m = 0; m < 4; ++m)
#pragma unroll
                        for (int n = 0; n < 2; ++n) acc[a][b][m][n] = (f32x4){0.f, 0.f, 0.f, 0.f};
        }
        cur = nxt; cA = nA; cB = nB; ++ui;
        if (wr == 1) PG8_BAR;
    }
    PG8_WAIT_V(0);
    PG8_BAR;
#undef PG8_SA
#undef PG8_SB
#undef PG8_STAGE
#undef PG8_LDA
#undef PG8_LDB
#undef PG8_MMA
#undef PG8_WAIT_V
#undef PG8_WAIT_L
#undef PG8_BAR
#undef PG8_SCHED
}
}

typedef unsigned short bf16;
typedef float f32x4 __attribute__((ext_vector_type(4)));
typedef unsigned u32x4 __attribute__((ext_vector_type(4)));
typedef unsigned u32x2 __attribute__((ext_vector_type(2)));
#define LAS __attribute__((address_space(3)))

constexpr int BATCH = 4, SEQ = 8192, T = BATCH * SEQ, D = 1024, FF = 2816, NGU = 2 * FF, ZP = 6656, INW = 6664;
constexpr int ZQA = 0, ZKA = 1024, ZVA = 1280, ZQM = 1536, ZKM = 2048, ZVM = 2560, ZOM = 3584, ZGA = 4608, ZGM = 5632;
constexpr float RMS_EPS = 1e-5f;
constexpr size_t MiB = (size_t)1 << 20;
constexpr size_t WS_WA = 0, WS_WP = 17 * MiB, WS_ROPE = 23 * MiB, WS_GATE = 25 * MiB, WS_MISC = 26 * MiB, WS_HA = 28 * MiB, WS_Z = 92 * MiB, WS_END = 508 * MiB;
constexpr size_t WA_GU = 0, WA_DN = 11 * MiB;
constexpr int LDS_BYTES = 147456;
constexpr int NPHASE = 13;

struct Args {
    const float* in[21]; float* out; unsigned char* ws; float inv_freq[32]; int ph_lo, ph_hi;
};

__device__ __forceinline__ unsigned f2bf(float f) { unsigned u = __builtin_bit_cast(unsigned, f); return (u + 0x7fffu + ((u >> 16) & 1u)) >> 16; }
__device__ __forceinline__ unsigned pk2(float lo, float hi) { return f2bf(lo) | (f2bf(hi) << 16); }
__device__ __forceinline__ float bf2f(bf16 b) { return __uint_as_float((unsigned)b << 16); }
__device__ __forceinline__ float wave_sum(float v) {
#pragma unroll
    for (int o = 1; o < 64; o <<= 1) v += __shfl_xor(v, o);
    return v;
}

__device__ __forceinline__ void transpose_item(const float* W, int pitch, int src_col0, int K, bf16* WT, int dst_row0, int k0, LAS float* scr, int lane) {
#pragma unroll 8
    for (int i = 0; i < 32; ++i) { const int kk = 2 * i + (lane >> 5); scr[kk * 33 + (lane & 31)] = W[(size_t)(k0 + kk) * pitch + src_col0 + (lane & 31)]; }
    asm volatile("s_waitcnt lgkmcnt(0)" ::: "memory");
    const int c = lane & 7;
#pragma unroll
    for (int j = 0; j < 4; ++j) { const int n = (lane >> 3) + 8 * j; const LAS float* s = scr + (8 * c) * 33 + n;
        u32x4 o; o.x = pk2(s[0 * 33], s[1 * 33]); o.y = pk2(s[2 * 33], s[3 * 33]); o.z = pk2(s[4 * 33], s[5 * 33]); o.w = pk2(s[6 * 33], s[7 * 33]);
        *(u32x4*)(WT + (size_t)(dst_row0 + n) * K + k0 + 8 * c) = o; }
    asm volatile("s_waitcnt lgkmcnt(0)" ::: "memory");
}
__device__ __forceinline__ void convert_weight(const float* W, int pitch, int K, int nblk, bf16* WT, int mode, int gw, int NGW, LAS float* scr, int lane) {
    const int nitems = (K / 64) * nblk;
    for (int it = gw; it < nitems; it += NGW) {
        const int kb = it / nblk, nb = it % nblk; int src = 32 * nb, dst = 32 * nb;
        if (mode == 1) dst = 256 * (src >> 7) + (src & 127);
        else if (mode == 2) dst = 256 * (src >> 7) + (src & 127) + 128;
        else if (mode == 3) src = dst < 4608 ? dst : dst + 8;
        transpose_item(W, pitch, src, K, WT, dst, 64 * kb, scr, lane);
    }
}

__device__ __forceinline__ void norm_row(const float* xrow, const float* gain, bf16* orow, int lane, f32x4 (&v)[4]) {
    const f32x4* xr = (const f32x4*)xrow + lane; const f32x4* gr = (const f32x4*)gain + lane;
    float s = 0.f;
#pragma unroll
    for (int j = 0; j < 4; ++j) { v[j] = xr[64 * j]; s += (v[j].x * v[j].x + v[j].y * v[j].y) + (v[j].z * v[j].z + v[j].w * v[j].w); }
    const float rstd = 1.0f / sqrtf(wave_sum(s) * (1.0f / D) + RMS_EPS);
    unsigned long long* o8 = (unsigned long long*)orow + lane;
#pragma unroll
    for (int j = 0; j < 4; ++j) { const f32x4 g = gr[64 * j]; v[j] = v[j] * rstd * g;
        o8[64 * j] = (unsigned long long)pk2(v[j].x, v[j].y) | ((unsigned long long)pk2(v[j].z, v[j].w) << 32); }
}

__device__ __forceinline__ void attn_simple(bf16* z, const float* rope_cos, const float* rope_sin, const float* sinks, unsigned char* lds) {
    float* Kf = (float*)lds; float* Vf = Kf + 256 * 65;
    const int tid = threadIdx.x;
    for (int item = blockIdx.x; item < 1024; item += gridDim.x) {
        const int hk = item & 3, n = (item >> 2) & 63, b = item >> 8;
        const size_t tok0 = (size_t)b * SEQ + (size_t)n * 128;
        __syncthreads();
        for (int idx = tid; idx < 256 * 32; idx += 512) {
            const int key = idx >> 5, i = idx & 31;
            float k1 = 0.f, k2 = 0.f, v1 = 0.f, v2 = 0.f;
            if (n > 0 || key >= 128) {
                const bf16* zr = z + (tok0 + key - 128) * ZP;
                const float a = bf2f(zr[ZKA + hk * 64 + i]), c = bf2f(zr[ZKA + hk * 64 + i + 32]);
                const int pos = n * 128 + key - 128;
                const float cs = rope_cos[pos * 32 + i], sn = rope_sin[pos * 32 + i];
                k1 = a * cs - c * sn; k2 = c * cs + a * sn;
                v1 = bf2f(zr[ZVA + hk * 64 + i]); v2 = bf2f(zr[ZVA + hk * 64 + i + 32]);
            }
            Kf[key * 65 + i] = k1; Kf[key * 65 + i + 32] = k2; Vf[key * 65 + i] = v1; Vf[key * 65 + i + 32] = v2;
        }
        __syncthreads();
        const int g = tid >> 7, qi = tid & 127, head = hk * 4 + g;
        bf16* qrow = z + (tok0 + qi) * ZP + ZQA + head * 64; const int pos = n * 128 + qi;
        float q[64];
#pragma unroll
        for (int i = 0; i < 32; ++i) { const float a = bf2f(qrow[i]), c = bf2f(qrow[i + 32]); const float cs = rope_cos[pos * 32 + i], sn = rope_sin[pos * 32 + i];
            q[i] = (a * cs - c * sn) * 0.125f; q[i + 32] = (c * cs + a * sn) * 0.125f; }
        float m = sinks[head], l = 1.0f; float o[64];
#pragma unroll
        for (int d = 0; d < 64; ++d) o[d] = 0.f;
        int k_lo = qi + 1; const int k_hi = qi + 128; if (n == 0 && k_lo < 128) k_lo = 128;
        for (int kk = k_lo; kk <= k_hi; ++kk) {
            const float* kr = Kf + kk * 65; float s = 0.f;
#pragma unroll
            for (int d = 0; d < 64; ++d) s += q[d] * kr[d];
            const float mn = fmaxf(m, s), sc = __expf(m - mn), pe = __expf(s - mn);
            l = l * sc + pe; const float* vr = Vf + kk * 65;
#pragma unroll
            for (int d = 0; d < 64; ++d) o[d] = o[d] * sc + pe * vr[d];
            m = mn;
        }
        const float inv = 1.0f / l;
#pragma unroll
        for (int d = 0; d < 64; d += 2) *(unsigned*)(qrow + d) = pk2(o[d] * inv, o[d + 1] * inv);
    }
}

__device__ __forceinline__ void mlstm_recurrent(const bf16* z, const float* gates, const float* conv_w, const float* conv_b, bf16* hb, unsigned char* lds) {
    float* qc = (float*)lds; float* kc = qc + 64 * 128; float* vsl = kc + 64 * 128; float* igs = vsl + 64 * 16; float* lfs = igs + 64;
    const int tid = threadIdx.x;
    for (int item = blockIdx.x; item < 256; item += gridDim.x) {
        const int vs = item & 15, h = (item >> 4) & 3, b = item >> 6;
        const size_t tokb = (size_t)b * SEQ;
        const int ch2 = tid & 255, d = ch2 & 127, tg = tid >> 8; const bool isk = ch2 >= 128;
        const int cch = (isk ? 512 : 0) + h * 128 + d;
        const float w0 = conv_w[cch], w1 = conv_w[1024 + cch], w2 = conv_w[2048 + cch], w3 = conv_w[3072 + cch], cb = conv_b[cch];
        const int zcol = (isk ? ZKM : ZQM) + h * 128 + d;
        float* dst = isk ? kc : qc; const float scale = isk ? 0.08838834764831845f : 1.0f;
        const int vi = tid >> 5, dg = tid & 31;
        float C0 = 0.f, C1 = 0.f, C2 = 0.f, C3 = 0.f, n0 = 0.f, n1 = 0.f, n2 = 0.f, n3 = 0.f, m = 0.f;
        for (int ck = 0; ck < SEQ / 64; ++ck) {
            const int t0 = ck * 64;
            __syncthreads();
            {
                const int ts = t0 + tg * 32;
                const bf16* zc = z + tokb * ZP + zcol;
                float r0 = ts - 3 >= 0 ? bf2f(zc[(size_t)(ts - 3) * ZP]) : 0.f, r1 = ts - 2 >= 0 ? bf2f(zc[(size_t)(ts - 2) * ZP]) : 0.f, r2 = ts - 1 >= 0 ? bf2f(zc[(size_t)(ts - 1) * ZP]) : 0.f;
#pragma unroll 4
                for (int i = 0; i < 32; ++i) { const float r3 = bf2f(zc[(size_t)(ts + i) * ZP]); float y = w0 * r0 + w1 * r1 + w2 * r2 + w3 * r3 + cb; y = y / (1.0f + __expf(-y));
                    dst[(tg * 32 + i) * 128 + d] = y * scale; r0 = r1; r1 = r2; r2 = r3; }
            }
            for (int idx = tid; idx < 1024; idx += 512) { const int s = idx >> 4, j = idx & 15; vsl[idx] = bf2f(z[(tokb + t0 + s) * ZP + ZVM + h * 256 + vs * 16 + j]); }
            if (tid < 64) { igs[tid] = gates[(tokb + t0 + tid) * 8 + h]; lfs[tid] = gates[(tokb + t0 + tid) * 8 + 4 + h]; }
            __syncthreads();
#pragma unroll 4
            for (int s = 0; s < 64; ++s) {
                const float lf = lfs[s], ig = igs[s];
                const float mn = fmaxf(lf + m, ig), fs = __expf(lf + m - mn), is = __expf(ig - mn); m = mn;
                const f32x4 k4 = *(const f32x4*)(kc + s * 128 + 4 * dg), q4 = *(const f32x4*)(qc + s * 128 + 4 * dg);
                const float iv = is * vsl[s * 16 + vi];
                C0 = fs * C0 + iv * k4.x; C1 = fs * C1 + iv * k4.y; C2 = fs * C2 + iv * k4.z; C3 = fs * C3 + iv * k4.w;
                n0 = fs * n0 + is * k4.x; n1 = fs * n1 + is * k4.y; n2 = fs * n2 + is * k4.z; n3 = fs * n3 + is * k4.w;
                float pn = (C0 * q4.x + C1 * q4.y) + (C2 * q4.z + C3 * q4.w), pd = (n0 * q4.x + n1 * q4.y) + (n2 * q4.z + n3 * q4.w);
#pragma unroll
                for (int o = 1; o < 32; o <<= 1) { pn += __shfl_xor(pn, o); pd += __shfl_xor(pd, o); }
                const float hv = pn / fmaxf(fabsf(pd), __expf(-m));
                if (dg == 0) hb[(tokb + t0 + s) * 1024 + h * 256 + vs * 16 + vi] = (bf16)f2bf(hv);
            }
        }
    }
}

__global__ void __launch_bounds__(512, 2) mega_fwd(Args args) {
    extern __shared__ __attribute__((aligned(16))) unsigned char lds[];
    cg::grid_group grid = cg::this_grid();
    const int tid = threadIdx.x, lane = tid & 63, wave = __builtin_amdgcn_readfirstlane(tid >> 6);
    const int G = gridDim.x, gw = blockIdx.x * 8 + wave, NGW = G * 8;
    unsigned char* ws = args.ws;
    const float* x = args.in[0];
    float* out = args.out;
    bf16* WA = (bf16*)(ws + WS_WA); bf16* Wgu = (bf16*)(ws + WS_WA + WA_GU); bf16* Wdn = (bf16*)(ws + WS_WA + WA_DN);
    bf16* Watt = (bf16*)(ws + WS_WP); bf16* Wml = (bf16*)(ws + WS_WP + 2 * MiB); bf16* Wout = (bf16*)(ws + WS_WP + 4 * MiB);
    float* rope_cos = (float*)(ws + WS_ROPE); float* rope_sin = rope_cos + SEQ * 32;
    float* gates = (float*)(ws + WS_GATE);
    bf16* hA = (bf16*)(ws + WS_HA); bf16* Z = (bf16*)(ws + WS_Z); bf16* HID = (bf16*)(ws + WS_Z);
    LAS float* scr = (LAS float*)((LAS unsigned char*)lds + wave * 16384);
    const int lo = args.ph_lo, hi = args.ph_hi;
#define IN(k) (lo <= (k) && (k) < hi)
#define SEAM(k) do { if (IN(k) && IN((k) + 1)) grid.sync(); } while (0)

    if (IN(0)) {
        convert_weight(args.in[2], FF, D, FF / 32, Wgu, 1, gw, NGW, scr, lane);
        convert_weight(args.in[3], FF, D, FF / 32, Wgu, 2, gw, NGW, scr, lane);
        convert_weight(args.in[4], D, FF, D / 32, Wdn, 0, gw, NGW, scr, lane);
        convert_weight(args.in[13], D, D, D / 32, Watt, 0, gw, NGW, scr, lane);
        convert_weight(args.in[14], D, D, D / 32, Wml, 0, gw, NGW, scr, lane);
        convert_weight(args.in[15], D, D, D / 32, Wout, 0, gw, NGW, scr, lane);
        for (int idx = blockIdx.x * 512 + tid; idx < SEQ * 32; idx += G * 512) {
            const int pos = idx >> 5, i = idx & 31;
            const float angf = (float)pos * args.inv_freq[i];
            const double ang = (double)angf;
            const double kq = rint(ang * 0.63661977236758134308);
            const double y = (ang - kq * 1.57079632679489655800) - kq * 6.123233995736766e-17;
            const double y2 = y * y;
            const double sy = y * (1.0 + y2 * (-1.0 / 6 + y2 * (1.0 / 120 + y2 * (-1.0 / 5040 + y2 * (1.0 / 362880 + y2 * (-1.0 / 39916800 + y2 * (1.0 / 6227020800.0)))))));
            const double cy = 1.0 + y2 * (-0.5 + y2 * (1.0 / 24 + y2 * (-1.0 / 720 + y2 * (1.0 / 40320 + y2 * (-1.0 / 3628800 + y2 * (1.0 / 479001600.0 + y2 * (-1.0 / 87178291200.0)))))));
            const long long qi = (long long)kq; const int qd = (int)(qi & 3);
            const double sn = qd == 0 ? sy : qd == 1 ? cy : qd == 2 ? -sy : -cy;
            const double cs = qd == 0 ? cy : qd == 1 ? -sy : qd == 2 ? -cy : sy;
            rope_cos[idx] = (float)cs; rope_sin[idx] = (float)sn;
        }
        for (int r = gw; r < T; r += NGW) { f32x4 v[4]; norm_row(x + (size_t)r * D, args.in[1], hA + (size_t)r * D, lane, v); }
    }
    SEAM(0);
    if (IN(1)) {
        pg8::Gemm g{hA, hA, Wgu, Wgu, D, D}; pg8::StaticOrder S; S.init(T, NGU, G, (int)blockIdx.x);
        pg8::EpiSwiGLU E{HID, FF};
        pg8::gemm_phase<pg8::EpiSwiGLU, pg8::StaticOrder>((PG8_LAS unsigned char*)lds, g, S, E);
    }
    SEAM(1);
    if (IN(2)) {
        pg8::Gemm g{HID, HID, Wdn, Wdn, FF, FF}; pg8::StaticOrder S; S.init(T, D, G, (int)blockIdx.x);
        pg8::EpiResid E{x, out, D, 0.5f};
        pg8::gemm_phase<pg8::EpiResid, pg8::StaticOrder>((PG8_LAS unsigned char*)lds, g, S, E);
    }
    SEAM(2);
    if (IN(3)) {
        convert_weight(args.in[6], INW, D, ZP / 32, WA, 3, gw, NGW, scr, lane);
        const float* win = args.in[6];
        for (int r = gw; r < T; r += NGW) {
            f32x4 v[4]; norm_row(out + (size_t)r * D, args.in[5], hA + (size_t)r * D, lane, v);
            float gsum[8];
#pragma unroll
            for (int e = 0; e < 8; ++e) gsum[e] = 0.f;
#pragma unroll
            for (int j = 0; j < 4; ++j)
#pragma unroll
                for (int e = 0; e < 4; ++e) { const int k = 256 * j + 4 * lane + e; const f32x4 wa = *(const f32x4*)(win + (size_t)k * INW + 4608), wb = *(const f32x4*)(win + (size_t)k * INW + 4612); const float hv = v[j][e];
                    gsum[0] += hv * wa.x; gsum[1] += hv * wa.y; gsum[2] += hv * wa.z; gsum[3] += hv * wa.w; gsum[4] += hv * wb.x; gsum[5] += hv * wb.y; gsum[6] += hv * wb.z; gsum[7] += hv * wb.w; }
#pragma unroll
            for (int e = 0; e < 8; ++e) gsum[e] = wave_sum(gsum[e]);
            if (lane < 8) {
                float val = lane == 0 ? gsum[0] : lane == 1 ? gsum[1] : lane == 2 ? gsum[2] : lane == 3 ? gsum[3] : lane == 4 ? gsum[4] : lane == 5 ? gsum[5] : lane == 6 ? gsum[6] : gsum[7];
                if (lane < 4) val += args.in[7][lane];
                else { const float xx = val + args.in[8][lane - 4]; val = fminf(xx, 0.f) - log1pf(expf(-fabsf(xx))); }
                gates[(size_t)r * 8 + lane] = val;
            }
        }
    }
    SEAM(3);
    if (IN(4)) {
        pg8::Gemm g{hA, hA, WA, WA, D, D}; pg8::StaticOrder S; S.init(T, ZP, G, (int)blockIdx.x);
        pg8::EpiBf16 E{Z, ZP};
        pg8::gemm_phase<pg8::EpiBf16, pg8::StaticOrder>((PG8_LAS unsigned char*)lds, g, S, E);
    }
    SEAM(4);
    if (IN(5)) {
        mlstm_recurrent(Z, gates, args.in[10], args.in[11], hA, lds);
        attn_simple(Z, rope_cos, rope_sin, args.in[9], lds);
    }
    SEAM(5);
    if (IN(6)) {
        __syncthreads();
        convert_weight(args.in[17], FF, D, FF / 32, Wgu, 1, gw, NGW, scr, lane);
        convert_weight(args.in[18], FF, D, FF / 32, Wgu, 2, gw, NGW, scr, lane);
        convert_weight(args.in[19], D, FF, D / 32, Wdn, 0, gw, NGW, scr, lane);
        const float* hn = args.in[12];
        for (int r = gw; r < T; r += NGW) {
            const int head = lane >> 4, j0 = (lane & 15) * 16;
            const bf16* hp = hA + (size_t)r * 1024 + head * 256 + j0;
            bf16* op = Z + (size_t)r * ZP + ZOM + head * 256 + j0;
            const u32x4 ha = *(const u32x4*)hp, hb2 = *(const u32x4*)(hp + 8);
            const u32x4 oa = *(const u32x4*)op, ob = *(const u32x4*)(op + 8);
            float hv[16] = {pg8::bf_lo(ha.x), pg8::bf_hi(ha.x), pg8::bf_lo(ha.y), pg8::bf_hi(ha.y), pg8::bf_lo(ha.z), pg8::bf_hi(ha.z), pg8::bf_lo(ha.w), pg8::bf_hi(ha.w),
                            pg8::bf_lo(hb2.x), pg8::bf_hi(hb2.x), pg8::bf_lo(hb2.y), pg8::bf_hi(hb2.y), pg8::bf_lo(hb2.z), pg8::bf_hi(hb2.z), pg8::bf_lo(hb2.w), pg8::bf_hi(hb2.w)};
            float ov[16] = {pg8::bf_lo(oa.x), pg8::bf_hi(oa.x), pg8::bf_lo(oa.y), pg8::bf_hi(oa.y), pg8::bf_lo(oa.z), pg8::bf_hi(oa.z), pg8::bf_lo(oa.w), pg8::bf_hi(oa.w),
                            pg8::bf_lo(ob.x), pg8::bf_hi(ob.x), pg8::bf_lo(ob.y), pg8::bf_hi(ob.y), pg8::bf_lo(ob.z), pg8::bf_hi(ob.z), pg8::bf_lo(ob.w), pg8::bf_hi(ob.w)};
            float ss = 0.f;
#pragma unroll
            for (int e = 0; e < 16; ++e) ss += hv[e] * hv[e];
            ss += __shfl_xor(ss, 1); ss += __shfl_xor(ss, 2); ss += __shfl_xor(ss, 4); ss += __shfl_xor(ss, 8);
            const float rstd = 1.0f / sqrtf(ss * (1.0f / 256.0f) + RMS_EPS);
            float res[16];
#pragma unroll
            for (int e = 0; e < 16; ++e) res[e] = hv[e] * rstd * hn[head * 256 + j0 + e] / (1.0f + __expf(-ov[e]));
            u32x4 w0, w1; w0.x = pk2(res[0], res[1]); w0.y = pk2(res[2], res[3]); w0.z = pk2(res[4], res[5]); w0.w = pk2(res[6], res[7]);
            w1.x = pk2(res[8], res[9]); w1.y = pk2(res[10], res[11]); w1.z = pk2(res[12], res[13]); w1.w = pk2(res[14], res[15]);
            *(u32x4*)op = w0; *(u32x4*)(op + 8) = w1;
        }
    }
    SEAM(6);
    if (IN(7)) {
        pg8::Gemm g{Z + ZQA, Z + ZOM, Watt, Wml, ZP, D}; pg8::PairOrder S; S.so.init(T, D, G, (int)blockIdx.x);
        pg8::EpiMix E{Z, Z + ZQM, ZP, ZGA, ZGM};
        pg8::gemm_phase<pg8::EpiMix, pg8::PairOrder>((PG8_LAS unsigned char*)lds, g, S, E);
    }
    SEAM(7);
    if (IN(8)) {
        pg8::Gemm g{Z + ZQM, Z + ZQM, Wout, Wout, ZP, D}; pg8::StaticOrder S; S.init(T, D, G, (int)blockIdx.x);
        pg8::EpiResid E{out, out, D, 1.0f};
        pg8::gemm_phase<pg8::EpiResid, pg8::StaticOrder>((PG8_LAS unsigned char*)lds, g, S, E);
    }
    SEAM(8);
    if (IN(9)) {
        for (int r = gw; r < T; r += NGW) { f32x4 v[4]; norm_row(out + (size_t)r * D, args.in[16], hA + (size_t)r * D, lane, v); }
    }
    SEAM(9);
    if (IN(10)) {
        pg8::Gemm g{hA, hA, Wgu, Wgu, D, D}; pg8::StaticOrder S; S.init(T, NGU, G, (int)blockIdx.x);
        pg8::EpiSwiGLU E{HID, FF};
        pg8::gemm_phase<pg8::EpiSwiGLU, pg8::StaticOrder>((PG8_LAS unsigned char*)lds, g, S, E);
    }
    SEAM(10);
    if (IN(11)) {
        pg8::Gemm g{HID, HID, Wdn, Wdn, FF, FF}; pg8::StaticOrder S; S.init(T, D, G, (int)blockIdx.x);
        pg8::EpiResid E{out, out, D, 0.5f};
        pg8::gemm_phase<pg8::EpiResid, pg8::StaticOrder>((PG8_LAS unsigned char*)lds, g, S, E);
    }
    SEAM(11);
    if (IN(12)) {
        const float* gain = args.in[20];
        for (int r = gw; r < T; r += NGW) {
            f32x4* xr = (f32x4*)(out + (size_t)r * D) + lane; const f32x4* gr = (const f32x4*)gain + lane;
            f32x4 v[4]; float s = 0.f;
#pragma unroll
            for (int j = 0; j < 4; ++j) { v[j] = xr[64 * j]; s += (v[j].x * v[j].x + v[j].y * v[j].y) + (v[j].z * v[j].z + v[j].w * v[j].w); }
            const float rstd = 1.0f / sqrtf(wave_sum(s) * (1.0f / D) + RMS_EPS);
#pragma unroll
            for (int j = 0; j < 4; ++j) xr[64 * j] = v[j] * rstd * gr[64 * j];
        }
    }
#undef IN
#undef SEAM
}

extern "C" void kernel_launch(void* const* d_in, const int* in_sizes, int n_in, void* d_out, int out_size, void* d_ws, size_t ws_size, hipStream_t stream) {
    static int grid = 0;
    if (grid == 0) {
        if (n_in != 21 || out_size != T * D || ws_size < WS_END) { fprintf(stderr, "kernel_launch: unexpected shapes (n_in %d out %d ws %zu)\n", n_in, out_size, ws_size); grid = -1; return; }
        int dev = 0, cus = 0, per_cu = 0;
        hipGetDevice(&dev); hipDeviceGetAttribute(&cus, hipDeviceAttributeMultiprocessorCount, dev);
        if (hipFuncSetAttribute((const void*)mega_fwd, hipFuncAttributeMaxDynamicSharedMemorySize, LDS_BYTES) != hipSuccess) { fprintf(stderr, "kernel_launch: hipFuncSetAttribute failed\n"); grid = -1; return; }
        if (hipOccupancyMaxActiveBlocksPerMultiprocessor(&per_cu, (const void*)mega_fwd, 512, LDS_BYTES) != hipSuccess || per_cu < 1) { fprintf(stderr, "kernel_launch: occupancy query failed (%d)\n", per_cu); per_cu = 1; }
        (void)hipGetLastError();
        grid = cus * per_cu;
    }
    if (grid < 0) return;
    Args a{};
    for (int i = 0; i < 21; ++i) a.in[i] = (const float*)d_in[i];
    a.out = (float*)d_out; a.ws = (unsigned char*)d_ws;
    for (int i = 0; i < 32; ++i) a.inv_freq[i] = (float)pow(10000.0, -(double)i / 32.0);
#if MK_PER_PHASE_LAUNCH
    for (int ph = 0; ph < NPHASE; ++ph) { a.ph_lo = ph; a.ph_hi = ph + 1; hipLaunchKernelGGL(mega_fwd, dim3(grid), dim3(512), LDS_BYTES, stream, a); }
#else
    a.ph_lo = 0; a.ph_hi = NPHASE;
    void* kargs[] = {&a};
    hipError_t e = hipLaunchCooperativeKernel((const void*)mega_fwd, dim3(grid), dim3(512), kargs, LDS_BYTES, stream);
    if (e != hipSuccess) fprintf(stderr, "kernel_launch: cooperative launch failed: %s (grid %d)\n", hipGetErrorString(e), grid);
#endif
}
```

```cpp
#include <hip/hip_runtime.h>
#include <hip/hip_cooperative_groups.h>
#include <cstdio>
#include <cstdint>
#include <cmath>
namespace cg = cooperative_groups;

#ifndef MK_PER_PHASE_LAUNCH
#define MK_PER_PHASE_LAUNCH 0
#endif

namespace pg8 {
#define PG8_LAS __attribute__((address_space(3)))
typedef unsigned short bf16_t;
typedef short bf16x8 __attribute__((ext_vector_type(8)));
typedef float f32x4 __attribute__((ext_vector_type(4)));
typedef unsigned u32x4 __attribute__((ext_vector_type(4)));
constexpr int BM = 256, BK = 64, HALF = 128, HTB = HALF * BK * 2, STAGE_BYTES = 8 * HTB, NXCD = 8, WGM = 8;

__host__ __device__ __forceinline__ int lds_byte(int r, int c) { const int st = (r >> 4) * 2 + (c >> 5), rr = r & 15, cc = c & 31, ob = rr * 64 + cc * 2; return st * 1024 + (ob ^ (((ob >> 9) & 1) << 5)); }
__host__ __device__ __forceinline__ void stage_rc(int b, int& R, int& C) { const int st = b / 1024, sb = b % 1024, swz = sb ^ (((sb >> 9) & 1) << 5); R = (st >> 1) * 16 + swz / 64; C = (st & 1) * 32 + (swz % 64) / 2; }
__host__ __device__ __forceinline__ int perm32(int rho) { const int n = rho >> 4, i = rho & 15; return 8 * (i >> 2) + 4 * n + (i & 3); }

struct Unit { int pm, pn, kind; };
struct Gemm { const bf16_t* A0; const bf16_t* A1; const bf16_t* B0; const bf16_t* B1; int lda, K; };

struct StaticOrder {
    int nM, nN, nwg, G, c;
    __host__ __device__ void init(int M, int N, int G_, int c_) { nM = M / BM; nN = N / BM; nwg = nM * nN; G = G_; c = c_; }
    __host__ __device__ bool next(int i, Unit& u) const {
        const long L = (long)i * G + c; if (L >= nwg) return false;
        int wgid = (int)L; { const int q = nwg / NXCD, r = nwg % NXCD, xcd = wgid % NXCD, off = wgid / NXCD; wgid = (xcd < r ? xcd * (q + 1) : r * (q + 1) + (xcd - r) * q) + off; }
        const int nig = WGM * nN, gid = wgid / nig, fm = gid * WGM, gsz = (nM - fm) < WGM ? (nM - fm) : WGM;
        u.pm = fm + ((wgid % nig) % gsz); u.pn = (wgid % nig) / gsz; u.kind = 0; return true;
    }
};
struct PairOrder {
    StaticOrder so;
    __host__ __device__ bool next(int i, Unit& u) const { if (!so.next(i >> 1, u)) return false; u.kind = i & 1; return true; }
};

__device__ __forceinline__ unsigned cvt_pk_bf16(float lo, float hi) { unsigned r; asm volatile("v_cvt_pk_bf16_f32 %0, %1, %2" : "=v"(r) : "v"(lo), "v"(hi)); return r; }
__device__ __forceinline__ float bf_lo(unsigned w) { return __uint_as_float(w << 16); }
__device__ __forceinline__ float bf_hi(unsigned w) { return __uint_as_float(w & 0xffff0000u); }
__device__ __forceinline__ float sigmoid_den(float x) { return 1.0f + __expf(-x); }


struct EpiBf16 {
    bf16_t* O; int ldc;
    __device__ __forceinline__ bool operator()(f32x4 (&acc)[2][2][4][2], const Unit& u, int wr, int wc, int fr, int fq) const {
        const int row0 = u.pm * BM + wr * 64 + fr, col0 = u.pn * BM + wc * 32 + 8 * fq;
#pragma unroll
        for (int ai = 0; ai < 2; ++ai)
#pragma unroll
            for (int m = 0; m < 4; ++m) { bf16_t* rowp = O + (size_t)(row0 + ai * HALF + m * 16) * ldc + col0;
#pragma unroll
                for (int bj = 0; bj < 2; ++bj) { const f32x4 v0 = acc[ai][bj][m][0], v1 = acc[ai][bj][m][1];
                    u32x4 w; w.x = cvt_pk_bf16(v0[0], v0[1]); w.y = cvt_pk_bf16(v0[2], v0[3]); w.z = cvt_pk_bf16(v1[0], v1[1]); w.w = cvt_pk_bf16(v1[2], v1[3]);
                    *(u32x4*)(rowp + bj * HALF) = w; } }
        return true;
    }
};
struct EpiSwiGLU {
    bf16_t* O; int ldc;
    __device__ __forceinline__ bool operator()(f32x4 (&acc)[2][2][4][2], const Unit& u, int wr, int wc, int fr, int fq) const {
        const int row0 = u.pm * BM + wr * 64 + fr, col0 = u.pn * HALF + wc * 32 + 8 * fq;
#pragma unroll
        for (int ai = 0; ai < 2; ++ai)
#pragma unroll
            for (int m = 0; m < 4; ++m) { bf16_t* rowp = O + (size_t)(row0 + ai * HALF + m * 16) * ldc + col0;
                float r[8];
#pragma unroll
                for (int n = 0; n < 2; ++n)
#pragma unroll
                    for (int e = 0; e < 4; ++e) { const float g = acc[ai][0][m][n][e], up = acc[ai][1][m][n][e]; r[4 * n + e] = g * __builtin_amdgcn_rcpf(1.0f + __expf(-g)) * up; }
                u32x4 w; w.x = cvt_pk_bf16(r[0], r[1]); w.y = cvt_pk_bf16(r[2], r[3]); w.z = cvt_pk_bf16(r[4], r[5]); w.w = cvt_pk_bf16(r[6], r[7]);
                *(u32x4*)rowp = w; }
        return true;
    }
};
struct EpiResid {
    const float* base; float* out; int ldc; float alpha;
    __device__ __forceinline__ bool operator()(f32x4 (&acc)[2][2][4][2], const Unit& u, int wr, int wc, int fr, int fq) const {
        const int row0 = u.pm * BM + wr * 64 + fr, col0 = u.pn * BM + wc * 32 + 8 * fq;
#pragma unroll
        for (int ai = 0; ai < 2; ++ai)
#pragma unroll
            for (int m = 0; m < 4; ++m) { const size_t off = (size_t)(row0 + ai * HALF + m * 16) * ldc + col0;
#pragma unroll
                for (int bj = 0; bj < 2; ++bj)
#pragma unroll
                    for (int n = 0; n < 2; ++n) { const f32x4 b = *(const f32x4*)(base + off + bj * HALF + 4 * n); *(f32x4*)(out + off + bj * HALF + 4 * n) = b + acc[ai][bj][m][n] * alpha; } }
        return true;
    }
};
struct EpiMix {
    const bf16_t* Z; bf16_t* Y; int ldz; int cga, cgm;
    __device__ __forceinline__ bool operator()(f32x4 (&acc)[2][2][4][2], const Unit& u, int wr, int wc, int fr, int fq) const {
        const int row0 = u.pm * BM + wr * 64 + fr, col0 = u.pn * BM + wc * 32 + 8 * fq;
#pragma unroll
        for (int ai = 0; ai < 2; ++ai)
#pragma unroll
            for (int m = 0; m < 4; ++m) { const size_t off = (size_t)(row0 + ai * HALF + m * 16) * ldz + col0;
#pragma unroll
                for (int bj = 0; bj < 2; ++bj) {
                    const u32x4 gm = *(const u32x4*)(Z + off + cgm + bj * HALF);
                    float dm[8] = {sigmoid_den(bf_lo(gm.x)), sigmoid_den(bf_hi(gm.x)), sigmoid_den(bf_lo(gm.y)), sigmoid_den(bf_hi(gm.y)), sigmoid_den(bf_lo(gm.z)), sigmoid_den(bf_hi(gm.z)), sigmoid_den(bf_lo(gm.w)), sigmoid_den(bf_hi(gm.w))};
                    if (u.kind == 0) {
                        const u32x4 ga = *(const u32x4*)(Z + off + cga + bj * HALF);
                        float da[8] = {sigmoid_den(bf_lo(ga.x)), sigmoid_den(bf_hi(ga.x)), sigmoid_den(bf_lo(ga.y)), sigmoid_den(bf_hi(ga.y)), sigmoid_den(bf_lo(ga.z)), sigmoid_den(bf_hi(ga.z)), sigmoid_den(bf_lo(ga.w)), sigmoid_den(bf_hi(ga.w))};
#pragma unroll
                        for (int n = 0; n < 2; ++n)
#pragma unroll
                            for (int e = 0; e < 4; ++e) acc[ai][bj][m][n][e] *= dm[4 * n + e] / da[4 * n + e];
                    } else {
                        float r[8];
#pragma unroll
                        for (int n = 0; n < 2; ++n)
#pragma unroll
                            for (int e = 0; e < 4; ++e) r[4 * n + e] = acc[ai][bj][m][n][e] / dm[4 * n + e];
                        u32x4 w; w.x = cvt_pk_bf16(r[0], r[1]); w.y = cvt_pk_bf16(r[2], r[3]); w.z = cvt_pk_bf16(r[4], r[5]); w.w = cvt_pk_bf16(r[6], r[7]);
                        *(u32x4*)(Y + off + bj * HALF) = w;
                    }
                } }
        return u.kind != 0;
    }
};

template <class Epi, class Sched>
__device__ __forceinline__ void gemm_phase(PG8_LAS unsigned char* lds, const Gemm g, const Sched& S, const Epi& E) {
    const int tid = threadIdx.x, wid = __builtin_amdgcn_readfirstlane(tid >> 6), lane = tid & 63, wr = wid >> 2, wc = wid & 3, fr = lane & 15, fq = lane >> 4;
    const int K = g.K, nt = K / BK, lda = g.lda;
    unsigned voffA[2], voffB[2];
#pragma unroll
    for (int i = 0; i < 2; ++i) { int R, C; stage_rc(tid * 16 + i * 8192, R, C); const int Rb = (R & ~31) + perm32(R & 31);
        voffA[i] = (unsigned)(R * lda + C) * 2u; voffB[i] = (unsigned)(Rb * K + C) * 2u; }
    const size_t kstep = (size_t)(BK * 2);
    const size_t hstepA = (size_t)HALF * lda * 2, hstepB = (size_t)HALF * K * 2;
    const size_t tstepA = 2 * hstepA, tstepB = 2 * hstepB;
    const unsigned ldsw = (unsigned)wid * 1024u;
    const int aoff = lds_byte(wr * 64 + fr, fq * 8), boff = lds_byte(wc * 32 + fr, fq * 8);
#define PG8_SA(b, h) (((b) * 2 + (h)) * HTB)
#define PG8_SB(b, h) ((4 + (b) * 2 + (h)) * HTB)
#define PG8_STAGE(bufoff, gbase, voff) do { _Pragma("unroll") for (int _i = 0; _i < 2; ++_i) \
        __builtin_amdgcn_global_load_lds((const unsigned*)((const char*)(gbase) + (voff)[_i]), (PG8_LAS unsigned*)(lds + (bufoff) + ldsw + _i * 8192), 16, 0, 0); } while (0)
#define PG8_LDA(dst, b, h) do { _Pragma("unroll") for (int m = 0; m < 4; ++m) _Pragma("unroll") for (int k = 0; k < 2; ++k) dst[m][k] = *(const PG8_LAS bf16x8*)(lds + PG8_SA(b, h) + aoff + m * 2048 + k * 1024); } while (0)
#define PG8_LDB(dst, b, h) do { _Pragma("unroll") for (int n = 0; n < 2; ++n) _Pragma("unroll") for (int k = 0; k < 2; ++k) dst[n][k] = *(const PG8_LAS bf16x8*)(lds + PG8_SB(b, h) + boff + n * 2048 + k * 1024); } while (0)
#define PG8_MMA(ai, bj, At, Bt) do { __builtin_amdgcn_s_setprio(1); _Pragma("unroll") for (int m = 0; m < 4; ++m) _Pragma("unroll") for (int n = 0; n < 2; ++n) _Pragma("unroll") for (int k = 0; k < 2; ++k) \
        acc[ai][bj][m][n] = __builtin_amdgcn_mfma_f32_16x16x32_bf16(Bt[n][k], At[m][k], acc[ai][bj][m][n], 0, 0, 0); __builtin_amdgcn_s_setprio(0); } while (0)
#define PG8_WAIT_V(n) asm volatile("s_waitcnt vmcnt(" #n ")" ::: "memory")
#define PG8_WAIT_L(n) asm volatile("s_waitcnt lgkmcnt(" #n ")" ::: "memory")
#define PG8_BAR __builtin_amdgcn_s_barrier()
#define PG8_SCHED __builtin_amdgcn_sched_barrier(0)
    Unit cur, nxt; int ui = 0;
    if (!S.next(0, cur)) return;
    f32x4 acc[2][2][4][2];
#pragma unroll
    for (int a = 0; a < 2; ++a)
#pragma unroll
        for (int b = 0; b < 2; ++b)
#pragma unroll
            for (int m = 0; m < 4; ++m)
#pragma unroll
                for (int n = 0; n < 2; ++n) acc[a][b][m][n] = (f32x4){0.f, 0.f, 0.f, 0.f};
    bf16x8 At[4][2], B0[2][2], B1[2][2];
    const char* cA = (const char*)(cur.kind ? g.A1 : g.A0) + (size_t)cur.pm * tstepA; const char* cB = (const char*)(cur.kind ? g.B1 : g.B0) + (size_t)cur.pn * tstepB;
    PG8_STAGE(PG8_SB(0, 0), cB, voffB); PG8_STAGE(PG8_SB(0, 1), cB + hstepB, voffB); PG8_STAGE(PG8_SA(0, 0), cA, voffA); PG8_STAGE(PG8_SA(0, 1), cA + hstepA, voffA);
    if (wr == 1) PG8_BAR;
    PG8_WAIT_V(2); PG8_BAR;
    PG8_STAGE(PG8_SB(1, 0), cB + kstep, voffB); PG8_STAGE(PG8_SA(1, 0), cA + kstep, voffA); PG8_STAGE(PG8_SB(1, 1), cB + hstepB + kstep, voffB);
    PG8_WAIT_V(6); PG8_BAR;
    for (;;) {
        const bool has_next = S.next(ui + 1, nxt);
        const char* nA = has_next ? (const char*)(nxt.kind ? g.A1 : g.A0) + (size_t)nxt.pm * tstepA : cA; const char* nB = has_next ? (const char*)(nxt.kind ? g.B1 : g.B0) + (size_t)nxt.pn * tstepB : cB;
        for (int t = 0; t < nt; t += 2) {
            const bool last = (t == nt - 2);
            const char* a1 = cA + (size_t)(t + 1) * kstep;
            const char* a2 = last ? nA : cA + (size_t)(t + 2) * kstep; const char* b2 = last ? nB : cB + (size_t)(t + 2) * kstep;
            const char* a3 = a2 + kstep; const char* b3 = b2 + kstep;
            PG8_LDB(B0, 0, 0); PG8_LDB(B1, 0, 1); PG8_SCHED; PG8_LDA(At, 0, 0); PG8_STAGE(PG8_SA(1, 1), a1 + hstepA, voffA);
            PG8_WAIT_V(8); PG8_WAIT_L(0); PG8_BAR; PG8_MMA(0, 0, At, B0); PG8_MMA(0, 1, At, B1); PG8_BAR; PG8_SCHED;
            PG8_LDA(At, 0, 1); PG8_STAGE(PG8_SB(0, 0), b2, voffB); PG8_STAGE(PG8_SB(0, 1), b2 + hstepB, voffB); PG8_STAGE(PG8_SA(0, 0), a2, voffA);
            PG8_WAIT_V(8); PG8_WAIT_L(0); PG8_BAR; PG8_MMA(1, 0, At, B0); PG8_MMA(1, 1, At, B1); PG8_BAR; PG8_SCHED;
            PG8_LDB(B0, 1, 0); PG8_LDB(B1, 1, 1); PG8_SCHED; PG8_LDA(At, 1, 0); PG8_STAGE(PG8_SA(0, 1), a2 + hstepA, voffA);
            PG8_WAIT_V(8); PG8_WAIT_L(0); PG8_BAR; PG8_MMA(0, 0, At, B0); PG8_MMA(0, 1, At, B1); PG8_BAR; PG8_SCHED;
            PG8_LDA(At, 1, 1); PG8_STAGE(PG8_SB(1, 0), b3, voffB); PG8_STAGE(PG8_SB(1, 1), b3 + hstepB, voffB); PG8_STAGE(PG8_SA(1, 0), a3, voffA);
            PG8_WAIT_V(8); PG8_WAIT_L(0); PG8_BAR; PG8_MMA(1, 0, At, B0); PG8_MMA(1, 1, At, B1); PG8_BAR; PG8_SCHED;
        }
        if (wr == 0) PG8_BAR;
        const bool zero = E(acc, cur, wr, wc, fr, fq);
        if (!has_next) break;
        if (zero) {
#pragma unroll
            for (int a = 0; a < 2; ++a)
#pragma unroll
                for (int b = 0; b < 2; ++b)
#pragma unroll
                    for (int m = 0; m < 4; ++m)
#pragma unroll
                        for (int n = 0; n < 2; ++n) acc[a][b][m][n] = (f32x4){0.f, 0.f, 0.f, 0.f};
        }
        cur = nxt; cA = nA; cB = nB; ++ui;
        if (wr == 1) PG8_BAR;
    }
    PG8_WAIT_V(0);
    PG8_BAR;
#undef PG8_SA
#undef PG8_SB
#undef PG8_STAGE
#undef PG8_LDA
#undef PG8_LDB
#undef PG8_MMA
#undef PG8_WAIT_V
#undef PG8_WAIT_L
#undef PG8_BAR
#undef PG8_SCHED
}
}

typedef unsigned short bf16;
typedef float f32x4 __attribute__((ext_vector_type(4)));
typedef unsigned u32x4 __attribute__((ext_vector_type(4)));
typedef unsigned u32x2 __attribute__((ext_vector_type(2)));
#define LAS __attribute__((address_space(3)))

constexpr int BATCH = 4, SEQ = 8192, T = BATCH * SEQ, D = 1024, FF = 2816, NGU = 2 * FF, ZP = 6656, INW = 6664;
constexpr int ZQA = 0, ZKA = 1024, ZVA = 1280, ZQM = 1536, ZKM = 2048, ZVM = 2560, ZOM = 3584, ZGA = 4608, ZGM = 5632;
constexpr float RMS_EPS = 1e-5f;
constexpr size_t MiB = (size_t)1 << 20;
constexpr size_t WS_WA = 0, WS_WP = 17 * MiB, WS_ROPE = 23 * MiB, WS_GATE = 25 * MiB, WS_MISC = 26 * MiB, WS_HA = 28 * MiB, WS_Z = 92 * MiB, WS_END = 508 * MiB;
constexpr size_t WA_GU = 0, WA_DN = 11 * MiB;
constexpr int LDS_BYTES = 147456;
constexpr int NPHASE = 14;

struct Args {
    const float* in[21]; float* out; unsigned char* ws; float inv_freq[32]; int ph_lo, ph_hi;
};

__device__ __forceinline__ unsigned f2bf(float f) { unsigned u = __builtin_bit_cast(unsigned, f); return (u + 0x7fffu + ((u >> 16) & 1u)) >> 16; }
__device__ __forceinline__ unsigned pk2(float lo, float hi) { return f2bf(lo) | (f2bf(hi) << 16); }
__device__ __forceinline__ float bf2f(bf16 b) { return __uint_as_float((unsigned)b << 16); }
__device__ __forceinline__ float wave_sum(float v) {
#pragma unroll
    for (int o = 1; o < 64; o <<= 1) v += __shfl_xor(v, o);
    return v;
}

__device__ __forceinline__ void transpose_item(const float* W, int pitch, int src_col0, int K, bf16* WT, int dst_row0, int k0, LAS float* scr, int lane) {
#pragma unroll 8
    for (int i = 0; i < 32; ++i) { const int kk = 2 * i + (lane >> 5); scr[kk * 33 + (lane & 31)] = W[(size_t)(k0 + kk) * pitch + src_col0 + (lane & 31)]; }
    asm volatile("s_waitcnt lgkmcnt(0)" ::: "memory");
    const int c = lane & 7;
#pragma unroll
    for (int j = 0; j < 4; ++j) { const int n = (lane >> 3) + 8 * j; const LAS float* s = scr + (8 * c) * 33 + n;
        u32x4 o; o.x = pk2(s[0 * 33], s[1 * 33]); o.y = pk2(s[2 * 33], s[3 * 33]); o.z = pk2(s[4 * 33], s[5 * 33]); o.w = pk2(s[6 * 33], s[7 * 33]);
        *(u32x4*)(WT + (size_t)(dst_row0 + n) * K + k0 + 8 * c) = o; }
    asm volatile("s_waitcnt lgkmcnt(0)" ::: "memory");
}
__device__ __forceinline__ void convert_weight(const float* W, int pitch, int K, int nblk, bf16* WT, int mode, int gw, int NGW, LAS float* scr, int lane) {
    const int nitems = (K / 64) * nblk;
    for (int it = gw; it < nitems; it += NGW) {
        const int kb = it / nblk, nb = it % nblk; int src = 32 * nb, dst = 32 * nb;
        if (mode == 1) dst = 256 * (src >> 7) + (src & 127);
        else if (mode == 2) dst = 256 * (src >> 7) + (src & 127) + 128;
        else if (mode == 3) src = dst < 4608 ? dst : dst + 8;
        transpose_item(W, pitch, src, K, WT, dst, 64 * kb, scr, lane);
    }
}

__device__ __forceinline__ void norm_row(const float* xrow, const float* gain, bf16* orow, int lane, f32x4 (&v)[4]) {
    const f32x4* xr = (const f32x4*)xrow + lane; const f32x4* gr = (const f32x4*)gain + lane;
    float s = 0.f;
#pragma unroll
    for (int j = 0; j < 4; ++j) { v[j] = xr[64 * j]; s += (v[j].x * v[j].x + v[j].y * v[j].y) + (v[j].z * v[j].z + v[j].w * v[j].w); }
    const float rstd = 1.0f / sqrtf(wave_sum(s) * (1.0f / D) + RMS_EPS);
    unsigned long long* o8 = (unsigned long long*)orow + lane;
#pragma unroll
    for (int j = 0; j < 4; ++j) { const f32x4 g = gr[64 * j]; v[j] = v[j] * rstd * g;
        o8[64 * j] = (unsigned long long)pk2(v[j].x, v[j].y) | ((unsigned long long)pk2(v[j].z, v[j].w) << 32); }
}

__device__ __forceinline__ void attn_simple(bf16* z, const float* rope_cos, const float* rope_sin, const float* sinks, unsigned char* lds) {
    float* Kf = (float*)lds; float* Vf = Kf + 256 * 65;
    const int tid = threadIdx.x;
    for (int item = blockIdx.x; item < 1024; item += gridDim.x) {
        const int hk = item & 3, n = (item >> 2) & 63, b = item >> 8;
        const size_t tok0 = (size_t)b * SEQ + (size_t)n * 128;
        __syncthreads();
        for (int idx = tid; idx < 256 * 32; idx += 512) {
            const int key = idx >> 5, i = idx & 31;
            float k1 = 0.f, k2 = 0.f, v1 = 0.f, v2 = 0.f;
            if (n > 0 || key >= 128) {
                const bf16* zr = z + (tok0 + key - 128) * ZP;
                const float a = bf2f(zr[ZKA + hk * 64 + i]), c = bf2f(zr[ZKA + hk * 64 + i + 32]);
                const int pos = n * 128 + key - 128;
                const float cs = rope_cos[pos * 32 + i], sn = rope_sin[pos * 32 + i];
                k1 = a * cs - c * sn; k2 = c * cs + a * sn;
                v1 = bf2f(zr[ZVA + hk * 64 + i]); v2 = bf2f(zr[ZVA + hk * 64 + i + 32]);
            }
            Kf[key * 65 + i] = k1; Kf[key * 65 + i + 32] = k2; Vf[key * 65 + i] = v1; Vf[key * 65 + i + 32] = v2;
        }
        __syncthreads();
        const int g = tid >> 7, qi = tid & 127, head = hk * 4 + g;
        bf16* qrow = z + (tok0 + qi) * ZP + ZQA + head * 64; const int pos = n * 128 + qi;
        float q[64];
#pragma unroll
        for (int i = 0; i < 32; ++i) { const float a = bf2f(qrow[i]), c = bf2f(qrow[i + 32]); const float cs = rope_cos[pos * 32 + i], sn = rope_sin[pos * 32 + i];
            q[i] = (a * cs - c * sn) * 0.125f; q[i + 32] = (c * cs + a * sn) * 0.125f; }
        float m = sinks[head], l = 1.0f; float o[64];
#pragma unroll
        for (int d = 0; d < 64; ++d) o[d] = 0.f;
        int k_lo = qi + 1; const int k_hi = qi + 128; if (n == 0 && k_lo < 128) k_lo = 128;
        for (int kk = k_lo; kk <= k_hi; ++kk) {
            const float* kr = Kf + kk * 65; float s = 0.f;
#pragma unroll
            for (int d = 0; d < 64; ++d) s += q[d] * kr[d];
            const float mn = fmaxf(m, s), sc = __expf(m - mn), pe = __expf(s - mn);
            l = l * sc + pe; const float* vr = Vf + kk * 65;
#pragma unroll
            for (int d = 0; d < 64; ++d) o[d] = o[d] * sc + pe * vr[d];
            m = mn;
        }
        const float inv = 1.0f / l;
#pragma unroll
        for (int d = 0; d < 64; d += 2) *(unsigned*)(qrow + d) = pk2(o[d] * inv, o[d + 1] * inv);
    }
}

__device__ __forceinline__ void mlstm_recurrent(const bf16* z, const float* gates, const float* conv_w, const float* conv_b, bf16* hb, unsigned char* lds) {
    float* qc = (float*)lds; float* kc = qc + 64 * 128; float* vsl = kc + 64 * 128; float* igs = vsl + 64 * 16; float* lfs = igs + 64;
    const int tid = threadIdx.x;
    for (int item = blockIdx.x; item < 256; item += gridDim.x) {
        const int vs = item & 15, h = (item >> 4) & 3, b = item >> 6;
        const size_t tokb = (size_t)b * SEQ;
        const int ch2 = tid & 255, d = ch2 & 127, tg = tid >> 8; const bool isk = ch2 >= 128;
        const int cch = (isk ? 512 : 0) + h * 128 + d;
        const float w0 = conv_w[cch], w1 = conv_w[1024 + cch], w2 = conv_w[2048 + cch], w3 = conv_w[3072 + cch], cb = conv_b[cch];
        const int zcol = (isk ? ZKM : ZQM) + h * 128 + d;
        float* dst = isk ? kc : qc; const float scale = isk ? 0.08838834764831845f : 1.0f;
        const int vi = tid >> 5, dg = tid & 31;
        float C0 = 0.f, C1 = 0.f, C2 = 0.f, C3 = 0.f, n0 = 0.f, n1 = 0.f, n2 = 0.f, n3 = 0.f, m = 0.f;
        for (int ck = 0; ck < SEQ / 64; ++ck) {
            const int t0 = ck * 64;
            __syncthreads();
            {
                const int ts = t0 + tg * 32;
                const bf16* zc = z + tokb * ZP + zcol;
                float r0 = ts - 3 >= 0 ? bf2f(zc[(size_t)(ts - 3) * ZP]) : 0.f, r1 = ts - 2 >= 0 ? bf2f(zc[(size_t)(ts - 2) * ZP]) : 0.f, r2 = ts - 1 >= 0 ? bf2f(zc[(size_t)(ts - 1) * ZP]) : 0.f;
#pragma unroll 4
                for (int i = 0; i < 32; ++i) { const float r3 = bf2f(zc[(size_t)(ts + i) * ZP]); float y = w0 * r0 + w1 * r1 + w2 * r2 + w3 * r3 + cb; y = y / (1.0f + __expf(-y));
                    dst[(tg * 32 + i) * 128 + d] = y * scale; r0 = r1; r1 = r2; r2 = r3; }
            }
            for (int idx = tid; idx < 1024; idx += 512) { const int s = idx >> 4, j = idx & 15; vsl[idx] = bf2f(z[(tokb + t0 + s) * ZP + ZVM + h * 256 + vs * 16 + j]); }
            if (tid < 64) { igs[tid] = gates[(tokb + t0 + tid) * 8 + h]; lfs[tid] = gates[(tokb + t0 + tid) * 8 + 4 + h]; }
            __syncthreads();
#pragma unroll 4
            for (int s = 0; s < 64; ++s) {
                const float lf = lfs[s], ig = igs[s];
                const float mn = fmaxf(lf + m, ig), fs = __expf(lf + m - mn), is = __expf(ig - mn); m = mn;
                const f32x4 k4 = *(const f32x4*)(kc + s * 128 + 4 * dg), q4 = *(const f32x4*)(qc + s * 128 + 4 * dg);
                const float iv = is * vsl[s * 16 + vi];
                C0 = fs * C0 + iv * k4.x; C1 = fs * C1 + iv * k4.y; C2 = fs * C2 + iv * k4.z; C3 = fs * C3 + iv * k4.w;
                n0 = fs * n0 + is * k4.x; n1 = fs * n1 + is * k4.y; n2 = fs * n2 + is * k4.z; n3 = fs * n3 + is * k4.w;
                float pn = (C0 * q4.x + C1 * q4.y) + (C2 * q4.z + C3 * q4.w), pd = (n0 * q4.x + n1 * q4.y) + (n2 * q4.z + n3 * q4.w);
#pragma unroll
                for (int o = 1; o < 32; o <<= 1) { pn += __shfl_xor(pn, o); pd += __shfl_xor(pd, o); }
                const float hv = pn / fmaxf(fabsf(pd), __expf(-m));
                if (dg == 0) hb[(tokb + t0 + s) * 1024 + h * 256 + vs * 16 + vi] = (bf16)f2bf(hv);
            }
        }
    }
}


namespace mm {
typedef short bf16x8 __attribute__((ext_vector_type(8)));
typedef short s16x4 __attribute__((ext_vector_type(4)));
typedef short v4i16_t __attribute__((ext_vector_type(4)));
typedef float f32x16 __attribute__((ext_vector_type(16)));
typedef float f32x8 __attribute__((ext_vector_type(8)));
typedef __bf16 bfv8 __attribute__((ext_vector_type(8)));
#define MFMA32(a, b, c) __builtin_amdgcn_mfma_f32_32x32x16_bf16((a), (b), (c), 0, 0, 0)
constexpr int PQ = 272, PV = 528;
__device__ __forceinline__ s16x4 vtr(const LAS unsigned char* p) { return __builtin_bit_cast(s16x4, __builtin_amdgcn_ds_read_tr16_b64_v4i16((LAS v4i16_t*)p)); }
__device__ __forceinline__ bf16x8 rowread(const LAS unsigned char* img, int pitch, int r0, int k0, int lane) { return *(const LAS bf16x8*)(img + (r0 + (lane & 31)) * pitch + (k0 + 8 * (lane >> 5)) * 2); }
template <bool PERM> __device__ __forceinline__ bf16x8 trread(const LAS unsigned char* img, int pitch, int k0, int c0, int lane) {
    const int h = lane >> 5, blk = (lane >> 4) & 1, q = (lane & 15) >> 2, p = lane & 3;
    const int rlo = PERM ? k0 + 4 * h + q : k0 + 8 * h + q, rhi = PERM ? k0 + 8 + 4 * h + q : k0 + 8 * h + 4 + q;
    const int cb = (c0 + 16 * blk + 4 * p) * 2;
    const s16x4 lo = vtr(img + rlo * pitch + cb), hi = vtr(img + rhi * pitch + cb);
    return __builtin_shufflevector(lo, hi, 0, 1, 2, 3, 4, 5, 6, 7);
}
__device__ __forceinline__ bf16x8 pack8(const f32x16& x, int s) {
    f32x8 v;
#pragma unroll
    for (int j = 0; j < 8; ++j) v[j] = x[8 * s + j];
    return __builtin_bit_cast(bf16x8, __builtin_convertvector(v, bfv8));
}
__device__ __forceinline__ void stage_conv(LAS unsigned char* img, const bf16* z, size_t tokb, int t0, int zcol0, const float* cw, const float* cbias, float scale, int tid) {
    const int cg8 = (tid & 15) * 8, lr = tid >> 4;
    float w[4][8], bb[8];
#pragma unroll
    for (int j = 0; j < 4; ++j) { const f32x4 a = *(const f32x4*)(cw + j * 1024 + cg8), b = *(const f32x4*)(cw + j * 1024 + cg8 + 4); w[j][0] = a.x; w[j][1] = a.y; w[j][2] = a.z; w[j][3] = a.w; w[j][4] = b.x; w[j][5] = b.y; w[j][6] = b.z; w[j][7] = b.w; }
    { const f32x4 a = *(const f32x4*)(cbias + cg8), b = *(const f32x4*)(cbias + cg8 + 4); bb[0] = a.x; bb[1] = a.y; bb[2] = a.z; bb[3] = a.w; bb[4] = b.x; bb[5] = b.y; bb[6] = b.z; bb[7] = b.w; }
    float r[7][8];
#pragma unroll
    for (int jj = 0; jj < 7; ++jj) { const int t = t0 + 4 * lr - 3 + jj; u32x4 v = {0u, 0u, 0u, 0u};
        if (t >= 0) v = *(const u32x4*)(z + (tokb + t) * ZP + zcol0 + cg8);
        r[jj][0] = pg8::bf_lo(v.x); r[jj][1] = pg8::bf_hi(v.x); r[jj][2] = pg8::bf_lo(v.y); r[jj][3] = pg8::bf_hi(v.y); r[jj][4] = pg8::bf_lo(v.z); r[jj][5] = pg8::bf_hi(v.z); r[jj][6] = pg8::bf_lo(v.w); r[jj][7] = pg8::bf_hi(v.w); }
#pragma unroll
    for (int i = 0; i < 4; ++i) { float y[8];
#pragma unroll
        for (int e = 0; e < 8; ++e) { float s = w[0][e] * r[i][e] + w[1][e] * r[i + 1][e] + w[2][e] * r[i + 2][e] + w[3][e] * r[i + 3][e] + bb[e]; y[e] = s / (1.0f + __expf(-s)) * scale; }
        u32x4 o; o.x = pk2(y[0], y[1]); o.y = pk2(y[2], y[3]); o.z = pk2(y[4], y[5]); o.w = pk2(y[6], y[7]);
        *(LAS u32x4*)(img + (4 * lr + i) * PQ + cg8 * 2) = o; }
}
template <bool SCALE> __device__ __forceinline__ void stage_v(LAS unsigned char* img, const bf16* z, size_t tok0, int h, const LAS float* aa, int tid) {
    const int v8 = (tid & 31) * 8, l0 = tid >> 5;
#pragma unroll
    for (int i = 0; i < 8; ++i) { const int l = l0 + 16 * i; u32x4 v = *(const u32x4*)(z + (tok0 + l) * ZP + ZVM + h * 256 + v8);
        if (SCALE) { const float a = aa[l]; v.x = pk2(pg8::bf_lo(v.x) * a, pg8::bf_hi(v.x) * a); v.y = pk2(pg8::bf_lo(v.y) * a, pg8::bf_hi(v.y) * a); v.z = pk2(pg8::bf_lo(v.z) * a, pg8::bf_hi(v.z) * a); v.w = pk2(pg8::bf_lo(v.w) * a, pg8::bf_hi(v.w) * a); }
        *(LAS u32x4*)(img + l * PV + v8 * 2) = v; }
}
constexpr int OFF_K1 = 0, OFF_V1 = 34816, OFF_F1 = 34816 + 67584;
__device__ __forceinline__ void dc_item(const bf16* z, const float* gates, const float* conv_w, const float* conv_b, bf16* dC, float* dn, float* mloc, float* bend, int item, LAS unsigned char* L, int tid, int lane, int wave) {
    const int b = item >> 8, h = (item >> 6) & 3, c = item & 63;
    const size_t tokb = (size_t)b * SEQ, tok0 = tokb + (size_t)c * 128;
    LAS unsigned char* kimg = L + OFF_K1; LAS unsigned char* vimg = L + OFF_V1; LAS float* lf = (LAS float*)(L + OFF_F1); LAS float* ig = lf + 128; LAS float* bc = lf + 256; LAS float* aa = lf + 384;
    __syncthreads();
    if (tid < 128) { lf[tid] = gates[(tok0 + tid) * 8 + 4 + h]; ig[tid] = gates[(tok0 + tid) * 8 + h]; }
    stage_conv(kimg, z, tokb, c * 128, ZKM + h * 128, conv_w + 512 + h * 128, conv_b + 512 + h * 128, 0.08838834764831845f, tid);
    __syncthreads();
    if (tid < 128) { float s = 0.f; for (int j = 0; j <= tid; ++j) s += lf[j]; bc[tid] = s; }
    __syncthreads();
    const float be = bc[127];
    if (tid < 128) aa[tid] = be - bc[tid] + ig[tid];
    __syncthreads();
    float ml = -INFINITY;
    for (int j = 0; j < 128; j += 4) { const f32x4 t = *(const LAS f32x4*)(aa + j); ml = fmaxf(ml, fmaxf(fmaxf(t.x, t.y), fmaxf(t.z, t.w))); }
    __syncthreads();
    if (tid < 128) aa[tid] = __expf(aa[tid] - ml);
    __syncthreads();
    stage_v<true>(vimg, z, tok0, h, aa, tid);
    __syncthreads();
    f32x16 acc[4];
#pragma unroll
    for (int dt = 0; dt < 4; ++dt)
#pragma unroll
        for (int i = 0; i < 16; ++i) acc[dt][i] = 0.f;
#pragma unroll
    for (int ks = 0; ks < 8; ++ks) { const bf16x8 bv = trread<false>(vimg, PV, 16 * ks, 32 * wave, lane);
#pragma unroll
        for (int dt = 0; dt < 4; ++dt) { const bf16x8 ak = trread<false>(kimg, PQ, 16 * ks, 32 * dt, lane); acc[dt] = MFMA32(ak, bv, acc[dt]); } }
    if (tid < 128) { float s = 0.f; for (int l = 0; l < 128; ++l) s += aa[l] * bf2f(*(const LAS bf16*)(kimg + l * PQ + tid * 2)); dn[(size_t)item * 128 + tid] = s; }
    if (tid == 0) { mloc[item] = ml; bend[item] = be; }
    const int r = lane & 31, hh = lane >> 5;
    bf16* orow = dC + (size_t)item * 32768 + (size_t)(32 * wave + r) * 128;
#pragma unroll
    for (int dt = 0; dt < 4; ++dt)
#pragma unroll
        for (int g = 0; g < 4; ++g) { u32x2 o; o.x = pk2(acc[dt][4 * g], acc[dt][4 * g + 1]); o.y = pk2(acc[dt][4 * g + 2], acc[dt][4 * g + 3]); *(u32x2*)(orow + 32 * dt + 8 * g + 4 * hh) = o; }
}
__device__ __forceinline__ void scan_phase(bf16* dC, float* dn, const float* mloc, const float* bend, float* mprev, int G, int tid) {
    for (int gidx = blockIdx.x * 512 + tid; gidx < 16 * 8192; gidx += G * 512) {
        const int bh = gidx >> 13, e4 = gidx & 8191;
        bf16* base = dC + (size_t)bh * 64 * 32768 + (size_t)e4 * 4;
        float C0 = 0.f, C1 = 0.f, C2 = 0.f, C3 = 0.f, m = 0.f;
        for (int c0 = 0; c0 < 64; c0 += 8) {
            u32x2 ld[8];
#pragma unroll
            for (int k = 0; k < 8; ++k) { const int c = c0 + k; ld[k] = (u32x2){0u, 0u}; if (c < 63) ld[k] = *(const u32x2*)(base + (size_t)c * 32768); }
#pragma unroll
            for (int k = 0; k < 8; ++k) { const int c = c0 + k;
                u32x2 o; o.x = pk2(C0, C1); o.y = pk2(C2, C3); *(u32x2*)(base + (size_t)c * 32768) = o;
                if (e4 == 0) mprev[bh * 64 + c] = m;
                if (c < 63) { const float ml = mloc[bh * 64 + c], be = bend[bh * 64 + c]; const float mn = fmaxf(be + m, ml), so = __expf(be + m - mn), sn = __expf(ml - mn);
                    C0 = so * C0 + sn * pg8::bf_lo(ld[k].x); C1 = so * C1 + sn * pg8::bf_hi(ld[k].x); C2 = so * C2 + sn * pg8::bf_lo(ld[k].y); C3 = so * C3 + sn * pg8::bf_hi(ld[k].y); m = mn; } }
        }
        if (gidx < 16 * 128) {
            const int bh2 = gidx >> 7, d = gidx & 127; float n = 0.f, m2 = 0.f;
            for (int c = 0; c < 64; ++c) { float* p = dn + (size_t)(bh2 * 64 + c) * 128 + d; const float dv = (c < 63) ? *p : 0.f; *p = n;
                if (c < 63) { const float ml = mloc[bh2 * 64 + c], be = bend[bh2 * 64 + c]; const float mn = fmaxf(be + m2, ml); n = __expf(be + m2 - mn) * n + __expf(ml - mn) * dv; m2 = mn; } }
        }
    }
}
constexpr int OFF_Q3 = 0, OFF_K3 = 34816, OFF_V3 = 69632, OFF_F3 = 69632 + 67584;
__device__ __forceinline__ void out_item(bf16* z, const float* gates, const float* conv_w, const float* conv_b, const bf16* Cprev, const float* nprev, const float* mprev, const float* hn, int item, LAS unsigned char* L, int tid, int lane, int wave) {
    const int b = item >> 8, h = (item >> 6) & 3, c = item & 63;
    const size_t tokb = (size_t)b * SEQ, tok0 = tokb + (size_t)c * 128;
    LAS unsigned char* qimg = L + OFF_Q3; LAS unsigned char* kimg = L + OFF_K3; LAS unsigned char* vimg = L + OFF_V3;
    LAS float* lf = (LAS float*)(L + OFF_F3); LAS float* ig = lf + 128; LAS float* bc = lf + 256; LAS float* uu = lf + 384; LAS float* gm = lf + 512; LAS float* np = lf + 640; LAS float* part = lf + 768;
    __syncthreads();
    if (tid < 128) { lf[tid] = gates[(tok0 + tid) * 8 + 4 + h]; ig[tid] = gates[(tok0 + tid) * 8 + h]; np[tid] = nprev[(size_t)item * 128 + tid]; }
    stage_conv(qimg, z, tokb, c * 128, ZQM + h * 128, conv_w + h * 128, conv_b + h * 128, 1.0f, tid);
    stage_conv(kimg, z, tokb, c * 128, ZKM + h * 128, conv_w + 512 + h * 128, conv_b + 512 + h * 128, 0.08838834764831845f, tid);
    stage_v<false>(vimg, z, tok0, h, nullptr, tid);
    __syncthreads();
    if (tid < 128) { float s = 0.f; for (int j = 0; j <= tid; ++j) s += lf[j]; bc[tid] = s; uu[tid] = ig[tid] - s; }
    __syncthreads();
    if (tid < 128) { float mx = -INFINITY; for (int j = 0; j <= tid; ++j) mx = fmaxf(mx, uu[j]); gm[tid] = mx; }
    __syncthreads();
    const float mp = mprev[item];
    const int lw = wave & 3, vw = wave >> 2, r = lane & 31, hh = lane >> 5, l = 32 * lw + r;
    const float b_l = bc[l], mt = fmaxf(b_l + gm[l], b_l + mp), inter = __expf(b_l + mp - mt), e0 = b_l - mt;
    f32x16 S[4];
#pragma unroll
    for (int st = 0; st < 4; ++st)
#pragma unroll
        for (int i = 0; i < 16; ++i) S[st][i] = 0.f;
#pragma unroll
    for (int ks = 0; ks < 8; ++ks) { const bf16x8 bq = rowread(qimg, PQ, 32 * lw, 16 * ks, lane);
#pragma unroll
        for (int st = 0; st < 4; ++st) if (st <= lw) { const bf16x8 ak = rowread(kimg, PQ, 32 * st, 16 * ks, lane); S[st] = MFMA32(ak, bq, S[st]); } }
    float dsum = 0.f;
#pragma unroll
    for (int st = 0; st < 4; ++st) if (st <= lw) {
#pragma unroll
        for (int g = 0; g < 4; ++g) { const int s0 = 32 * st + 8 * g + 4 * hh; const f32x4 u4 = *(const LAS f32x4*)(uu + s0);
#pragma unroll
            for (int e = 0; e < 4; ++e) { const float w = (s0 + e <= l) ? __expf(e0 + u4[e]) : 0.f; const float v = S[st][4 * g + e] * w; S[st][4 * g + e] = v; dsum += v; } } }
    dsum += __shfl_xor(dsum, 32);
    bf16x8 fr[4][2];
#pragma unroll
    for (int st = 0; st < 4; ++st) { fr[st][0] = pack8(S[st], 0); fr[st][1] = pack8(S[st], 1); }
    float qn = 0.f;
#pragma unroll
    for (int d8 = 0; d8 < 8; ++d8) { const bf16x8 qf = *(const LAS bf16x8*)(qimg + l * PQ + (64 * hh + 8 * d8) * 2); const f32x4 na = *(const LAS f32x4*)(np + 64 * hh + 8 * d8), nb = *(const LAS f32x4*)(np + 64 * hh + 8 * d8 + 4);
        qn += bf2f((bf16)qf[0]) * na.x + bf2f((bf16)qf[1]) * na.y + bf2f((bf16)qf[2]) * na.z + bf2f((bf16)qf[3]) * na.w + bf2f((bf16)qf[4]) * nb.x + bf2f((bf16)qf[5]) * nb.y + bf2f((bf16)qf[6]) * nb.z + bf2f((bf16)qf[7]) * nb.w; }
    qn += __shfl_xor(qn, 32);
    const float den = dsum + inter * qn, rden = 1.0f / fmaxf(fabsf(den), __expf(-mt));
    f32x16 O[4];
#pragma unroll
    for (int vt = 0; vt < 4; ++vt)
#pragma unroll
        for (int i = 0; i < 16; ++i) O[vt][i] = 0.f;
    const bf16* cp = Cprev + (size_t)item * 32768 + (size_t)(128 * vw + r) * 128 + 8 * hh;
#pragma unroll
    for (int ks = 0; ks < 8; ++ks) { const bf16x8 bq = rowread(qimg, PQ, 32 * lw, 16 * ks, lane);
#pragma unroll
        for (int vt = 0; vt < 4; ++vt) { const bf16x8 ac = *(const bf16x8*)(cp + vt * 4096 + 16 * ks); O[vt] = MFMA32(ac, bq, O[vt]); } }
#pragma unroll
    for (int vt = 0; vt < 4; ++vt)
#pragma unroll
        for (int i = 0; i < 16; ++i) O[vt][i] *= inter;
#pragma unroll
    for (int st = 0; st < 4; ++st) if (st <= lw) {
#pragma unroll
        for (int s2 = 0; s2 < 2; ++s2)
#pragma unroll
            for (int vt = 0; vt < 4; ++vt) { const bf16x8 av = trread<true>(vimg, PV, 32 * st + 16 * s2, 128 * vw + 32 * vt, lane); O[vt] = MFMA32(av, fr[st][s2], O[vt]); } }
    float ss = 0.f;
#pragma unroll
    for (int vt = 0; vt < 4; ++vt)
#pragma unroll
        for (int i = 0; i < 16; ++i) { const float v = O[vt][i] * rden; O[vt][i] = v; ss += v * v; }
    ss += __shfl_xor(ss, 32);
    if (hh == 0) part[vw * 128 + l] = ss;
    __syncthreads();
    const float rstd = 1.0f / sqrtf((part[l] + part[128 + l]) * (1.0f / 256.0f) + RMS_EPS);
    bf16* orow = z + (tok0 + l) * ZP + ZOM + h * 256;
#pragma unroll
    for (int vt = 0; vt < 4; ++vt)
#pragma unroll
        for (int g = 0; g < 4; ++g) { const int v0 = 128 * vw + 32 * vt + 8 * g + 4 * hh; const u32x2 ow = *(const u32x2*)(orow + v0); const f32x4 gn = *(const f32x4*)(hn + h * 256 + v0);
            const float r0 = O[vt][4 * g] * rstd * gn.x / (1.0f + __expf(-pg8::bf_lo(ow.x))), r1 = O[vt][4 * g + 1] * rstd * gn.y / (1.0f + __expf(-pg8::bf_hi(ow.x)));
            const float r2 = O[vt][4 * g + 2] * rstd * gn.z / (1.0f + __expf(-pg8::bf_lo(ow.y))), r3 = O[vt][4 * g + 3] * rstd * gn.w / (1.0f + __expf(-pg8::bf_hi(ow.y)));
            u32x2 o; o.x = pk2(r0, r1); o.y = pk2(r2, r3); *(u32x2*)(orow + v0) = o; }
}
}

__global__ void __launch_bounds__(512, 2) mega_fwd(Args args) {
    extern __shared__ __attribute__((aligned(16))) unsigned char lds[];
    cg::grid_group grid = cg::this_grid();
    const int tid = threadIdx.x, lane = tid & 63, wave = __builtin_amdgcn_readfirstlane(tid >> 6);
    const int G = gridDim.x, gw = blockIdx.x * 8 + wave, NGW = G * 8;
    unsigned char* ws = args.ws;
    const float* x = args.in[0];
    float* out = args.out;
    bf16* WA = (bf16*)(ws + WS_WA); bf16* Wgu = (bf16*)(ws + WS_WA + WA_GU); bf16* Wdn = (bf16*)(ws + WS_WA + WA_DN);
    bf16* Watt = (bf16*)(ws + WS_WP); bf16* Wml = (bf16*)(ws + WS_WP + 2 * MiB); bf16* Wout = (bf16*)(ws + WS_WP + 4 * MiB);
    float* rope_cos = (float*)(ws + WS_ROPE); float* rope_sin = rope_cos + SEQ * 32;
    float* gates = (float*)(ws + WS_GATE);
    float* dnb = (float*)(ws + WS_MISC); float* mlocb = dnb + 1024 * 128; float* bendb = mlocb + 1024; float* mprevb = bendb + 1024;
    bf16* hA = (bf16*)(ws + WS_HA); bf16* Z = (bf16*)(ws + WS_Z); bf16* HID = (bf16*)(ws + WS_Z);
    LAS float* scr = (LAS float*)((LAS unsigned char*)lds + wave * 16384);
    const int lo = args.ph_lo, hi = args.ph_hi;
#define IN(k) (lo <= (k) && (k) < hi)
#define SEAM(k) do { if (IN(k) && IN((k) + 1)) grid.sync(); } while (0)

    if (IN(0)) {
        convert_weight(args.in[2], FF, D, FF / 32, Wgu, 1, gw, NGW, scr, lane);
        convert_weight(args.in[3], FF, D, FF / 32, Wgu, 2, gw, NGW, scr, lane);
        convert_weight(args.in[4], D, FF, D / 32, Wdn, 0, gw, NGW, scr, lane);
        convert_weight(args.in[13], D, D, D / 32, Watt, 0, gw, NGW, scr, lane);
        convert_weight(args.in[14], D, D, D / 32, Wml, 0, gw, NGW, scr, lane);
        convert_weight(args.in[15], D, D, D / 32, Wout, 0, gw, NGW, scr, lane);
        for (int idx = blockIdx.x * 512 + tid; idx < SEQ * 32; idx += G * 512) {
            const int pos = idx >> 5, i = idx & 31;
            const float angf = (float)pos * args.inv_freq[i];
            const double ang = (double)angf;
            const double kq = rint(ang * 0.63661977236758134308);
            const double y = (ang - kq * 1.57079632679489655800) - kq * 6.123233995736766e-17;
            const double y2 = y * y;
            const double sy = y * (1.0 + y2 * (-1.0 / 6 + y2 * (1.0 / 120 + y2 * (-1.0 / 5040 + y2 * (1.0 / 362880 + y2 * (-1.0 / 39916800 + y2 * (1.0 / 6227020800.0)))))));
            const double cy = 1.0 + y2 * (-0.5 + y2 * (1.0 / 24 + y2 * (-1.0 / 720 + y2 * (1.0 / 40320 + y2 * (-1.0 / 3628800 + y2 * (1.0 / 479001600.0 + y2 * (-1.0 / 87178291200.0)))))));
            const long long qi = (long long)kq; const int qd = (int)(qi & 3);
            const double sn = qd == 0 ? sy : qd == 1 ? cy : qd == 2 ? -sy : -cy;
            const double cs = qd == 0 ? cy : qd == 1 ? -sy : qd == 2 ? -cy : sy;
            rope_cos[idx] = (float)cs; rope_sin[idx] = (float)sn;
        }
        for (int r = gw; r < T; r += NGW) { f32x4 v[4]; norm_row(x + (size_t)r * D, args.in[1], hA + (size_t)r * D, lane, v); }
    }
    SEAM(0);
    if (IN(1)) {
        pg8::Gemm g{hA, hA, Wgu, Wgu, D, D}; pg8::StaticOrder S; S.init(T, NGU, G, (int)blockIdx.x);
        pg8::EpiSwiGLU E{HID, FF};
        pg8::gemm_phase<pg8::EpiSwiGLU, pg8::StaticOrder>((PG8_LAS unsigned char*)lds, g, S, E);
    }
    SEAM(1);
    if (IN(2)) {
        pg8::Gemm g{HID, HID, Wdn, Wdn, FF, FF}; pg8::StaticOrder S; S.init(T, D, G, (int)blockIdx.x);
        pg8::EpiResid E{x, out, D, 0.5f};
        pg8::gemm_phase<pg8::EpiResid, pg8::StaticOrder>((PG8_LAS unsigned char*)lds, g, S, E);
    }
    SEAM(2);
    if (IN(3)) {
        convert_weight(args.in[6], INW, D, ZP / 32, WA, 3, gw, NGW, scr, lane);
        const float* win = args.in[6];
        for (int r = gw; r < T; r += NGW) {
            f32x4 v[4]; norm_row(out + (size_t)r * D, args.in[5], hA + (size_t)r * D, lane, v);
            float gsum[8];
#pragma unroll
            for (int e = 0; e < 8; ++e) gsum[e] = 0.f;
#pragma unroll
            for (int j = 0; j < 4; ++j)
#pragma unroll
                for (int e = 0; e < 4; ++e) { const int k = 256 * j + 4 * lane + e; const f32x4 wa = *(const f32x4*)(win + (size_t)k * INW + 4608), wb = *(const f32x4*)(win + (size_t)k * INW + 4612); const float hv = v[j][e];
                    gsum[0] += hv * wa.x; gsum[1] += hv * wa.y; gsum[2] += hv * wa.z; gsum[3] += hv * wa.w; gsum[4] += hv * wb.x; gsum[5] += hv * wb.y; gsum[6] += hv * wb.z; gsum[7] += hv * wb.w; }
#pragma unroll
            for (int e = 0; e < 8; ++e) gsum[e] = wave_sum(gsum[e]);
            if (lane < 8) {
                float val = lane == 0 ? gsum[0] : lane == 1 ? gsum[1] : lane == 2 ? gsum[2] : lane == 3 ? gsum[3] : lane == 4 ? gsum[4] : lane == 5 ? gsum[5] : lane == 6 ? gsum[6] : gsum[7];
                if (lane < 4) val += args.in[7][lane];
                else { const float xx = val + args.in[8][lane - 4]; val = fminf(xx, 0.f) - log1pf(expf(-fabsf(xx))); }
                gates[(size_t)r * 8 + lane] = val;
            }
        }
    }
    SEAM(3);
    if (IN(4)) {
        pg8::Gemm g{hA, hA, WA, WA, D, D}; pg8::StaticOrder S; S.init(T, ZP, G, (int)blockIdx.x);
        pg8::EpiBf16 E{Z, ZP};
        pg8::gemm_phase<pg8::EpiBf16, pg8::StaticOrder>((PG8_LAS unsigned char*)lds, g, S, E);
    }
    SEAM(4);
    if (IN(5)) {
        for (int it = blockIdx.x; it < 1024; it += G) if ((it & 63) != 63) mm::dc_item(Z, gates, args.in[10], args.in[11], hA, dnb, mlocb, bendb, it, (LAS unsigned char*)lds, tid, lane, wave);
        attn_simple(Z, rope_cos, rope_sin, args.in[9], lds);
    }
    SEAM(5);
    if (IN(6)) {
        __syncthreads();
        mm::scan_phase(hA, dnb, mlocb, bendb, mprevb, G, tid);
        convert_weight(args.in[17], FF, D, FF / 32, Wgu, 1, gw, NGW, scr, lane);
        convert_weight(args.in[18], FF, D, FF / 32, Wgu, 2, gw, NGW, scr, lane);
        convert_weight(args.in[19], D, FF, D / 32, Wdn, 0, gw, NGW, scr, lane);
    }
    SEAM(6);
    if (IN(7)) {
        for (int it = blockIdx.x; it < 1024; it += G) mm::out_item(Z, gates, args.in[10], args.in[11], hA, dnb, mprevb, args.in[12], it, (LAS unsigned char*)lds, tid, lane, wave);
    }
    SEAM(7);
    if (IN(8)) {
        pg8::Gemm g{Z + ZQA, Z + ZOM, Watt, Wml, ZP, D}; pg8::PairOrder S; S.so.init(T, D, G, (int)blockIdx.x);
        pg8::EpiMix E{Z, Z + ZQM, ZP, ZGA, ZGM};
        pg8::gemm_phase<pg8::EpiMix, pg8::PairOrder>((PG8_LAS unsigned char*)lds, g, S, E);
    }
    SEAM(8);
    if (IN(9)) {
        pg8::Gemm g{Z + ZQM, Z + ZQM, Wout, Wout, ZP, D}; pg8::StaticOrder S; S.init(T, D, G, (int)blockIdx.x);
        pg8::EpiResid E{out, out, D, 1.0f};
        pg8::gemm_phase<pg8::EpiResid, pg8::StaticOrder>((PG8_LAS unsigned char*)lds, g, S, E);
    }
    SEAM(9);
    if (IN(10)) {
        for (int r = gw; r < T; r += NGW) { f32x4 v[4]; norm_row(out + (size_t)r * D, args.in[16], hA + (size_t)r * D, lane, v); }
    }
    SEAM(10);
    if (IN(11)) {
        pg8::Gemm g{hA, hA, Wgu, Wgu, D, D}; pg8::StaticOrder S; S.init(T, NGU, G, (int)blockIdx.x);
        pg8::EpiSwiGLU E{HID, FF};
        pg8::gemm_phase<pg8::EpiSwiGLU, pg8::StaticOrder>((PG8_LAS unsigned char*)lds, g, S, E);
    }
    SEAM(11);
    if (IN(12)) {
        pg8::Gemm g{HID, HID, Wdn, Wdn, FF, FF}; pg8::StaticOrder S; S.init(T, D, G, (int)blockIdx.x);
        pg8::EpiResid E{out, out, D, 0.5f};
        pg8::gemm_phase<pg8::EpiResid, pg8::StaticOrder>((PG8_LAS unsigned char*)lds, g, S, E);
    }
    SEAM(12);
    if (IN(13)) {
        const float* gain = args.in[20];
        for (int r = gw; r < T; r += NGW) {
            f32x4* xr = (f32x4*)(out + (size_t)r * D) + lane; const f32x4* gr = (const f32x4*)gain + lane;
            f32x4 v[4]; float s = 0.f;
#pragma unroll
            for (int j = 0; j < 4; ++j) { v[j] = xr[64 * j]; s += (v[j].x * v[j].x + v[j].y * v[j].y) + (v[j].z * v[j].z + v[j].w * v[j].w); }
            const float rstd = 1.0f / sqrtf(wave_sum(s) * (1.0f / D) + RMS_EPS);
#pragma unroll
            for (int j = 0; j < 4; ++j) xr[64 * j] = v[j] * rstd * gr[64 * j];
        }
    }
#undef IN
#undef SEAM
}

extern "C" void kernel_launch(void* const* d_in, const int* in_sizes, int n_in, void* d_out, int out_size, void* d_ws, size_t ws_size, hipStream_t stream) {
    static int grid = 0;
    if (grid == 0) {
        if (n_in != 21 || out_size != T * D || ws_size < WS_END) { fprintf(stderr, "kernel_launch: unexpected shapes (n_in %d out %d ws %zu)\n", n_in, out_size, ws_size); grid = -1; return; }
        int dev = 0, cus = 0, per_cu = 0;
        hipGetDevice(&dev); hipDeviceGetAttribute(&cus, hipDeviceAttributeMultiprocessorCount, dev);
        if (hipFuncSetAttribute((const void*)mega_fwd, hipFuncAttributeMaxDynamicSharedMemorySize, LDS_BYTES) != hipSuccess) { fprintf(stderr, "kernel_launch: hipFuncSetAttribute failed\n"); grid = -1; return; }
        if (hipOccupancyMaxActiveBlocksPerMultiprocessor(&per_cu, (const void*)mega_fwd, 512, LDS_BYTES) != hipSuccess || per_cu < 1) { fprintf(stderr, "kernel_launch: occupancy query failed (%d)\n", per_cu); per_cu = 1; }
        (void)hipGetLastError();
        grid = cus * per_cu;
    }
    if (grid < 0) return;
    Args a{};
    for (int i = 0; i < 21; ++i) a.in[i] = (const float*)d_in[i];
    a.out = (float*)d_out; a.ws = (unsigned char*)d_ws;
    for (int i = 0; i < 32; ++i) a.inv_freq[i] = (float)pow(10000.0, -(double)i / 32.0);
#if MK_PER_PHASE_LAUNCH
    for (int ph = 0; ph < NPHASE; ++ph) { a.ph_lo = ph; a.ph_hi = ph + 1; hipLaunchKernelGGL(mega_fwd, dim3(grid), dim3(512), LDS_BYTES, stream, a); }
#else
    a.ph_lo = 0; a.ph_hi = NPHASE;
    void* kargs[] = {&a};
    hipError_t e = hipLaunchCooperativeKernel((const void*)mega_fwd, dim3(grid), dim3(512), kargs, LDS_BYTES, stream);
    if (e != hipSuccess) fprintf(stderr, "kernel_launch: cooperative launch failed: %s (grid %d)\n", hipGetErrorString(e), grid);
#endif
}
```

```cpp
#include <hip/hip_runtime.h>
#include <hip/hip_cooperative_groups.h>
#include <cstdio>
#include <cstdint>
#include <cmath>
namespace cg = cooperative_groups;

#ifndef MK_PER_PHASE_LAUNCH
#define MK_PER_PHASE_LAUNCH 0
#endif

namespace pg8 {
#define PG8_LAS __attribute__((address_space(3)))
typedef unsigned short bf16_t;
typedef short bf16x8 __attribute__((ext_vector_type(8)));
typedef float f32x4 __attribute__((ext_vector_type(4)));
typedef unsigned u32x4 __attribute__((ext_vector_type(4)));
constexpr int BM = 256, BK = 64, HALF = 128, HTB = HALF * BK * 2, STAGE_BYTES = 8 * HTB, NXCD = 8, WGM = 8;

__host__ __device__ __forceinline__ int lds_byte(int r, int c) { const int st = (r >> 4) * 2 + (c >> 5), rr = r & 15, cc = c & 31, ob = rr * 64 + cc * 2; return st * 1024 + (ob ^ (((ob >> 9) & 1) << 5)); }
__host__ __device__ __forceinline__ void stage_rc(int b, int& R, int& C) { const int st = b / 1024, sb = b % 1024, swz = sb ^ (((sb >> 9) & 1) << 5); R = (st >> 1) * 16 + swz / 64; C = (st & 1) * 32 + (swz % 64) / 2; }
__host__ __device__ __forceinline__ int perm32(int rho) { const int n = rho >> 4, i = rho & 15; return 8 * (i >> 2) + 4 * n + (i & 3); }

struct Unit { int pm, pn, kind; };
struct Gemm { const bf16_t* A0; const bf16_t* A1; const bf16_t* B0; const bf16_t* B1; int lda, K; };

struct StaticOrder {
    int nM, nN, nwg, G, c;
    __host__ __device__ void init(int M, int N, int G_, int c_) { nM = M / BM; nN = N / BM; nwg = nM * nN; G = G_; c = c_; }
    __host__ __device__ bool next(int i, Unit& u) const {
        const long L = (long)i * G + c; if (L >= nwg) return false;
        int wgid = (int)L; { const int q = nwg / NXCD, r = nwg % NXCD, xcd = wgid % NXCD, off = wgid / NXCD; wgid = (xcd < r ? xcd * (q + 1) : r * (q + 1) + (xcd - r) * q) + off; }
        const int nig = WGM * nN, gid = wgid / nig, fm = gid * WGM, gsz = (nM - fm) < WGM ? (nM - fm) : WGM;
        u.pm = fm + ((wgid % nig) % gsz); u.pn = (wgid % nig) / gsz; u.kind = 0; return true;
    }
};
struct PairOrder {
    StaticOrder so;
    __host__ __device__ bool next(int i, Unit& u) const { if (!so.next(i >> 1, u)) return false; u.kind = i & 1; return true; }
};

__device__ __forceinline__ unsigned cvt_pk_bf16(float lo, float hi) { unsigned r; asm volatile("v_cvt_pk_bf16_f32 %0, %1, %2" : "=v"(r) : "v"(lo), "v"(hi)); return r; }
__device__ __forceinline__ float bf_lo(unsigned w) { return __uint_as_float(w << 16); }
__device__ __forceinline__ float bf_hi(unsigned w) { return __uint_as_float(w & 0xffff0000u); }
__device__ __forceinline__ float sigmoid_den(float x) { return 1.0f + __expf(-x); }


struct EpiBf16 {
    bf16_t* O; int ldc;
    __device__ __forceinline__ bool operator()(f32x4 (&acc)[2][2][4][2], const Unit& u, int wr, int wc, int fr, int fq) const {
        const int row0 = u.pm * BM + wr * 64 + fr, col0 = u.pn * BM + wc * 32 + 8 * fq;
#pragma unroll
        for (int ai = 0; ai < 2; ++ai)
#pragma unroll
            for (int m = 0; m < 4; ++m) { bf16_t* rowp = O + (size_t)(row0 + ai * HALF + m * 16) * ldc + col0;
#pragma unroll
                for (int bj = 0; bj < 2; ++bj) { const f32x4 v0 = acc[ai][bj][m][0], v1 = acc[ai][bj][m][1];
                    u32x4 w; w.x = cvt_pk_bf16(v0[0], v0[1]); w.y = cvt_pk_bf16(v0[2], v0[3]); w.z = cvt_pk_bf16(v1[0], v1[1]); w.w = cvt_pk_bf16(v1[2], v1[3]);
                    *(u32x4*)(rowp + bj * HALF) = w; } }
        return true;
    }
};
struct EpiSwiGLU {
    bf16_t* O; int ldc;
    __device__ __forceinline__ bool operator()(f32x4 (&acc)[2][2][4][2], const Unit& u, int wr, int wc, int fr, int fq) const {
        const int row0 = u.pm * BM + wr * 64 + fr, col0 = u.pn * HALF + wc * 32 + 8 * fq;
#pragma unroll
        for (int ai = 0; ai < 2; ++ai)
#pragma unroll
            for (int m = 0; m < 4; ++m) { bf16_t* rowp = O + (size_t)(row0 + ai * HALF + m * 16) * ldc + col0;
                float r[8];
#pragma unroll
                for (int n = 0; n < 2; ++n)
#pragma unroll
                    for (int e = 0; e < 4; ++e) { const float g = acc[ai][0][m][n][e], up = acc[ai][1][m][n][e]; r[4 * n + e] = g * __builtin_amdgcn_rcpf(1.0f + __expf(-g)) * up; }
                u32x4 w; w.x = cvt_pk_bf16(r[0], r[1]); w.y = cvt_pk_bf16(r[2], r[3]); w.z = cvt_pk_bf16(r[4], r[5]); w.w = cvt_pk_bf16(r[6], r[7]);
                *(u32x4*)rowp = w; }
        return true;
    }
};
struct EpiResid {
    const float* base; float* out; int ldc; float alpha;
    __device__ __forceinline__ bool operator()(f32x4 (&acc)[2][2][4][2], const Unit& u, int wr, int wc, int fr, int fq) const {
        const int row0 = u.pm * BM + wr * 64 + fr, col0 = u.pn * BM + wc * 32 + 8 * fq;
#pragma unroll
        for (int ai = 0; ai < 2; ++ai)
#pragma unroll
            for (int m = 0; m < 4; ++m) { const size_t off = (size_t)(row0 + ai * HALF + m * 16) * ldc + col0;
#pragma unroll
                for (int bj = 0; bj < 2; ++bj)
#pragma unroll
                    for (int n = 0; n < 2; ++n) { const f32x4 b = *(const f32x4*)(base + off + bj * HALF + 4 * n); *(f32x4*)(out + off + bj * HALF + 4 * n) = b + acc[ai][bj][m][n] * alpha; } }
        return true;
    }
};
struct EpiMix {
    const bf16_t* Z; bf16_t* Y; int ldz; int cga, cgm;
    __device__ __forceinline__ bool operator()(f32x4 (&acc)[2][2][4][2], const Unit& u, int wr, int wc, int fr, int fq) const {
        const int row0 = u.pm * BM + wr * 64 + fr, col0 = u.pn * BM + wc * 32 + 8 * fq;
#pragma unroll
        for (int ai = 0; ai < 2; ++ai)
#pragma unroll
            for (int m = 0; m < 4; ++m) { const size_t off = (size_t)(row0 + ai * HALF + m * 16) * ldz + col0;
#pragma unroll
                for (int bj = 0; bj < 2; ++bj) {
                    const u32x4 gm = *(const u32x4*)(Z + off + cgm + bj * HALF);
                    float dm[8] = {sigmoid_den(bf_lo(gm.x)), sigmoid_den(bf_hi(gm.x)), sigmoid_den(bf_lo(gm.y)), sigmoid_den(bf_hi(gm.y)), sigmoid_den(bf_lo(gm.z)), sigmoid_den(bf_hi(gm.z)), sigmoid_den(bf_lo(gm.w)), sigmoid_den(bf_hi(gm.w))};
                    if (u.kind == 0) {
                        const u32x4 ga = *(const u32x4*)(Z + off + cga + bj * HALF);
                        float da[8] = {sigmoid_den(bf_lo(ga.x)), sigmoid_den(bf_hi(ga.x)), sigmoid_den(bf_lo(ga.y)), sigmoid_den(bf_hi(ga.y)), sigmoid_den(bf_lo(ga.z)), sigmoid_den(bf_hi(ga.z)), sigmoid_den(bf_lo(ga.w)), sigmoid_den(bf_hi(ga.w))};
#pragma unroll
                        for (int n = 0; n < 2; ++n)
#pragma unroll
                            for (int e = 0; e < 4; ++e) acc[ai][bj][m][n][e] *= dm[4 * n + e] / da[4 * n + e];
                    } else {
                        float r[8];
#pragma unroll
                        for (int n = 0; n < 2; ++n)
#pragma unroll
                            for (int e = 0; e < 4; ++e) r[4 * n + e] = acc[ai][bj][m][n][e] / dm[4 * n + e];
                        u32x4 w; w.x = cvt_pk_bf16(r[0], r[1]); w.y = cvt_pk_bf16(r[2], r[3]); w.z = cvt_pk_bf16(r[4], r[5]); w.w = cvt_pk_bf16(r[6], r[7]);
                        *(u32x4*)(Y + off + bj * HALF) = w;
                    }
                } }
        return u.kind != 0;
    }
};

template <class Epi, class Sched>
__device__ __forceinline__ void gemm_phase(PG8_LAS unsigned char* lds, const Gemm g, const Sched& S, const Epi& E) {
    const int tid = threadIdx.x, wid = __builtin_amdgcn_readfirstlane(tid >> 6), lane = tid & 63, wr = wid >> 2, wc = wid & 3, fr = lane & 15, fq = lane >> 4;
    const int K = g.K, nt = K / BK, lda = g.lda;
    unsigned voffA[2], voffB[2];
#pragma unroll
    for (int i = 0; i < 2; ++i) { int R, C; stage_rc(tid * 16 + i * 8192, R, C); const int Rb = (R & ~31) + perm32(R & 31);
        voffA[i] = (unsigned)(R * lda + C) * 2u; voffB[i] = (unsigned)(Rb * K + C) * 2u; }
    const size_t kstep = (size_t)(BK * 2);
    const size_t hstepA = (size_t)HALF * lda * 2, hstepB = (size_t)HALF * K * 2;
    const size_t tstepA = 2 * hstepA, tstepB = 2 * hstepB;
    const unsigned ldsw = (unsigned)wid * 1024u;
    const int aoff = lds_byte(wr * 64 + fr, fq * 8), boff = lds_byte(wc * 32 + fr, fq * 8);
#define PG8_SA(b, h) (((b) * 2 + (h)) * HTB)
#define PG8_SB(b, h) ((4 + (b) * 2 + (h)) * HTB)
#define PG8_STAGE(bufoff, gbase, voff) do { _Pragma("unroll") for (int _i = 0; _i < 2; ++_i) \
        __builtin_amdgcn_global_load_lds((const unsigned*)((const char*)(gbase) + (voff)[_i]), (PG8_LAS unsigned*)(lds + (bufoff) + ldsw + _i * 8192), 16, 0, 0); } while (0)
#define PG8_LDA(dst, b, h) do { _Pragma("unroll") for (int m = 0; m < 4; ++m) _Pragma("unroll") for (int k = 0; k < 2; ++k) dst[m][k] = *(const PG8_LAS bf16x8*)(lds + PG8_SA(b, h) + aoff + m * 2048 + k * 1024); } while (0)
#define PG8_LDB(dst, b, h) do { _Pragma("unroll") for (int n = 0; n < 2; ++n) _Pragma("unroll") for (int k = 0; k < 2; ++k) dst[n][k] = *(const PG8_LAS bf16x8*)(lds + PG8_SB(b, h) + boff + n * 2048 + k * 1024); } while (0)
#define PG8_MMA(ai, bj, At, Bt) do { __builtin_amdgcn_s_setprio(1); _Pragma("unroll") for (int m = 0; m < 4; ++m) _Pragma("unroll") for (int n = 0; n < 2; ++n) _Pragma("unroll") for (int k = 0; k < 2; ++k) \
        acc[ai][bj][m][n] = __builtin_amdgcn_mfma_f32_16x16x32_bf16(Bt[n][k], At[m][k], acc[ai][bj][m][n], 0, 0, 0); __builtin_amdgcn_s_setprio(0); } while (0)
#define PG8_WAIT_V(n) asm volatile("s_waitcnt vmcnt(" #n ")" ::: "memory")
#define PG8_WAIT_L(n) asm volatile("s_waitcnt lgkmcnt(" #n ")" ::: "memory")
#define PG8_BAR __builtin_amdgcn_s_barrier()
#define PG8_SCHED __builtin_amdgcn_sched_barrier(0)
    Unit cur, nxt; int ui = 0;
    if (!S.next(0, cur)) return;
    f32x4 acc[2][2][4][2];
#pragma unroll
    for (int a = 0; a < 2; ++a)
#pragma unroll
        for (int b = 0; b < 2; ++b)
#pragma unroll
            for (int m = 0; m < 4; ++m)
#pragma unroll
                for (int n = 0; n < 2; ++n) acc[a][b][m][n] = (f32x4){0.f, 0.f, 0.f, 0.f};
    bf16x8 At[4][2], B0[2][2], B1[2][2];
    const char* cA = (const char*)(cur.kind ? g.A1 : g.A0) + (size_t)cur.pm * tstepA; const char* cB = (const char*)(cur.kind ? g.B1 : g.B0) + (size_t)cur.pn * tstepB;
    PG8_STAGE(PG8_SB(0, 0), cB, voffB); PG8_STAGE(PG8_SB(0, 1), cB + hstepB, voffB); PG8_STAGE(PG8_SA(0, 0), cA, voffA); PG8_STAGE(PG8_SA(0, 1), cA + hstepA, voffA);
    if (wr == 1) PG8_BAR;
    PG8_WAIT_V(2); PG8_BAR;
    PG8_STAGE(PG8_SB(1, 0), cB + kstep, voffB); PG8_STAGE(PG8_SA(1, 0), cA + kstep, voffA); PG8_STAGE(PG8_SB(1, 1), cB + hstepB + kstep, voffB);
    PG8_WAIT_V(6); PG8_BAR;
    for (;;) {
        const bool has_next = S.next(ui + 1, nxt);
        const char* nA = has_next ? (const char*)(nxt.kind ? g.A1 : g.A0) + (size_t)nxt.pm * tstepA : cA; const char* nB = has_next ? (const char*)(nxt.kind ? g.B1 : g.B0) + (size_t)nxt.pn * tstepB : cB;
        for (int t = 0; t < nt; t += 2) {
            const bool last = (t == nt - 2);
            const char* a1 = cA + (size_t)(t + 1) * kstep;
            const char* a2 = last ? nA : cA + (size_t)(t + 2) * kstep; const char* b2 = last ? nB : cB + (size_t)(t + 2) * kstep;
            const char* a3 = a2 + kstep; const char* b3 = b2 + kstep;
            PG8_LDB(B0, 0, 0); PG8_LDB(B1, 0, 1); PG8_SCHED; PG8_LDA(At, 0, 0); PG8_STAGE(PG8_SA(1, 1), a1 + hstepA, voffA);
            PG8_WAIT_V(8); PG8_WAIT_L(0); PG8_BAR; PG8_MMA(0, 0, At, B0); PG8_MMA(0, 1, At, B1); PG8_BAR; PG8_SCHED;
            PG8_LDA(At, 0, 1); PG8_STAGE(PG8_SB(0, 0), b2, voffB); PG8_STAGE(PG8_SB(0, 1), b2 + hstepB, voffB); PG8_STAGE(PG8_SA(0, 0), a2, voffA);
            PG8_WAIT_V(8); PG8_WAIT_L(0); PG8_BAR; PG8_MMA(1, 0, At, B0); PG8_MMA(1, 1, At, B1); PG8_BAR; PG8_SCHED;
            PG8_LDB(B0, 1, 0); PG8_LDB(B1, 1, 1); PG8_SCHED; PG8_LDA(At, 1, 0); PG8_STAGE(PG8_SA(0, 1), a2 + hstepA, voffA);
            PG8_WAIT_V(8); PG8_WAIT_L(0); PG8_BAR; PG8_MMA(0, 0, At, B0); PG8_MMA(0, 1, At, B1); PG8_BAR; PG8_SCHED;
            PG8_LDA(At, 1, 1); PG8_STAGE(PG8_SB(1, 0), b3, voffB); PG8_STAGE(PG8_SB(1, 1), b3 + hstepB, voffB); PG8_STAGE(PG8_SA(1, 0), a3, voffA);
            PG8_WAIT_V(8); PG8_WAIT_L(0); PG8_BAR; PG8_MMA(1, 0, At, B0); PG8_MMA(1, 1, At, B1); PG8_BAR; PG8_SCHED;
        }
        if (wr == 0) PG8_BAR;
        const bool zero = E(acc, cur, wr, wc, fr, fq);
        if (!has_next) break;
        if (zero) {
#pragma unroll
            for (int a = 0; a < 2; ++a)
#pragma unroll
                for (int b = 0; b < 2; ++b)
#pragma unroll
                    for (int m = 0; m < 4; ++m)
#pragma unroll
                        for (int n = 0; n < 2; ++n) acc[a][b][m][n] = (f32x4){0.f, 0.f, 0.f, 0.f};
        }
        cur = nxt; cA = nA; cB = nB; ++ui;
        if (wr == 1) PG8_BAR;
    }
    PG8_WAIT_V(0);
    PG8_BAR;
#undef PG8_SA
#undef PG8_SB
#undef PG8_STAGE
#undef PG8_LDA
#undef PG8_LDB
#undef PG8_MMA
#undef PG8_WAIT_V
#undef PG8_WAIT_L
#undef PG8_BAR
#undef PG8_SCHED
}
}

typedef unsigned short bf16;
typedef float f32x4 __attribute__((ext_vector_type(4)));
typedef unsigned u32x4 __attribute__((ext_vector_type(4)));
typedef unsigned u32x2 __attribute__((ext_vector_type(2)));
#define LAS __attribute__((address_space(3)))

constexpr int BATCH = 4, SEQ = 8192, T = BATCH * SEQ, D = 1024, FF = 2816, NGU = 2 * FF, ZP = 6656, INW = 6664;
constexpr int ZQA = 0, ZKA = 1024, ZVA = 1280, ZQM = 1536, ZKM = 2048, ZVM = 2560, ZOM = 3584, ZGA = 4608, ZGM = 5632;
constexpr float RMS_EPS = 1e-5f;
constexpr size_t MiB = (size_t)1 << 20;
constexpr size_t WS_WA = 0, WS_WP = 17 * MiB, WS_ROPE = 23 * MiB, WS_GATE = 25 * MiB, WS_MISC = 26 * MiB, WS_HA = 28 * MiB, WS_Z = 92 * MiB, WS_END = 508 * MiB;
constexpr size_t WA_GU = 0, WA_DN = 11 * MiB;
constexpr int LDS_BYTES = 147456;
constexpr int NPHASE = 14;

struct Args {
    const float* in[21]; float* out; unsigned char* ws; float inv_freq[32]; int ph_lo, ph_hi;
};

__device__ __forceinline__ unsigned f2bf(float f) { unsigned u = __builtin_bit_cast(unsigned, f); return (u + 0x7fffu + ((u >> 16) & 1u)) >> 16; }
__device__ __forceinline__ unsigned pk2(float lo, float hi) { return f2bf(lo) | (f2bf(hi) << 16); }
__device__ __forceinline__ float bf2f(bf16 b) { return __uint_as_float((unsigned)b << 16); }
__device__ __forceinline__ float wave_sum(float v) {
#pragma unroll
    for (int o = 1; o < 64; o <<= 1) v += __shfl_xor(v, o);
    return v;
}

__device__ __forceinline__ void transpose_item(const float* W, int pitch, int src_col0, int K, bf16* WT, int dst_row0, int k0, LAS float* scr, int lane) {
#pragma unroll 8
    for (int i = 0; i < 32; ++i) { const int kk = 2 * i + (lane >> 5); scr[kk * 33 + (lane & 31)] = W[(size_t)(k0 + kk) * pitch + src_col0 + (lane & 31)]; }
    asm volatile("s_waitcnt lgkmcnt(0)" ::: "memory");
    const int c = lane & 7;
#pragma unroll
    for (int j = 0; j < 4; ++j) { const int n = (lane >> 3) + 8 * j; const LAS float* s = scr + (8 * c) * 33 + n;
        u32x4 o; o.x = pk2(s[0 * 33], s[1 * 33]); o.y = pk2(s[2 * 33], s[3 * 33]); o.z = pk2(s[4 * 33], s[5 * 33]); o.w = pk2(s[6 * 33], s[7 * 33]);
        *(u32x4*)(WT + (size_t)(dst_row0 + n) * K + k0 + 8 * c) = o; }
    asm volatile("s_waitcnt lgkmcnt(0)" ::: "memory");
}
__device__ __forceinline__ void convert_weight(const float* W, int pitch, int K, int nblk, bf16* WT, int mode, int gw, int NGW, LAS float* scr, int lane) {
    const int nitems = (K / 64) * nblk;
    for (int it = gw; it < nitems; it += NGW) {
        const int kb = it / nblk, nb = it % nblk; int src = 32 * nb, dst = 32 * nb;
        if (mode == 1) dst = 256 * (src >> 7) + (src & 127);
        else if (mode == 2) dst = 256 * (src >> 7) + (src & 127) + 128;
        else if (mode == 3) src = dst < 4608 ? dst : dst + 8;
        transpose_item(W, pitch, src, K, WT, dst, 64 * kb, scr, lane);
    }
}

__device__ __forceinline__ void norm_row(const float* xrow, const float* gain, bf16* orow, int lane, f32x4 (&v)[4]) {
    const f32x4* xr = (const f32x4*)xrow + lane; const f32x4* gr = (const f32x4*)gain + lane;
    float s = 0.f;
#pragma unroll
    for (int j = 0; j < 4; ++j) { v[j] = xr[64 * j]; s += (v[j].x * v[j].x + v[j].y * v[j].y) + (v[j].z * v[j].z + v[j].w * v[j].w); }
    const float rstd = 1.0f / sqrtf(wave_sum(s) * (1.0f / D) + RMS_EPS);
    unsigned long long* o8 = (unsigned long long*)orow + lane;
#pragma unroll
    for (int j = 0; j < 4; ++j) { const f32x4 g = gr[64 * j]; v[j] = v[j] * rstd * g;
        o8[64 * j] = (unsigned long long)pk2(v[j].x, v[j].y) | ((unsigned long long)pk2(v[j].z, v[j].w) << 32); }
}

namespace mm {
typedef short bf16x8 __attribute__((ext_vector_type(8)));
typedef short s16x4 __attribute__((ext_vector_type(4)));
typedef short v4i16_t __attribute__((ext_vector_type(4)));
typedef float f32x16 __attribute__((ext_vector_type(16)));
typedef float f32x8 __attribute__((ext_vector_type(8)));
typedef __bf16 bfv8 __attribute__((ext_vector_type(8)));
#define MFMA32(a, b, c) __builtin_amdgcn_mfma_f32_32x32x16_bf16((a), (b), (c), 0, 0, 0)
constexpr int PQ = 272, PV = 528;
__device__ __forceinline__ s16x4 vtr(const LAS unsigned char* p) { return __builtin_bit_cast(s16x4, __builtin_amdgcn_ds_read_tr16_b64_v4i16((LAS v4i16_t*)p)); }
__device__ __forceinline__ bf16x8 rowread(const LAS unsigned char* img, int pitch, int r0, int k0, int lane) { return *(const LAS bf16x8*)(img + (r0 + (lane & 31)) * pitch + (k0 + 8 * (lane >> 5)) * 2); }
template <bool PERM> __device__ __forceinline__ bf16x8 trread(const LAS unsigned char* img, int pitch, int k0, int c0, int lane) {
    const int h = lane >> 5, blk = (lane >> 4) & 1, q = (lane & 15) >> 2, p = lane & 3;
    const int rlo = PERM ? k0 + 4 * h + q : k0 + 8 * h + q, rhi = PERM ? k0 + 8 + 4 * h + q : k0 + 8 * h + 4 + q;
    const int cb = (c0 + 16 * blk + 4 * p) * 2;
    const s16x4 lo = vtr(img + rlo * pitch + cb), hi = vtr(img + rhi * pitch + cb);
    return __builtin_shufflevector(lo, hi, 0, 1, 2, 3, 4, 5, 6, 7);
}
__device__ __forceinline__ bf16x8 pack8(const f32x16& x, int s) {
    f32x8 v;
#pragma unroll
    for (int j = 0; j < 8; ++j) v[j] = x[8 * s + j];
    return __builtin_bit_cast(bf16x8, __builtin_convertvector(v, bfv8));
}
__device__ __forceinline__ void stage_conv(LAS unsigned char* img, const bf16* z, size_t tokb, int t0, int zcol0, const float* cw, const float* cbias, float scale, int tid) {
    const int cg8 = (tid & 15) * 8, lr = tid >> 4;
    float w[4][8], bb[8];
#pragma unroll
    for (int j = 0; j < 4; ++j) { const f32x4 a = *(const f32x4*)(cw + j * 1024 + cg8), b = *(const f32x4*)(cw + j * 1024 + cg8 + 4); w[j][0] = a.x; w[j][1] = a.y; w[j][2] = a.z; w[j][3] = a.w; w[j][4] = b.x; w[j][5] = b.y; w[j][6] = b.z; w[j][7] = b.w; }
    { const f32x4 a = *(const f32x4*)(cbias + cg8), b = *(const f32x4*)(cbias + cg8 + 4); bb[0] = a.x; bb[1] = a.y; bb[2] = a.z; bb[3] = a.w; bb[4] = b.x; bb[5] = b.y; bb[6] = b.z; bb[7] = b.w; }
    float r[7][8];
#pragma unroll
    for (int jj = 0; jj < 7; ++jj) { const int t = t0 + 4 * lr - 3 + jj; u32x4 v = {0u, 0u, 0u, 0u};
        if (t >= 0) v = *(const u32x4*)(z + (tokb + t) * ZP + zcol0 + cg8);
        r[jj][0] = pg8::bf_lo(v.x); r[jj][1] = pg8::bf_hi(v.x); r[jj][2] = pg8::bf_lo(v.y); r[jj][3] = pg8::bf_hi(v.y); r[jj][4] = pg8::bf_lo(v.z); r[jj][5] = pg8::bf_hi(v.z); r[jj][6] = pg8::bf_lo(v.w); r[jj][7] = pg8::bf_hi(v.w); }
#pragma unroll
    for (int i = 0; i < 4; ++i) { float y[8];
#pragma unroll
        for (int e = 0; e < 8; ++e) { float s = w[0][e] * r[i][e] + w[1][e] * r[i + 1][e] + w[2][e] * r[i + 2][e] + w[3][e] * r[i + 3][e] + bb[e]; y[e] = s / (1.0f + __expf(-s)) * scale; }
        u32x4 o; o.x = pk2(y[0], y[1]); o.y = pk2(y[2], y[3]); o.z = pk2(y[4], y[5]); o.w = pk2(y[6], y[7]);
        *(LAS u32x4*)(img + (4 * lr + i) * PQ + cg8 * 2) = o; }
}
template <bool SCALE> __device__ __forceinline__ void stage_v(LAS unsigned char* img, const bf16* z, size_t tok0, int h, const LAS float* aa, int tid) {
    const int v8 = (tid & 31) * 8, l0 = tid >> 5;
#pragma unroll
    for (int i = 0; i < 8; ++i) { const int l = l0 + 16 * i; u32x4 v = *(const u32x4*)(z + (tok0 + l) * ZP + ZVM + h * 256 + v8);
        if (SCALE) { const float a = aa[l]; v.x = pk2(pg8::bf_lo(v.x) * a, pg8::bf_hi(v.x) * a); v.y = pk2(pg8::bf_lo(v.y) * a, pg8::bf_hi(v.y) * a); v.z = pk2(pg8::bf_lo(v.z) * a, pg8::bf_hi(v.z) * a); v.w = pk2(pg8::bf_lo(v.w) * a, pg8::bf_hi(v.w) * a); }
        *(LAS u32x4*)(img + l * PV + v8 * 2) = v; }
}
constexpr int OFF_K1 = 0, OFF_V1 = 34816, OFF_F1 = 34816 + 67584;
__device__ __forceinline__ void dc_item(const bf16* z, const float* gates, const float* conv_w, const float* conv_b, bf16* dC, float* dn, float* mloc, float* bend, int item, LAS unsigned char* L, int tid, int lane, int wave) {
    const int b = item >> 8, h = (item >> 6) & 3, c = item & 63;
    const size_t tokb = (size_t)b * SEQ, tok0 = tokb + (size_t)c * 128;
    LAS unsigned char* kimg = L + OFF_K1; LAS unsigned char* vimg = L + OFF_V1; LAS float* lf = (LAS float*)(L + OFF_F1); LAS float* ig = lf + 128; LAS float* bc = lf + 256; LAS float* aa = lf + 384;
    __syncthreads();
    if (tid < 128) { lf[tid] = gates[(tok0 + tid) * 8 + 4 + h]; ig[tid] = gates[(tok0 + tid) * 8 + h]; }
    stage_conv(kimg, z, tokb, c * 128, ZKM + h * 128, conv_w + 512 + h * 128, conv_b + 512 + h * 128, 0.08838834764831845f, tid);
    __syncthreads();
    if (tid < 128) { float s = 0.f; for (int j = 0; j <= tid; ++j) s += lf[j]; bc[tid] = s; }
    __syncthreads();
    const float be = bc[127];
    if (tid < 128) aa[tid] = be - bc[tid] + ig[tid];
    __syncthreads();
    float ml = -INFINITY;
    for (int j = 0; j < 128; j += 4) { const f32x4 t = *(const LAS f32x4*)(aa + j); ml = fmaxf(ml, fmaxf(fmaxf(t.x, t.y), fmaxf(t.z, t.w))); }
    __syncthreads();
    if (tid < 128) aa[tid] = __expf(aa[tid] - ml);
    __syncthreads();
    stage_v<true>(vimg, z, tok0, h, aa, tid);
    __syncthreads();
    f32x16 acc[4];
#pragma unroll
    for (int dt = 0; dt < 4; ++dt)
#pragma unroll
        for (int i = 0; i < 16; ++i) acc[dt][i] = 0.f;
#pragma unroll
    for (int ks = 0; ks < 8; ++ks) { const bf16x8 bv = trread<false>(vimg, PV, 16 * ks, 32 * wave, lane);
#pragma unroll
        for (int dt = 0; dt < 4; ++dt) { const bf16x8 ak = trread<false>(kimg, PQ, 16 * ks, 32 * dt, lane); acc[dt] = MFMA32(ak, bv, acc[dt]); } }
    if (tid < 128) { float s = 0.f; for (int l = 0; l < 128; ++l) s += aa[l] * bf2f(*(const LAS bf16*)(kimg + l * PQ + tid * 2)); dn[(size_t)item * 128 + tid] = s; }
    if (tid == 0) { mloc[item] = ml; bend[item] = be; }
    const int r = lane & 31, hh = lane >> 5;
    bf16* orow = dC + (size_t)item * 32768 + (size_t)(32 * wave + r) * 128;
#pragma unroll
    for (int dt = 0; dt < 4; ++dt)
#pragma unroll
        for (int g = 0; g < 4; ++g) { u32x2 o; o.x = pk2(acc[dt][4 * g], acc[dt][4 * g + 1]); o.y = pk2(acc[dt][4 * g + 2], acc[dt][4 * g + 3]); *(u32x2*)(orow + 32 * dt + 8 * g + 4 * hh) = o; }
}
__device__ __forceinline__ void scan_phase(bf16* dC, float* dn, const float* mloc, const float* bend, float* mprev, int G, int tid) {
    for (int gidx = blockIdx.x * 512 + tid; gidx < 16 * 8192; gidx += G * 512) {
        const int bh = gidx >> 13, e4 = gidx & 8191;
        bf16* base = dC + (size_t)bh * 64 * 32768 + (size_t)e4 * 4;
        float C0 = 0.f, C1 = 0.f, C2 = 0.f, C3 = 0.f, m = 0.f;
        for (int c0 = 0; c0 < 64; c0 += 8) {
            u32x2 ld[8];
#pragma unroll
            for (int k = 0; k < 8; ++k) { const int c = c0 + k; ld[k] = (u32x2){0u, 0u}; if (c < 63) ld[k] = *(const u32x2*)(base + (size_t)c * 32768); }
#pragma unroll
            for (int k = 0; k < 8; ++k) { const int c = c0 + k;
                u32x2 o; o.x = pk2(C0, C1); o.y = pk2(C2, C3); *(u32x2*)(base + (size_t)c * 32768) = o;
                if (e4 == 0) mprev[bh * 64 + c] = m;
                if (c < 63) { const float ml = mloc[bh * 64 + c], be = bend[bh * 64 + c]; const float mn = fmaxf(be + m, ml), so = __expf(be + m - mn), sn = __expf(ml - mn);
                    C0 = so * C0 + sn * pg8::bf_lo(ld[k].x); C1 = so * C1 + sn * pg8::bf_hi(ld[k].x); C2 = so * C2 + sn * pg8::bf_lo(ld[k].y); C3 = so * C3 + sn * pg8::bf_hi(ld[k].y); m = mn; } }
        }
        if (gidx < 16 * 128) {
            const int bh2 = gidx >> 7, d = gidx & 127; float n = 0.f, m2 = 0.f;
            for (int c = 0; c < 64; ++c) { float* p = dn + (size_t)(bh2 * 64 + c) * 128 + d; const float dv = (c < 63) ? *p : 0.f; *p = n;
                if (c < 63) { const float ml = mloc[bh2 * 64 + c], be = bend[bh2 * 64 + c]; const float mn = fmaxf(be + m2, ml); n = __expf(be + m2 - mn) * n + __expf(ml - mn) * dv; m2 = mn; } }
        }
    }
}
constexpr int OFF_Q3 = 0, OFF_K3 = 34816, OFF_V3 = 69632, OFF_F3 = 69632 + 67584;
__device__ __forceinline__ void out_item(bf16* z, const float* gates, const float* conv_w, const float* conv_b, const bf16* Cprev, const float* nprev, const float* mprev, const float* hn, int item, LAS unsigned char* L, int tid, int lane, int wave) {
    const int b = item >> 8, h = (item >> 6) & 3, c = item & 63;
    const size_t tokb = (size_t)b * SEQ, tok0 = tokb + (size_t)c * 128;
    LAS unsigned char* qimg = L + OFF_Q3; LAS unsigned char* kimg = L + OFF_K3; LAS unsigned char* vimg = L + OFF_V3;
    LAS float* lf = (LAS float*)(L + OFF_F3); LAS float* ig = lf + 128; LAS float* bc = lf + 256; LAS float* uu = lf + 384; LAS float* gm = lf + 512; LAS float* np = lf + 640; LAS float* part = lf + 768;
    __syncthreads();
    if (tid < 128) { lf[tid] = gates[(tok0 + tid) * 8 + 4 + h]; ig[tid] = gates[(tok0 + tid) * 8 + h]; np[tid] = nprev[(size_t)item * 128 + tid]; }
    stage_conv(qimg, z, tokb, c * 128, ZQM + h * 128, conv_w + h * 128, conv_b + h * 128, 1.0f, tid);
    stage_conv(kimg, z, tokb, c * 128, ZKM + h * 128, conv_w + 512 + h * 128, conv_b + 512 + h * 128, 0.08838834764831845f, tid);
    stage_v<false>(vimg, z, tok0, h, nullptr, tid);
    __syncthreads();
    if (tid < 128) { float s = 0.f; for (int j = 0; j <= tid; ++j) s += lf[j]; bc[tid] = s; uu[tid] = ig[tid] - s; }
    __syncthreads();
    if (tid < 128) { float mx = -INFINITY; for (int j = 0; j <= tid; ++j) mx = fmaxf(mx, uu[j]); gm[tid] = mx; }
    __syncthreads();
    const float mp = mprev[item];
    const int lw = wave & 3, vw = wave >> 2, r = lane & 31, hh = lane >> 5, l = 32 * lw + r;
    const float b_l = bc[l], mt = fmaxf(b_l + gm[l], b_l + mp), inter = __expf(b_l + mp - mt), e0 = b_l - mt;
    f32x16 S[4];
#pragma unroll
    for (int st = 0; st < 4; ++st)
#pragma unroll
        for (int i = 0; i < 16; ++i) S[st][i] = 0.f;
#pragma unroll
    for (int ks = 0; ks < 8; ++ks) { const bf16x8 bq = rowread(qimg, PQ, 32 * lw, 16 * ks, lane);
#pragma unroll
        for (int st = 0; st < 4; ++st) if (st <= lw) { const bf16x8 ak = rowread(kimg, PQ, 32 * st, 16 * ks, lane); S[st] = MFMA32(ak, bq, S[st]); } }
    float dsum = 0.f;
#pragma unroll
    for (int st = 0; st < 4; ++st) if (st <= lw) {
#pragma unroll
        for (int g = 0; g < 4; ++g) { const int s0 = 32 * st + 8 * g + 4 * hh; const f32x4 u4 = *(const LAS f32x4*)(uu + s0);
#pragma unroll
            for (int e = 0; e < 4; ++e) { const float w = (s0 + e <= l) ? __expf(e0 + u4[e]) : 0.f; const float v = S[st][4 * g + e] * w; S[st][4 * g + e] = v; dsum += v; } } }
    dsum += __shfl_xor(dsum, 32);
    bf16x8 fr[4][2];
#pragma unroll
    for (int st = 0; st < 4; ++st) { fr[st][0] = pack8(S[st], 0); fr[st][1] = pack8(S[st], 1); }
    float qn = 0.f;
#pragma unroll
    for (int d8 = 0; d8 < 8; ++d8) { const bf16x8 qf = *(const LAS bf16x8*)(qimg + l * PQ + (64 * hh + 8 * d8) * 2); const f32x4 na = *(const LAS f32x4*)(np + 64 * hh + 8 * d8), nb = *(const LAS f32x4*)(np + 64 * hh + 8 * d8 + 4);
        qn += bf2f((bf16)qf[0]) * na.x + bf2f((bf16)qf[1]) * na.y + bf2f((bf16)qf[2]) * na.z + bf2f((bf16)qf[3]) * na.w + bf2f((bf16)qf[4]) * nb.x + bf2f((bf16)qf[5]) * nb.y + bf2f((bf16)qf[6]) * nb.z + bf2f((bf16)qf[7]) * nb.w; }
    qn += __shfl_xor(qn, 32);
    const float den = dsum + inter * qn, rden = 1.0f / fmaxf(fabsf(den), __expf(-mt));
    f32x16 O[4];
#pragma unroll
    for (int vt = 0; vt < 4; ++vt)
#pragma unroll
        for (int i = 0; i < 16; ++i) O[vt][i] = 0.f;
    const bf16* cp = Cprev + (size_t)item * 32768 + (size_t)(128 * vw + r) * 128 + 8 * hh;
#pragma unroll
    for (int ks = 0; ks < 8; ++ks) { const bf16x8 bq = rowread(qimg, PQ, 32 * lw, 16 * ks, lane);
#pragma unroll
        for (int vt = 0; vt < 4; ++vt) { const bf16x8 ac = *(const bf16x8*)(cp + vt * 4096 + 16 * ks); O[vt] = MFMA32(ac, bq, O[vt]); } }
#pragma unroll
    for (int vt = 0; vt < 4; ++vt)
#pragma unroll
        for (int i = 0; i < 16; ++i) O[vt][i] *= inter;
#pragma unroll
    for (int st = 0; st < 4; ++st) if (st <= lw) {
#pragma unroll
        for (int s2 = 0; s2 < 2; ++s2)
#pragma unroll
            for (int vt = 0; vt < 4; ++vt) { const bf16x8 av = trread<true>(vimg, PV, 32 * st + 16 * s2, 128 * vw + 32 * vt, lane); O[vt] = MFMA32(av, fr[st][s2], O[vt]); } }
    float ss = 0.f;
#pragma unroll
    for (int vt = 0; vt < 4; ++vt)
#pragma unroll
        for (int i = 0; i < 16; ++i) { const float v = O[vt][i] * rden; O[vt][i] = v; ss += v * v; }
    ss += __shfl_xor(ss, 32);
    if (hh == 0) part[vw * 128 + l] = ss;
    __syncthreads();
    const float rstd = 1.0f / sqrtf((part[l] + part[128 + l]) * (1.0f / 256.0f) + RMS_EPS);
    bf16* orow = z + (tok0 + l) * ZP + ZOM + h * 256;
#pragma unroll
    for (int vt = 0; vt < 4; ++vt)
#pragma unroll
        for (int g = 0; g < 4; ++g) { const int v0 = 128 * vw + 32 * vt + 8 * g + 4 * hh; const u32x2 ow = *(const u32x2*)(orow + v0); const f32x4 gn = *(const f32x4*)(hn + h * 256 + v0);
            const float r0 = O[vt][4 * g] * rstd * gn.x / (1.0f + __expf(-pg8::bf_lo(ow.x))), r1 = O[vt][4 * g + 1] * rstd * gn.y / (1.0f + __expf(-pg8::bf_hi(ow.x)));
            const float r2 = O[vt][4 * g + 2] * rstd * gn.z / (1.0f + __expf(-pg8::bf_lo(ow.y))), r3 = O[vt][4 * g + 3] * rstd * gn.w / (1.0f + __expf(-pg8::bf_hi(ow.y)));
            u32x2 o; o.x = pk2(r0, r1); o.y = pk2(r2, r3); *(u32x2*)(orow + v0) = o; }
}
}


namespace at {
using namespace mm;
constexpr int PK = 144;
constexpr int OFF_K = 0, OFF_V = 256 * PK;
__device__ __forceinline__ void unpack8(const u32x4 v, float (&x)[8]) { x[0] = pg8::bf_lo(v.x); x[1] = pg8::bf_hi(v.x); x[2] = pg8::bf_lo(v.y); x[3] = pg8::bf_hi(v.y); x[4] = pg8::bf_lo(v.z); x[5] = pg8::bf_hi(v.z); x[6] = pg8::bf_lo(v.w); x[7] = pg8::bf_hi(v.w); }
__device__ __forceinline__ void load8f(const float* p, float (&x)[8]) { const f32x4 a = *(const f32x4*)p, b = *(const f32x4*)(p + 4); x[0] = a.x; x[1] = a.y; x[2] = a.z; x[3] = a.w; x[4] = b.x; x[5] = b.y; x[6] = b.z; x[7] = b.w; }
__device__ __forceinline__ bf16x8 cvt8(const float (&y)[8]) { f32x8 v;
#pragma unroll
    for (int e = 0; e < 8; ++e) v[e] = y[e];
    return __builtin_bit_cast(bf16x8, __builtin_convertvector(v, bfv8)); }
__device__ __forceinline__ void attn_item(bf16* z, const float* rope_cos, const float* rope_sin, const float* sinks, int item, LAS unsigned char* L, int tid, int lane, int wave) {
    const int hk = item & 3, n = (item >> 2) & 63, b = item >> 8;
    const size_t tok0 = (size_t)b * SEQ + (size_t)n * 128;
    LAS unsigned char* kimg = L + OFF_K; LAS unsigned char* vimg = L + OFF_V;
    __syncthreads();
    for (int idx = tid; idx < 1024; idx += 512) {
        const int key = idx >> 2, c8 = (idx & 3) * 8;
        bf16x8 o1 = {0, 0, 0, 0, 0, 0, 0, 0}, o2 = {0, 0, 0, 0, 0, 0, 0, 0};
        if (n > 0 || key >= 128) {
            const bf16* zr = z + (tok0 + key - 128) * ZP + ZKA + hk * 64;
            float x1[8], x2[8], cs[8], sn[8], y1[8], y2[8];
            unpack8(*(const u32x4*)(zr + c8), x1); unpack8(*(const u32x4*)(zr + c8 + 32), x2);
            const int pos = n * 128 + key - 128;
            load8f(rope_cos + pos * 32 + c8, cs); load8f(rope_sin + pos * 32 + c8, sn);
#pragma unroll
            for (int e = 0; e < 8; ++e) { y1[e] = x1[e] * cs[e] - x2[e] * sn[e]; y2[e] = x2[e] * cs[e] + x1[e] * sn[e]; }
            o1 = cvt8(y1); o2 = cvt8(y2);
        }
        *(LAS bf16x8*)(kimg + key * PK + c8 * 2) = o1; *(LAS bf16x8*)(kimg + key * PK + (c8 + 32) * 2) = o2;
    }
    for (int idx = tid; idx < 2048; idx += 512) {
        const int key = idx >> 3, c8 = (idx & 7) * 8; u32x4 v = {0u, 0u, 0u, 0u};
        if (n > 0 || key >= 128) v = *(const u32x4*)(z + (tok0 + key - 128) * ZP + ZVA + hk * 64 + c8);
        *(LAS u32x4*)(vimg + key * PK + c8 * 2) = v;
    }
    __syncthreads();
    const int r = lane & 31, hh = lane >> 5;
#pragma unroll 1
    for (int gsel = 0; gsel < 2; ++gsel) {
        const int gi = wave + 8 * gsel, g = gi >> 2, j = gi & 3, head = hk * 4 + g;
        bf16* qrow = z + (tok0 + 32 * j + r) * ZP + ZQA + head * 64; const int pos = n * 128 + 32 * j + r;
        u32x4 raw[4];
#pragma unroll
        for (int ks = 0; ks < 4; ++ks) raw[ks] = *(const u32x4*)(qrow + 16 * ks + 8 * hh);
        bf16x8 qf[4];
#pragma unroll
        for (int k2 = 0; k2 < 2; ++k2) { float x1[8], x2[8], cs[8], sn[8], y1[8], y2[8];
            unpack8(raw[k2], x1); unpack8(raw[k2 + 2], x2); load8f(rope_cos + pos * 32 + 16 * k2 + 8 * hh, cs); load8f(rope_sin + pos * 32 + 16 * k2 + 8 * hh, sn);
#pragma unroll
            for (int e = 0; e < 8; ++e) { y1[e] = (x1[e] * cs[e] - x2[e] * sn[e]) * 0.125f; y2[e] = (x2[e] * cs[e] + x1[e] * sn[e]) * 0.125f; }
            qf[k2] = cvt8(y1); qf[k2 + 2] = cvt8(y2); }
        f32x16 S[5];
#pragma unroll
        for (int kt = 0; kt < 5; ++kt)
#pragma unroll
            for (int i = 0; i < 16; ++i) S[kt][i] = 0.f;
#pragma unroll
        for (int ks = 0; ks < 4; ++ks)
#pragma unroll
            for (int kt = 0; kt < 5; ++kt) { const bf16x8 ak = rowread(kimg, PK, 32 * (j + kt), 16 * ks, lane); S[kt] = MFMA32(ak, qf[ks], S[kt]); }
        const float sink = sinks[head]; float mx = sink;
#pragma unroll
        for (int kt = 0; kt < 5; ++kt)
#pragma unroll
            for (int i = 0; i < 16; ++i) { const int cr = (i & 3) + 8 * (i >> 2) + 4 * hh; bool ok = (kt == 0) ? (cr > r) : (kt == 4) ? (cr <= r) : true; if (n == 0 && j + kt < 4) ok = false;
                const float s = ok ? S[kt][i] : -INFINITY; S[kt][i] = s; mx = fmaxf(mx, s); }
        mx = fmaxf(mx, __shfl_xor(mx, 32));
        float sum = 0.f;
#pragma unroll
        for (int kt = 0; kt < 5; ++kt)
#pragma unroll
            for (int i = 0; i < 16; ++i) { const float p = __expf(S[kt][i] - mx); S[kt][i] = p; sum += p; }
        sum += __shfl_xor(sum, 32); sum += __expf(sink - mx);
        const float inv = 1.0f / sum;
        f32x16 O[2];
#pragma unroll
        for (int dt = 0; dt < 2; ++dt)
#pragma unroll
            for (int i = 0; i < 16; ++i) O[dt][i] = 0.f;
#pragma unroll
        for (int kt = 0; kt < 5; ++kt)
#pragma unroll
            for (int s2 = 0; s2 < 2; ++s2) { const bf16x8 pf = pack8(S[kt], s2);
#pragma unroll
                for (int dt = 0; dt < 2; ++dt) { const bf16x8 av = trread<true>(vimg, PK, 32 * (j + kt) + 16 * s2, 32 * dt, lane); O[dt] = MFMA32(av, pf, O[dt]); } }
#pragma unroll
        for (int dt = 0; dt < 2; ++dt)
#pragma unroll
            for (int g4 = 0; g4 < 4; ++g4) { u32x2 o; o.x = pk2(O[dt][4 * g4] * inv, O[dt][4 * g4 + 1] * inv); o.y = pk2(O[dt][4 * g4 + 2] * inv, O[dt][4 * g4 + 3] * inv); *(u32x2*)(qrow + 32 * dt + 8 * g4 + 4 * hh) = o; }
    }
}
}

__global__ void __launch_bounds__(512, 2) mega_fwd(Args args) {
    extern __shared__ __attribute__((aligned(16))) unsigned char lds[];
    cg::grid_group grid = cg::this_grid();
    const int tid = threadIdx.x, lane = tid & 63, wave = __builtin_amdgcn_readfirstlane(tid >> 6);
    const int G = gridDim.x, gw = blockIdx.x * 8 + wave, NGW = G * 8;
    unsigned char* ws = args.ws;
    const float* x = args.in[0];
    float* out = args.out;
    bf16* WA = (bf16*)(ws + WS_WA); bf16* Wgu = (bf16*)(ws + WS_WA + WA_GU); bf16* Wdn = (bf16*)(ws + WS_WA + WA_DN);
    bf16* Watt = (bf16*)(ws + WS_WP); bf16* Wml = (bf16*)(ws + WS_WP + 2 * MiB); bf16* Wout = (bf16*)(ws + WS_WP + 4 * MiB);
    float* rope_cos = (float*)(ws + WS_ROPE); float* rope_sin = rope_cos + SEQ * 32;
    float* gates = (float*)(ws + WS_GATE);
    float* dnb = (float*)(ws + WS_MISC); float* mlocb = dnb + 1024 * 128; float* bendb = mlocb + 1024; float* mprevb = bendb + 1024;
    bf16* hA = (bf16*)(ws + WS_HA); bf16* Z = (bf16*)(ws + WS_Z); bf16* HID = (bf16*)(ws + WS_Z);
    LAS float* scr = (LAS float*)((LAS unsigned char*)lds + wave * 16384);
    const int lo = args.ph_lo, hi = args.ph_hi;
#define IN(k) (lo <= (k) && (k) < hi)
#define SEAM(k) do { if (IN(k) && IN((k) + 1)) grid.sync(); } while (0)

    if (IN(0)) {
        convert_weight(args.in[2], FF, D, FF / 32, Wgu, 1, gw, NGW, scr, lane);
        convert_weight(args.in[3], FF, D, FF / 32, Wgu, 2, gw, NGW, scr, lane);
        convert_weight(args.in[4], D, FF, D / 32, Wdn, 0, gw, NGW, scr, lane);
        convert_weight(args.in[13], D, D, D / 32, Watt, 0, gw, NGW, scr, lane);
        convert_weight(args.in[14], D, D, D / 32, Wml, 0, gw, NGW, scr, lane);
        convert_weight(args.in[15], D, D, D / 32, Wout, 0, gw, NGW, scr, lane);
        for (int idx = blockIdx.x * 512 + tid; idx < SEQ * 32; idx += G * 512) {
            const int pos = idx >> 5, i = idx & 31;
            const float angf = (float)pos * args.inv_freq[i];
            const double ang = (double)angf;
            const double kq = rint(ang * 0.63661977236758134308);
            const double y = (ang - kq * 1.57079632679489655800) - kq * 6.123233995736766e-17;
            const double y2 = y * y;
            const double sy = y * (1.0 + y2 * (-1.0 / 6 + y2 * (1.0 / 120 + y2 * (-1.0 / 5040 + y2 * (1.0 / 362880 + y2 * (-1.0 / 39916800 + y2 * (1.0 / 6227020800.0)))))));
            const double cy = 1.0 + y2 * (-0.5 + y2 * (1.0 / 24 + y2 * (-1.0 / 720 + y2 * (1.0 / 40320 + y2 * (-1.0 / 3628800 + y2 * (1.0 / 479001600.0 + y2 * (-1.0 / 87178291200.0)))))));
            const long long qi = (long long)kq; const int qd = (int)(qi & 3);
            const double sn = qd == 0 ? sy : qd == 1 ? cy : qd == 2 ? -sy : -cy;
            const double cs = qd == 0 ? cy : qd == 1 ? -sy : qd == 2 ? -cy : sy;
            rope_cos[idx] = (float)cs; rope_sin[idx] = (float)sn;
        }
        for (int r = gw; r < T; r += NGW) { f32x4 v[4]; norm_row(x + (size_t)r * D, args.in[1], hA + (size_t)r * D, lane, v); }
    }
    SEAM(0);
    if (IN(1)) {
        pg8::Gemm g{hA, hA, Wgu, Wgu, D, D}; pg8::StaticOrder S; S.init(T, NGU, G, (int)blockIdx.x);
        pg8::EpiSwiGLU E{HID, FF};
        pg8::gemm_phase<pg8::EpiSwiGLU, pg8::StaticOrder>((PG8_LAS unsigned char*)lds, g, S, E);
    }
    SEAM(1);
    if (IN(2)) {
        pg8::Gemm g{HID, HID, Wdn, Wdn, FF, FF}; pg8::StaticOrder S; S.init(T, D, G, (int)blockIdx.x);
        pg8::EpiResid E{x, out, D, 0.5f};
        pg8::gemm_phase<pg8::EpiResid, pg8::StaticOrder>((PG8_LAS unsigned char*)lds, g, S, E);
    }
    SEAM(2);
    if (IN(3)) {
        convert_weight(args.in[6], INW, D, ZP / 32, WA, 3, gw, NGW, scr, lane);
        const float* win = args.in[6];
        for (int r = gw; r < T; r += NGW) {
            f32x4 v[4]; norm_row(out + (size_t)r * D, args.in[5], hA + (size_t)r * D, lane, v);
            float gsum[8];
#pragma unroll
            for (int e = 0; e < 8; ++e) gsum[e] = 0.f;
#pragma unroll
            for (int j = 0; j < 4; ++j)
#pragma unroll
                for (int e = 0; e < 4; ++e) { const int k = 256 * j + 4 * lane + e; const f32x4 wa = *(const f32x4*)(win + (size_t)k * INW + 4608), wb = *(const f32x4*)(win + (size_t)k * INW + 4612); const float hv = v[j][e];
                    gsum[0] += hv * wa.x; gsum[1] += hv * wa.y; gsum[2] += hv * wa.z; gsum[3] += hv * wa.w; gsum[4] += hv * wb.x; gsum[5] += hv * wb.y; gsum[6] += hv * wb.z; gsum[7] += hv * wb.w; }
#pragma unroll
            for (int e = 0; e < 8; ++e) gsum[e] = wave_sum(gsum[e]);
            if (lane < 8) {
                float val = lane == 0 ? gsum[0] : lane == 1 ? gsum[1] : lane == 2 ? gsum[2] : lane == 3 ? gsum[3] : lane == 4 ? gsum[4] : lane == 5 ? gsum[5] : lane == 6 ? gsum[6] : gsum[7];
                if (lane < 4) val += args.in[7][lane];
                else { const float xx = val + args.in[8][lane - 4]; val = fminf(xx, 0.f) - log1pf(expf(-fabsf(xx))); }
                gates[(size_t)r * 8 + lane] = val;
            }
        }
    }
    SEAM(3);
    if (IN(4)) {
        pg8::Gemm g{hA, hA, WA, WA, D, D}; pg8::StaticOrder S; S.init(T, ZP, G, (int)blockIdx.x);
        pg8::EpiBf16 E{Z, ZP};
        pg8::gemm_phase<pg8::EpiBf16, pg8::StaticOrder>((PG8_LAS unsigned char*)lds, g, S, E);
    }
    SEAM(4);
    if (IN(5)) {
        for (int it = blockIdx.x; it < 1024; it += G) if ((it & 63) != 63) mm::dc_item(Z, gates, args.in[10], args.in[11], hA, dnb, mlocb, bendb, it, (LAS unsigned char*)lds, tid, lane, wave);
        for (int it = blockIdx.x; it < 1024; it += G) at::attn_item(Z, rope_cos, rope_sin, args.in[9], it, (LAS unsigned char*)lds, tid, lane, wave);
    }
    SEAM(5);
    if (IN(6)) {
        __syncthreads();
        mm::scan_phase(hA, dnb, mlocb, bendb, mprevb, G, tid);
        convert_weight(args.in[17], FF, D, FF / 32, Wgu, 1, gw, NGW, scr, lane);
        convert_weight(args.in[18], FF, D, FF / 32, Wgu, 2, gw, NGW, scr, lane);
        convert_weight(args.in[19], D, FF, D / 32, Wdn, 0, gw, NGW, scr, lane);
    }
    SEAM(6);
    if (IN(7)) {
        for (int it = blockIdx.x; it < 1024; it += G) mm::out_item(Z, gates, args.in[10], args.in[11], hA, dnb, mprevb, args.in[12], it, (LAS unsigned char*)lds, tid, lane, wave);
    }
    SEAM(7);
    if (IN(8)) {
        pg8::Gemm g{Z + ZQA, Z + ZOM, Watt, Wml, ZP, D}; pg8::PairOrder S; S.so.init(T, D, G, (int)blockIdx.x);
        pg8::EpiMix E{Z, Z + ZQM, ZP, ZGA, ZGM};
        pg8::gemm_phase<pg8::EpiMix, pg8::PairOrder>((PG8_LAS unsigned char*)lds, g, S, E);
    }
    SEAM(8);
    if (IN(9)) {
        pg8::Gemm g{Z + ZQM, Z + ZQM, Wout, Wout, ZP, D}; pg8::StaticOrder S; S.init(T, D, G, (int)blockIdx.x);
        pg8::EpiResid E{out, out, D, 1.0f};
        pg8::gemm_phase<pg8::EpiResid, pg8::StaticOrder>((PG8_LAS unsigned char*)lds, g, S, E);
    }
    SEAM(9);
    if (IN(10)) {
        for (int r = gw; r < T; r += NGW) { f32x4 v[4]; norm_row(out + (size_t)r * D, args.in[16], hA + (size_t)r * D, lane, v); }
    }
    SEAM(10);
    if (IN(11)) {
        pg8::Gemm g{hA, hA, Wgu, Wgu, D, D}; pg8::StaticOrder S; S.init(T, NGU, G, (int)blockIdx.x);
        pg8::EpiSwiGLU E{HID, FF};
        pg8::gemm_phase<pg8::EpiSwiGLU, pg8::StaticOrder>((PG8_LAS unsigned char*)lds, g, S, E);
    }
    SEAM(11);
    if (IN(12)) {
        pg8::Gemm g{HID, HID, Wdn, Wdn, FF, FF}; pg8::StaticOrder S; S.init(T, D, G, (int)blockIdx.x);
        pg8::EpiResid E{out, out, D, 0.5f};
        pg8::gemm_phase<pg8::EpiResid, pg8::StaticOrder>((PG8_LAS unsigned char*)lds, g, S, E);
    }
    SEAM(12);
    if (IN(13)) {
        const float* gain = args.in[20];
        for (int r = gw; r < T; r += NGW) {
            f32x4* xr = (f32x4*)(out + (size_t)r * D) + lane; const f32x4* gr = (const f32x4*)gain + lane;
            f32x4 v[4]; float s = 0.f;
#pragma unroll
            for (int j = 0; j < 4; ++j) { v[j] = xr[64 * j]; s += (v[j].x * v[j].x + v[j].y * v[j].y) + (v[j].z * v[j].z + v[j].w * v[j].w); }
            const float rstd = 1.0f / sqrtf(wave_sum(s) * (1.0f / D) + RMS_EPS);
#pragma unroll
            for (int j = 0; j < 4; ++j) xr[64 * j] = v[j] * rstd * gr[64 * j];
        }
    }
#undef IN
#undef SEAM
}

extern "C" void kernel_launch(void* const* d_in, const int* in_sizes, int n_in, void* d_out, int out_size, void* d_ws, size_t ws_size, hipStream_t stream) {
    static int grid = 0;
    if (grid == 0) {
        if (n_in != 21 || out_size != T * D || ws_size < WS_END) { fprintf(stderr, "kernel_launch: unexpected shapes (n_in %d out %d ws %zu)\n", n_in, out_size, ws_size); grid = -1; return; }
        int dev = 0, cus = 0, per_cu = 0;
        hipGetDevice(&dev); hipDeviceGetAttribute(&cus, hipDeviceAttributeMultiprocessorCount, dev);
        if (hipFuncSetAttribute((const void*)mega_fwd, hipFuncAttributeMaxDynamicSharedMemorySize, LDS_BYTES) != hipSuccess) { fprintf(stderr, "kernel_launch: hipFuncSetAttribute failed\n"); grid = -1; return; }
        if (hipOccupancyMaxActiveBlocksPerMultiprocessor(&per_cu, (const void*)mega_fwd, 512, LDS_BYTES) != hipSuccess || per_cu < 1) { fprintf(stderr, "kernel_launch: occupancy query failed (%d)\n", per_cu); per_cu = 1; }
        (void)hipGetLastError();
        grid = cus * per_cu;
    }
    if (grid < 0) return;
    Args a{};
    for (int i = 0; i < 21; ++i) a.in[i] = (const float*)d_in[i];
    a.out = (float*)d_out; a.ws = (unsigned char*)d_ws;
    for (int i = 0; i < 32; ++i) a.inv_freq[i] = (float)pow(10000.0, -(double)i / 32.0);
#if MK_PER_PHASE_LAUNCH
    for (int ph = 0; ph < NPHASE; ++ph) { a.ph_lo = ph; a.ph_hi = ph + 1; hipLaunchKernelGGL(mega_fwd, dim3(grid), dim3(512), LDS_BYTES, stream, a); }
#else
    a.ph_lo = 0; a.ph_hi = NPHASE;
    void* kargs[] = {&a};
    hipError_t e = hipLaunchCooperativeKernel((const void*)mega_fwd, dim3(grid), dim3(512), kargs, LDS_BYTES, stream);
    if (e != hipSuccess) fprintf(stderr, "kernel_launch: cooperative launch failed: %s (grid %d)\n", hipGetErrorString(e), grid);
#endif
}
```

```cpp
#include <hip/hip_runtime.h>
#include <hip/hip_cooperative_groups.h>
#include <cstdio>
#include <cstdint>
#include <cmath>
namespace cg = cooperative_groups;

#ifndef MK_PER_PHASE_LAUNCH
#define MK_PER_PHASE_LAUNCH 0
#endif

namespace pg8 {
#define PG8_LAS __attribute__((address_space(3)))
typedef unsigned short bf16_t;
typedef short bf16x8 __attribute__((ext_vector_type(8)));
typedef float f32x4 __attribute__((ext_vector_type(4)));
typedef unsigned u32x4 __attribute__((ext_vector_type(4)));
constexpr int BM = 256, BK = 64, HALF = 128, HTB = HALF * BK * 2, STAGE_BYTES = 8 * HTB, NXCD = 8, WGM = 8;

__host__ __device__ __forceinline__ int lds_byte(int r, int c) { const int st = (r >> 4) * 2 + (c >> 5), rr = r & 15, cc = c & 31, ob = rr * 64 + cc * 2; return st * 1024 + (ob ^ (((ob >> 9) & 1) << 5)); }
__host__ __device__ __forceinline__ void stage_rc(int b, int& R, int& C) { const int st = b / 1024, sb = b % 1024, swz = sb ^ (((sb >> 9) & 1) << 5); R = (st >> 1) * 16 + swz / 64; C = (st & 1) * 32 + (swz % 64) / 2; }
__host__ __device__ __forceinline__ int perm32(int rho) { const int n = rho >> 4, i = rho & 15; return 8 * (i >> 2) + 4 * n + (i & 3); }

struct Unit { int pm, pn, kind; };
struct Gemm { const bf16_t* A0; const bf16_t* A1; const bf16_t* B0; const bf16_t* B1; int lda, K; };

struct StaticOrder {
    int nM, nN, nwg, G, c;
    __host__ __device__ void init(int M, int N, int G_, int c_) { nM = M / BM; nN = N / BM; nwg = nM * nN; G = G_; c = c_; }
    __host__ __device__ bool next(int i, Unit& u) const {
        const long L = (long)i * G + c; if (L >= nwg) return false;
        int wgid = (int)L; { const int q = nwg / NXCD, r = nwg % NXCD, xcd = wgid % NXCD, off = wgid / NXCD; wgid = (xcd < r ? xcd * (q + 1) : r * (q + 1) + (xcd - r) * q) + off; }
        const int nig = WGM * nN, gid = wgid / nig, fm = gid * WGM, gsz = (nM - fm) < WGM ? (nM - fm) : WGM;
        u.pm = fm + ((wgid % nig) % gsz); u.pn = (wgid % nig) / gsz; u.kind = 0; return true;
    }
};
struct PairOrder {
    StaticOrder so;
    __host__ __device__ bool next(int i, Unit& u) const { if (!so.next(i >> 1, u)) return false; u.kind = i & 1; return true; }
};

__device__ __forceinline__ unsigned cvt_pk_bf16(float lo, float hi) { unsigned r; asm volatile("v_cvt_pk_bf16_f32 %0, %1, %2" : "=v"(r) : "v"(lo), "v"(hi)); return r; }
__device__ __forceinline__ float bf_lo(unsigned w) { return __uint_as_float(w << 16); }
__device__ __forceinline__ float bf_hi(unsigned w) { return __uint_as_float(w & 0xffff0000u); }
__device__ __forceinline__ float sigmoid_den(float x) { return 1.0f + __expf(-x); }


struct EpiBf16 {
    bf16_t* O; int ldc;
    __device__ __forceinline__ bool operator()(f32x4 (&acc)[2][2][4][2], const Unit& u, int wr, int wc, int fr, int fq) const {
        const int row0 = u.pm * BM + wr * 64 + fr, col0 = u.pn * BM + wc * 32 + 8 * fq;
#pragma unroll
        for (int ai = 0; ai < 2; ++ai)
#pragma unroll
            for (int m = 0; m < 4; ++m) { bf16_t* rowp = O + (size_t)(row0 + ai * HALF + m * 16) * ldc + col0;
#pragma unroll
                for (int bj = 0; bj < 2; ++bj) { const f32x4 v0 = acc[ai][bj][m][0], v1 = acc[ai][bj][m][1];
                    u32x4 w; w.x = cvt_pk_bf16(v0[0], v0[1]); w.y = cvt_pk_bf16(v0[2], v0[3]); w.z = cvt_pk_bf16(v1[0], v1[1]); w.w = cvt_pk_bf16(v1[2], v1[3]);
                    *(u32x4*)(rowp + bj * HALF) = w; } }
        return true;
    }
};
struct EpiSwiGLU {
    bf16_t* O; int ldc;
    __device__ __forceinline__ bool operator()(f32x4 (&acc)[2][2][4][2], const Unit& u, int wr, int wc, int fr, int fq) const {
        const int row0 = u.pm * BM + wr * 64 + fr, col0 = u.pn * HALF + wc * 32 + 8 * fq;
#pragma unroll
        for (int ai = 0; ai < 2; ++ai)
#pragma unroll
            for (int m = 0; m < 4; ++m) { bf16_t* rowp = O + (size_t)(row0 + ai * HALF + m * 16) * ldc + col0;
                float r[8];
#pragma unroll
                for (int n = 0; n < 2; ++n)
#pragma unroll
                    for (int e = 0; e < 4; ++e) { const float g = acc[ai][0][m][n][e], up = acc[ai][1][m][n][e]; r[4 * n + e] = g * __builtin_amdgcn_rcpf(1.0f + __expf(-g)) * up; }
                u32x4 w; w.x = cvt_pk_bf16(r[0], r[1]); w.y = cvt_pk_bf16(r[2], r[3]); w.z = cvt_pk_bf16(r[4], r[5]); w.w = cvt_pk_bf16(r[6], r[7]);
                *(u32x4*)rowp = w; }
        return true;
    }
};
struct EpiResid {
    const float* base; float* out; int ldc; float alpha;
    __device__ __forceinline__ bool operator()(f32x4 (&acc)[2][2][4][2], const Unit& u, int wr, int wc, int fr, int fq) const {
        const int row0 = u.pm * BM + wr * 64 + fr, col0 = u.pn * BM + wc * 32 + 8 * fq;
#pragma unroll
        for (int ai = 0; ai < 2; ++ai)
#pragma unroll
            for (int m = 0; m < 4; ++m) { const size_t off = (size_t)(row0 + ai * HALF + m * 16) * ldc + col0;
#pragma unroll
                for (int bj = 0; bj < 2; ++bj)
#pragma unroll
                    for (int n = 0; n < 2; ++n) { const f32x4 b = *(const f32x4*)(base + off + bj * HALF + 4 * n); *(f32x4*)(out + off + bj * HALF + 4 * n) = b + acc[ai][bj][m][n] * alpha; } }
        return true;
    }
};
struct EpiMix {
    const bf16_t* Z; bf16_t* Y; int ldz; int cga, cgm;
    __device__ __forceinline__ bool operator()(f32x4 (&acc)[2][2][4][2], const Unit& u, int wr, int wc, int fr, int fq) const {
        const int row0 = u.pm * BM + wr * 64 + fr, col0 = u.pn * BM + wc * 32 + 8 * fq;
#pragma unroll
        for (int ai = 0; ai < 2; ++ai)
#pragma unroll
            for (int m = 0; m < 4; ++m) { const size_t off = (size_t)(row0 + ai * HALF + m * 16) * ldz + col0;
#pragma unroll
                for (int bj = 0; bj < 2; ++bj) {
                    const u32x4 gm = *(const u32x4*)(Z + off + cgm + bj * HALF);
                    float dm[8] = {sigmoid_den(bf_lo(gm.x)), sigmoid_den(bf_hi(gm.x)), sigmoid_den(bf_lo(gm.y)), sigmoid_den(bf_hi(gm.y)), sigmoid_den(bf_lo(gm.z)), sigmoid_den(bf_hi(gm.z)), sigmoid_den(bf_lo(gm.w)), sigmoid_den(bf_hi(gm.w))};
                    if (u.kind == 0) {
                        const u32x4 ga = *(const u32x4*)(Z + off + cga + bj * HALF);
                        float da[8] = {sigmoid_den(bf_lo(ga.x)), sigmoid_den(bf_hi(ga.x)), sigmoid_den(bf_lo(ga.y)), sigmoid_den(bf_hi(ga.y)), sigmoid_den(bf_lo(ga.z)), sigmoid_den(bf_hi(ga.z)), sigmoid_den(bf_lo(ga.w)), sigmoid_den(bf_hi(ga.w))};
#pragma unroll
                        for (int n = 0; n < 2; ++n)
#pragma unroll
                            for (int e = 0; e < 4; ++e) acc[ai][bj][m][n][e] *= dm[4 * n + e] / da[4 * n + e];
                    } else {
                        float r[8];
#pragma unroll
                        for (int n = 0; n < 2; ++n)
#pragma unroll
                            for (int e = 0; e < 4; ++e) r[4 * n + e] = acc[ai][bj][m][n][e] / dm[4 * n + e];
                        u32x4 w; w.x = cvt_pk_bf16(r[0], r[1]); w.y = cvt_pk_bf16(r[2], r[3]); w.z = cvt_pk_bf16(r[4], r[5]); w.w = cvt_pk_bf16(r[6], r[7]);
                        *(u32x4*)(Y + off + bj * HALF) = w;
                    }
                } }
        return u.kind != 0;
    }
};

template <class Epi, class Sched>
__device__ __forceinline__ void gemm_phase(PG8_LAS unsigned char* lds, const Gemm g, const Sched& S, const Epi& E) {
    const int tid = threadIdx.x, wid = __builtin_amdgcn_readfirstlane(tid >> 6), lane = tid & 63, wr = wid >> 2, wc = wid & 3, fr = lane & 15, fq = lane >> 4;
    const int K = g.K, nt = K / BK, lda = g.lda;
    unsigned voffA[2], voffB[2];
#pragma unroll
    for (int i = 0; i < 2; ++i) { int R, C; stage_rc(tid * 16 + i * 8192, R, C); const int Rb = (R & ~31) + perm32(R & 31);
        voffA[i] = (unsigned)(R * lda + C) * 2u; voffB[i] = (unsigned)(Rb * K + C) * 2u; }
    const size_t kstep = (size_t)(BK * 2);
    const size_t hstepA = (size_t)HALF * lda * 2, hstepB = (size_t)HALF * K * 2;
    const size_t tstepA = 2 * hstepA, tstepB = 2 * hstepB;
    const unsigned ldsw = (unsigned)wid * 1024u;
    const int aoff = lds_byte(wr * 64 + fr, fq * 8), boff = lds_byte(wc * 32 + fr, fq * 8);
#define PG8_SA(b, h) (((b) * 2 + (h)) * HTB)
#define PG8_SB(b, h) ((4 + (b) * 2 + (h)) * HTB)
#define PG8_STAGE(bufoff, gbase, voff) do { _Pragma("unroll") for (int _i = 0; _i < 2; ++_i) \
        __builtin_amdgcn_global_load_lds((const unsigned*)((const char*)(gbase) + (voff)[_i]), (PG8_LAS unsigned*)(lds + (bufoff) + ldsw + _i * 8192), 16, 0, 0); } while (0)
#define PG8_LDA(dst, b, h) do { _Pragma("unroll") for (int m = 0; m < 4; ++m) _Pragma("unroll") for (int k = 0; k < 2; ++k) dst[m][k] = *(const PG8_LAS bf16x8*)(lds + PG8_SA(b, h) + aoff + m * 2048 + k * 1024); } while (0)
#define PG8_LDB(dst, b, h) do { _Pragma("unroll") for (int n = 0; n < 2; ++n) _Pragma("unroll") for (int k = 0; k < 2; ++k) dst[n][k] = *(const PG8_LAS bf16x8*)(lds + PG8_SB(b, h) + boff + n * 2048 + k * 1024); } while (0)
#define PG8_MMA(ai, bj, At, Bt) do { __builtin_amdgcn_s_setprio(1); _Pragma("unroll") for (int m = 0; m < 4; ++m) _Pragma("unroll") for (int n = 0; n < 2; ++n) _Pragma("unroll") for (int k = 0; k < 2; ++k) \
        acc[ai][bj][m][n] = __builtin_amdgcn_mfma_f32_16x16x32_bf16(Bt[n][k], At[m][k], acc[ai][bj][m][n], 0, 0, 0); __builtin_amdgcn_s_setprio(0); } while (0)
#define PG8_WAIT_V(n) asm volatile("s_waitcnt vmcnt(" #n ")" ::: "memory")
#define PG8_WAIT_L(n) asm volatile("s_waitcnt lgkmcnt(" #n ")" ::: "memory")
#define PG8_BAR __builtin_amdgcn_s_barrier()
#define PG8_SCHED __builtin_amdgcn_sched_barrier(0)
    Unit cur, nxt; int ui = 0;
    if (!S.next(0, cur)) return;
    f32x4 acc[2][2][4][2];
#pragma unroll
    for (int a = 0; a < 2; ++a)
#pragma unroll
        for (int b = 0; b < 2; ++b)
#pragma unroll
            for (int m = 0; m < 4; ++m)
#pragma unroll
                for (int n = 0; n < 2; ++n) acc[a][b][m][n] = (f32x4){0.f, 0.f, 0.f, 0.f};
    bf16x8 At[4][2], B0[2][2], B1[2][2];
    const char* cA = (const char*)(cur.kind ? g.A1 : g.A0) + (size_t)cur.pm * tstepA; const char* cB = (const char*)(cur.kind ? g.B1 : g.B0) + (size_t)cur.pn * tstepB;
    PG8_STAGE(PG8_SB(0, 0), cB, voffB); PG8_STAGE(PG8_SB(0, 1), cB + hstepB, voffB); PG8_STAGE(PG8_SA(0, 0), cA, voffA); PG8_STAGE(PG8_SA(0, 1), cA + hstepA, voffA);
    if (wr == 1) PG8_BAR;
    PG8_WAIT_V(2); PG8_BAR;
    PG8_STAGE(PG8_SB(1, 0), cB + kstep, voffB); PG8_STAGE(PG8_SA(1, 0), cA + kstep, voffA); PG8_STAGE(PG8_SB(1, 1), cB + hstepB + kstep, voffB);
    PG8_WAIT_V(6); PG8_BAR;
    for (;;) {
        const bool has_next = S.next(ui + 1, nxt);
        const char* nA = has_next ? (const char*)(nxt.kind ? g.A1 : g.A0) + (size_t)nxt.pm * tstepA : cA; const char* nB = has_next ? (const char*)(nxt.kind ? g.B1 : g.B0) + (size_t)nxt.pn * tstepB : cB;
        for (int t = 0; t < nt; t += 2) {
            const bool last = (t == nt - 2);
            const char* a1 = cA + (size_t)(t + 1) * kstep;
            const char* a2 = last ? nA : cA + (size_t)(t + 2) * kstep; const char* b2 = last ? nB : cB + (size_t)(t + 2) * kstep;
            const char* a3 = a2 + kstep; const char* b3 = b2 + kstep;
            PG8_LDB(B0, 0, 0); PG8_LDB(B1, 0, 1); PG8_SCHED; PG8_LDA(At, 0, 0); PG8_STAGE(PG8_SA(1, 1), a1 + hstepA, voffA);
            PG8_WAIT_V(8); PG8_WAIT_L(0); PG8_BAR; PG8_MMA(0, 0, At, B0); PG8_MMA(0, 1, At, B1); PG8_BAR; PG8_SCHED;
            PG8_LDA(At, 0, 1); PG8_STAGE(PG8_SB(0, 0), b2, voffB); PG8_STAGE(PG8_SB(0, 1), b2 + hstepB, voffB); PG8_STAGE(PG8_SA(0, 0), a2, voffA);
            PG8_WAIT_V(8); PG8_WAIT_L(0); PG8_BAR; PG8_MMA(1, 0, At, B0); PG8_MMA(1, 1, At, B1); PG8_BAR; PG8_SCHED;
            PG8_LDB(B0, 1, 0); PG8_LDB(B1, 1, 1); PG8_SCHED; PG8_LDA(At, 1, 0); PG8_STAGE(PG8_SA(0, 1), a2 + hstepA, voffA);
            PG8_WAIT_V(8); PG8_WAIT_L(0); PG8_BAR; PG8_MMA(0, 0, At, B0); PG8_MMA(0, 1, At, B1); PG8_BAR; PG8_SCHED;
            PG8_LDA(At, 1, 1); PG8_STAGE(PG8_SB(1, 0), b3, voffB); PG8_STAGE(PG8_SB(1, 1), b3 + hstepB, voffB); PG8_STAGE(PG8_SA(1, 0), a3, voffA);
            PG8_WAIT_V(8); PG8_WAIT_L(0); PG8_BAR; PG8_MMA(1, 0, At, B0); PG8_MMA(1, 1, At, B1); PG8_BAR; PG8_SCHED;
        }
        if (wr == 0) PG8_BAR;
        const bool zero = E(acc, cur, wr, wc, fr, fq);
        if (!has_next) break;
        if (zero) {
#pragma unroll
            for (int a = 0; a < 2; ++a)
#pragma unroll
                for (int b = 0; b < 2; ++b)
#pragma unroll
                    for (int m = 0; m < 4; ++m)
#pragma unroll
                        for (int n = 0; n < 2; ++n) acc[a][b][m][n] = (f32x4){0.f, 0.f, 0.f, 0.f};
        }
        cur = nxt; cA = nA; cB = nB; ++ui;
        if (wr == 1) PG8_BAR;
    }
    PG8_WAIT_V(0);
    PG8_BAR;
#undef PG8_SA
#undef PG8_SB
#undef PG8_STAGE
#undef PG8_LDA
#undef PG8_LDB
#undef PG8_MMA
#undef PG8_WAIT_V
#undef PG8_WAIT_L
#undef PG8_BAR
#undef PG8_SCHED
}
}

typedef unsigned short bf16;
typedef float f32x4 __attribute__((ext_vector_type(4)));
typedef unsigned u32x4 __attribute__((ext_vector_type(4)));
typedef unsigned u32x2 __attribute__((ext_vector_type(2)));
#define LAS __attribute__((address_space(3)))

constexpr int BATCH = 4, SEQ = 8192, T = BATCH * SEQ, D = 1024, FF = 2816, NGU = 2 * FF, ZP = 6656, INW = 6664;
constexpr int ZQA = 0, ZKA = 1024, ZVA = 1280, ZQM = 1536, ZKM = 2048, ZVM = 2560, ZOM = 3584, ZGA = 4608, ZGM = 5632;
constexpr float RMS_EPS = 1e-5f;
constexpr size_t MiB = (size_t)1 << 20;
constexpr size_t WS_WA = 0, WS_WP = 17 * MiB, WS_ROPE = 23 * MiB, WS_GATE = 25 * MiB, WS_MISC = 26 * MiB, WS_HA = 28 * MiB, WS_Z = 92 * MiB, WS_END = 508 * MiB;
constexpr size_t WA_GU = 0, WA_DN = 11 * MiB;
constexpr int LDS_BYTES = 147456;
constexpr int NPHASE = 14;

struct Args {
    const float* in[21]; float* out; unsigned char* ws; float inv_freq[32]; int ph_lo, ph_hi;
};

__device__ __forceinline__ unsigned f2bf(float f) { unsigned u = __builtin_bit_cast(unsigned, f); return (u + 0x7fffu + ((u >> 16) & 1u)) >> 16; }
__device__ __forceinline__ unsigned pk2(float lo, float hi) { return f2bf(lo) | (f2bf(hi) << 16); }
__device__ __forceinline__ float bf2f(bf16 b) { return __uint_as_float((unsigned)b << 16); }
__device__ __forceinline__ float wave_sum(float v) {
#pragma unroll
    for (int o = 1; o < 64; o <<= 1) v += __shfl_xor(v, o);
    return v;
}

__device__ __forceinline__ void transpose_item(const float* W, int pitch, int src_col0, int K, bf16* WT, int dst_row0, int k0, LAS float* scr, int lane) {
#pragma unroll 8
    for (int i = 0; i < 32; ++i) { const int kk = 2 * i + (lane >> 5); scr[kk * 33 + (lane & 31)] = W[(size_t)(k0 + kk) * pitch + src_col0 + (lane & 31)]; }
    asm volatile("s_waitcnt lgkmcnt(0)" ::: "memory");
    const int c = lane & 7;
#pragma unroll
    for (int j = 0; j < 4; ++j) { const int n = (lane >> 3) + 8 * j; const LAS float* s = scr + (8 * c) * 33 + n;
        u32x4 o; o.x = pk2(s[0 * 33], s[1 * 33]); o.y = pk2(s[2 * 33], s[3 * 33]); o.z = pk2(s[4 * 33], s[5 * 33]); o.w = pk2(s[6 * 33], s[7 * 33]);
        *(u32x4*)(WT + (size_t)(dst_row0 + n) * K + k0 + 8 * c) = o; }
    asm volatile("s_waitcnt lgkmcnt(0)" ::: "memory");
}
__device__ __forceinline__ void convert_weight(const float* W, int pitch, int K, int nblk, bf16* WT, int mode, int gw, int NGW, LAS float* scr, int lane) {
    const int nitems = (K / 64) * nblk;
    for (int it = gw; it < nitems; it += NGW) {
        const int kb = it / nblk, nb = it % nblk; int src = 32 * nb, dst = 32 * nb;
        if (mode == 1) dst = 256 * (src >> 7) + (src & 127);
        else if (mode == 2) dst = 256 * (src >> 7) + (src & 127) + 128;
        else if (mode == 3) src = dst < 4608 ? dst : dst + 8;
        transpose_item(W, pitch, src, K, WT, dst, 64 * kb, scr, lane);
    }
}

__device__ __forceinline__ void norm_row(const float* xrow, const float* gain, bf16* orow, int lane, f32x4 (&v)[4]) {
    const f32x4* xr = (const f32x4*)xrow + lane; const f32x4* gr = (const f32x4*)gain + lane;
    float s = 0.f;
#pragma unroll
    for (int j = 0; j < 4; ++j) { v[j] = xr[64 * j]; s += (v[j].x * v[j].x + v[j].y * v[j].y) + (v[j].z * v[j].z + v[j].w * v[j].w); }
    const float rstd = 1.0f / sqrtf(wave_sum(s) * (1.0f / D) + RMS_EPS);
    unsigned long long* o8 = (unsigned long long*)orow + lane;
#pragma unroll
    for (int j = 0; j < 4; ++j) { const f32x4 g = gr[64 * j]; v[j] = v[j] * rstd * g;
        o8[64 * j] = (unsigned long long)pk2(v[j].x, v[j].y) | ((unsigned long long)pk2(v[j].z, v[j].w) << 32); }
}

namespace mm {
typedef short bf16x8 __attribute__((ext_vector_type(8)));
typedef short s16x4 __attribute__((ext_vector_type(4)));
typedef short v4i16_t __attribute__((ext_vector_type(4)));
typedef float f32x16 __attribute__((ext_vector_type(16)));
typedef float f32x8 __attribute__((ext_vector_type(8)));
typedef __bf16 bfv8 __attribute__((ext_vector_type(8)));
#define MFMA32(a, b, c) __builtin_amdgcn_mfma_f32_32x32x16_bf16((a), (b), (c), 0, 0, 0)
constexpr int PQ = 272, PV = 528;
__device__ __forceinline__ s16x4 vtr(const LAS unsigned char* p) { return __builtin_bit_cast(s16x4, __builtin_amdgcn_ds_read_tr16_b64_v4i16((LAS v4i16_t*)p)); }
__device__ __forceinline__ bf16x8 rowread(const LAS unsigned char* img, int pitch, int r0, int k0, int lane) { return *(const LAS bf16x8*)(img + (r0 + (lane & 31)) * pitch + (k0 + 8 * (lane >> 5)) * 2); }
template <bool PERM> __device__ __forceinline__ bf16x8 trread(const LAS unsigned char* img, int pitch, int k0, int c0, int lane) {
    const int h = lane >> 5, blk = (lane >> 4) & 1, q = (lane & 15) >> 2, p = lane & 3;
    const int rlo = PERM ? k0 + 4 * h + q : k0 + 8 * h + q, rhi = PERM ? k0 + 8 + 4 * h + q : k0 + 8 * h + 4 + q;
    const int cb = (c0 + 16 * blk + 4 * p) * 2;
    const s16x4 lo = vtr(img + rlo * pitch + cb), hi = vtr(img + rhi * pitch + cb);
    return __builtin_shufflevector(lo, hi, 0, 1, 2, 3, 4, 5, 6, 7);
}
__device__ __forceinline__ bf16x8 pack8(const f32x16& x, int s) {
    f32x8 v;
#pragma unroll
    for (int j = 0; j < 8; ++j) v[j] = x[8 * s + j];
    return __builtin_bit_cast(bf16x8, __builtin_convertvector(v, bfv8));
}
__device__ __forceinline__ void stage_conv(LAS unsigned char* img, const bf16* z, size_t tokb, int t0, int zcol0, const float* cw, const float* cbias, float scale, int tid) {
    const int cg8 = (tid & 15) * 8, lr = tid >> 4;
    float w[4][8], bb[8];
#pragma unroll
    for (int j = 0; j < 4; ++j) { const f32x4 a = *(const f32x4*)(cw + j * 1024 + cg8), b = *(const f32x4*)(cw + j * 1024 + cg8 + 4); w[j][0] = a.x; w[j][1] = a.y; w[j][2] = a.z; w[j][3] = a.w; w[j][4] = b.x; w[j][5] = b.y; w[j][6] = b.z; w[j][7] = b.w; }
    { const f32x4 a = *(const f32x4*)(cbias + cg8), b = *(const f32x4*)(cbias + cg8 + 4); bb[0] = a.x; bb[1] = a.y; bb[2] = a.z; bb[3] = a.w; bb[4] = b.x; bb[5] = b.y; bb[6] = b.z; bb[7] = b.w; }
    float r[7][8];
#pragma unroll
    for (int jj = 0; jj < 7; ++jj) { const int t = t0 + 4 * lr - 3 + jj; u32x4 v = {0u, 0u, 0u, 0u};
        if (t >= 0) v = *(const u32x4*)(z + (tokb + t) * ZP + zcol0 + cg8);
        r[jj][0] = pg8::bf_lo(v.x); r[jj][1] = pg8::bf_hi(v.x); r[jj][2] = pg8::bf_lo(v.y); r[jj][3] = pg8::bf_hi(v.y); r[jj][4] = pg8::bf_lo(v.z); r[jj][5] = pg8::bf_hi(v.z); r[jj][6] = pg8::bf_lo(v.w); r[jj][7] = pg8::bf_hi(v.w); }
#pragma unroll
    for (int i = 0; i < 4; ++i) { float y[8];
#pragma unroll
        for (int e = 0; e < 8; ++e) { float s = w[0][e] * r[i][e] + w[1][e] * r[i + 1][e] + w[2][e] * r[i + 2][e] + w[3][e] * r[i + 3][e] + bb[e]; y[e] = s / (1.0f + __expf(-s)) * scale; }
        u32x4 o; o.x = pk2(y[0], y[1]); o.y = pk2(y[2], y[3]); o.z = pk2(y[4], y[5]); o.w = pk2(y[6], y[7]);
        *(LAS u32x4*)(img + (4 * lr + i) * PQ + cg8 * 2) = o; }
}
template <bool SCALE> __device__ __forceinline__ void stage_v(LAS unsigned char* img, const bf16* z, size_t tok0, int h, const LAS float* aa, int tid) {
    const int v8 = (tid & 31) * 8, l0 = tid >> 5;
#pragma unroll
    for (int i = 0; i < 8; ++i) { const int l = l0 + 16 * i; u32x4 v = *(const u32x4*)(z + (tok0 + l) * ZP + ZVM + h * 256 + v8);
        if (SCALE) { const float a = aa[l]; v.x = pk2(pg8::bf_lo(v.x) * a, pg8::bf_hi(v.x) * a); v.y = pk2(pg8::bf_lo(v.y) * a, pg8::bf_hi(v.y) * a); v.z = pk2(pg8::bf_lo(v.z) * a, pg8::bf_hi(v.z) * a); v.w = pk2(pg8::bf_lo(v.w) * a, pg8::bf_hi(v.w) * a); }
        *(LAS u32x4*)(img + l * PV + v8 * 2) = v; }
}
constexpr int OFF_K1 = 0, OFF_V1 = 34816, OFF_F1 = 34816 + 67584;
__device__ __forceinline__ void dc_item(const bf16* z, const float* gates, const float* conv_w, const float* conv_b, bf16* dC, float* dn, float* mloc, float* bend, int item, LAS unsigned char* L, int tid, int lane, int wave) {
    const int b = item >> 8, h = (item >> 6) & 3, c = item & 63;
    const size_t tokb = (size_t)b * SEQ, tok0 = tokb + (size_t)c * 128;
    LAS unsigned char* kimg = L + OFF_K1; LAS unsigned char* vimg = L + OFF_V1; LAS float* lf = (LAS float*)(L + OFF_F1); LAS float* ig = lf + 128; LAS float* bc = lf + 256; LAS float* aa = lf + 384;
    __syncthreads();
    if (tid < 128) { lf[tid] = gates[(tok0 + tid) * 8 + 4 + h]; ig[tid] = gates[(tok0 + tid) * 8 + h]; }
    stage_conv(kimg, z, tokb, c * 128, ZKM + h * 128, conv_w + 512 + h * 128, conv_b + 512 + h * 128, 0.08838834764831845f, tid);
    __syncthreads();
    if (tid < 128) { float s = 0.f; for (int j = 0; j <= tid; ++j) s += lf[j]; bc[tid] = s; }
    __syncthreads();
    const float be = bc[127];
    if (tid < 128) aa[tid] = be - bc[tid] + ig[tid];
    __syncthreads();
    float ml = -INFINITY;
    for (int j = 0; j < 128; j += 4) { const f32x4 t = *(const LAS f32x4*)(aa + j); ml = fmaxf(ml, fmaxf(fmaxf(t.x, t.y), fmaxf(t.z, t.w))); }
    __syncthreads();
    if (tid < 128) aa[tid] = __expf(aa[tid] - ml);
    __syncthreads();
    stage_v<true>(vimg, z, tok0, h, aa, tid);
    __syncthreads();
    f32x16 acc[4];
#pragma unroll
    for (int dt = 0; dt < 4; ++dt)
#pragma unroll
        for (int i = 0; i < 16; ++i) acc[dt][i] = 0.f;
#pragma unroll
    for (int ks = 0; ks < 8; ++ks) { const bf16x8 bv = trread<false>(vimg, PV, 16 * ks, 32 * wave, lane);
#pragma unroll
        for (int dt = 0; dt < 4; ++dt) { const bf16x8 ak = trread<false>(kimg, PQ, 16 * ks, 32 * dt, lane); acc[dt] = MFMA32(ak, bv, acc[dt]); } }
    if (tid < 128) { float s = 0.f; for (int l = 0; l < 128; ++l) s += aa[l] * bf2f(*(const LAS bf16*)(kimg + l * PQ + tid * 2)); dn[(size_t)item * 128 + tid] = s; }
    if (tid == 0) { mloc[item] = ml; bend[item] = be; }
    const int r = lane & 31, hh = lane >> 5;
    bf16* orow = dC + (size_t)item * 32768 + (size_t)(32 * wave + r) * 128;
#pragma unroll
    for (int dt = 0; dt < 4; ++dt)
#pragma unroll
        for (int g = 0; g < 4; ++g) { u32x2 o; o.x = pk2(acc[dt][4 * g], acc[dt][4 * g + 1]); o.y = pk2(acc[dt][4 * g + 2], acc[dt][4 * g + 3]); *(u32x2*)(orow + 32 * dt + 8 * g + 4 * hh) = o; }
}
__device__ __forceinline__ void scan_phase(bf16* dC, float* dn, const float* mloc, const float* bend, float* mprev, int G, int tid) {
    for (int gidx = blockIdx.x * 512 + tid; gidx < 16 * 8192; gidx += G * 512) {
        const int bh = gidx >> 13, e4 = gidx & 8191;
        bf16* base = dC + (size_t)bh * 64 * 32768 + (size_t)e4 * 4;
        float C0 = 0.f, C1 = 0.f, C2 = 0.f, C3 = 0.f, m = 0.f;
        for (int c0 = 0; c0 < 64; c0 += 8) {
            u32x2 ld[8];
#pragma unroll
            for (int k = 0; k < 8; ++k) { const int c = c0 + k; ld[k] = (u32x2){0u, 0u}; if (c < 63) ld[k] = *(const u32x2*)(base + (size_t)c * 32768); }
#pragma unroll
            for (int k = 0; k < 8; ++k) { const int c = c0 + k;
                u32x2 o; o.x = pk2(C0, C1); o.y = pk2(C2, C3); *(u32x2*)(base + (size_t)c * 32768) = o;
                if (e4 == 0) mprev[bh * 64 + c] = m;
                if (c < 63) { const float ml = mloc[bh * 64 + c], be = bend[bh * 64 + c]; const float mn = fmaxf(be + m, ml), so = __expf(be + m - mn), sn = __expf(ml - mn);
                    C0 = so * C0 + sn * pg8::bf_lo(ld[k].x); C1 = so * C1 + sn * pg8::bf_hi(ld[k].x); C2 = so * C2 + sn * pg8::bf_lo(ld[k].y); C3 = so * C3 + sn * pg8::bf_hi(ld[k].y); m = mn; } }
        }
        if (gidx < 16 * 128) {
            const int bh2 = gidx >> 7, d = gidx & 127; float n = 0.f, m2 = 0.f;
            for (int c = 0; c < 64; ++c) { float* p = dn + (size_t)(bh2 * 64 + c) * 128 + d; const float dv = (c < 63) ? *p : 0.f; *p = n;
                if (c < 63) { const float ml = mloc[bh2 * 64 + c], be = bend[bh2 * 64 + c]; const float mn = fmaxf(be + m2, ml); n = __expf(be + m2 - mn) * n + __expf(ml - mn) * dv; m2 = mn; } }
        }
    }
}
constexpr int OFF_Q3 = 0, OFF_K3 = 34816, OFF_V3 = 69632, OFF_F3 = 69632 + 67584;
__device__ __forceinline__ void out_item(bf16* z, const float* gates, const float* conv_w, const float* conv_b, const bf16* Cprev, const float* nprev, const float* mprev, const float* hn, int item, LAS unsigned char* L, int tid, int lane, int wave) {
    const int b = item >> 8, h = (item >> 6) & 3, c = item & 63;
    const size_t tokb = (size_t)b * SEQ, tok0 = tokb + (size_t)c * 128;
    LAS unsigned char* qimg = L + OFF_Q3; LAS unsigned char* kimg = L + OFF_K3; LAS unsigned char* vimg = L + OFF_V3;
    LAS float* lf = (LAS float*)(L + OFF_F3); LAS float* ig = lf + 128; LAS float* bc = lf + 256; LAS float* uu = lf + 384; LAS float* gm = lf + 512; LAS float* np = lf + 640; LAS float* part = lf + 768;
    __syncthreads();
    if (tid < 128) { lf[tid] = gates[(tok0 + tid) * 8 + 4 + h]; ig[tid] = gates[(tok0 + tid) * 8 + h]; np[tid] = nprev[(size_t)item * 128 + tid]; }
    stage_conv(qimg, z, tokb, c * 128, ZQM + h * 128, conv_w + h * 128, conv_b + h * 128, 1.0f, tid);
    stage_conv(kimg, z, tokb, c * 128, ZKM + h * 128, conv_w + 512 + h * 128, conv_b + 512 + h * 128, 0.08838834764831845f, tid);
    stage_v<false>(vimg, z, tok0, h, nullptr, tid);
    __syncthreads();
    if (tid < 128) { float s = 0.f; for (int j = 0; j <= tid; ++j) s += lf[j]; bc[tid] = s; uu[tid] = ig[tid] - s; }
    __syncthreads();
    if (tid < 128) { float mx = -INFINITY; for (int j = 0; j <= tid; ++j) mx = fmaxf(mx, uu[j]); gm[tid] = mx; }
    __syncthreads();
    const float mp = mprev[item];
    const int lw = wave & 3, vw = wave >> 2, r = lane & 31, hh = lane >> 5, l = 32 * lw + r;
    const float b_l = bc[l], mt = fmaxf(b_l + gm[l], b_l + mp), inter = __expf(b_l + mp - mt), e0 = b_l - mt;
    f32x16 S[4];
#pragma unroll
    for (int st = 0; st < 4; ++st)
#pragma unroll
        for (int i = 0; i < 16; ++i) S[st][i] = 0.f;
#pragma unroll
    for (int ks = 0; ks < 8; ++ks) { const bf16x8 bq = rowread(qimg, PQ, 32 * lw, 16 * ks, lane);
#pragma unroll
        for (int st = 0; st < 4; ++st) if (st <= lw) { const bf16x8 ak = rowread(kimg, PQ, 32 * st, 16 * ks, lane); S[st] = MFMA32(ak, bq, S[st]); } }
    float dsum = 0.f;
#pragma unroll
    for (int st = 0; st < 4; ++st) if (st <= lw) {
#pragma unroll
        for (int g = 0; g < 4; ++g) { const int s0 = 32 * st + 8 * g + 4 * hh; const f32x4 u4 = *(const LAS f32x4*)(uu + s0);
#pragma unroll
            for (int e = 0; e < 4; ++e) { const float w = (s0 + e <= l) ? __expf(e0 + u4[e]) : 0.f; const float v = S[st][4 * g + e] * w; S[st][4 * g + e] = v; dsum += v; } } }
    dsum += __shfl_xor(dsum, 32);
    bf16x8 fr[4][2];
#pragma unroll
    for (int st = 0; st < 4; ++st) { fr[st][0] = pack8(S[st], 0); fr[st][1] = pack8(S[st], 1); }
    float qn = 0.f;
#pragma unroll
    for (int d8 = 0; d8 < 8; ++d8) { const bf16x8 qf = *(const LAS bf16x8*)(qimg + l * PQ + (64 * hh + 8 * d8) * 2); const f32x4 na = *(const LAS f32x4*)(np + 64 * hh + 8 * d8), nb = *(const LAS f32x4*)(np + 64 * hh + 8 * d8 + 4);
        qn += bf2f((bf16)qf[0]) * na.x + bf2f((bf16)qf[1]) * na.y + bf2f((bf16)qf[2]) * na.z + bf2f((bf16)qf[3]) * na.w + bf2f((bf16)qf[4]) * nb.x + bf2f((bf16)qf[5]) * nb.y + bf2f((bf16)qf[6]) * nb.z + bf2f((bf16)qf[7]) * nb.w; }
    qn += __shfl_xor(qn, 32);
    const float den = dsum + inter * qn, rden = 1.0f / fmaxf(fabsf(den), __expf(-mt));
    f32x16 O[4];
#pragma unroll
    for (int vt = 0; vt < 4; ++vt)
#pragma unroll
        for (int i = 0; i < 16; ++i) O[vt][i] = 0.f;
    const bf16* cp = Cprev + (size_t)item * 32768 + (size_t)(128 * vw + r) * 128 + 8 * hh;
#pragma unroll
    for (int ks = 0; ks < 8; ++ks) { const bf16x8 bq = rowread(qimg, PQ, 32 * lw, 16 * ks, lane);
#pragma unroll
        for (int vt = 0; vt < 4; ++vt) { const bf16x8 ac = *(const bf16x8*)(cp + vt * 4096 + 16 * ks); O[vt] = MFMA32(ac, bq, O[vt]); } }
#pragma unroll
    for (int vt = 0; vt < 4; ++vt)
#pragma unroll
        for (int i = 0; i < 16; ++i) O[vt][i] *= inter;
#pragma unroll
    for (int st = 0; st < 4; ++st) if (st <= lw) {
#pragma unroll
        for (int s2 = 0; s2 < 2; ++s2)
#pragma unroll
            for (int vt = 0; vt < 4; ++vt) { const bf16x8 av = trread<true>(vimg, PV, 32 * st + 16 * s2, 128 * vw + 32 * vt, lane); O[vt] = MFMA32(av, fr[st][s2], O[vt]); } }
    float ss = 0.f;
#pragma unroll
    for (int vt = 0; vt < 4; ++vt)
#pragma unroll
        for (int i = 0; i < 16; ++i) { const float v = O[vt][i] * rden; O[vt][i] = v; ss += v * v; }
    ss += __shfl_xor(ss, 32);
    if (hh == 0) part[vw * 128 + l] = ss;
    __syncthreads();
    const float rstd = 1.0f / sqrtf((part[l] + part[128 + l]) * (1.0f / 256.0f) + RMS_EPS);
    bf16* orow = z + (tok0 + l) * ZP + ZOM + h * 256;
#pragma unroll
    for (int vt = 0; vt < 4; ++vt)
#pragma unroll
        for (int g = 0; g < 4; ++g) { const int v0 = 128 * vw + 32 * vt + 8 * g + 4 * hh; const u32x2 ow = *(const u32x2*)(orow + v0); const f32x4 gn = *(const f32x4*)(hn + h * 256 + v0);
            const float r0 = O[vt][4 * g] * rstd * gn.x / (1.0f + __expf(-pg8::bf_lo(ow.x))), r1 = O[vt][4 * g + 1] * rstd * gn.y / (1.0f + __expf(-pg8::bf_hi(ow.x)));
            const float r2 = O[vt][4 * g + 2] * rstd * gn.z / (1.0f + __expf(-pg8::bf_lo(ow.y))), r3 = O[vt][4 * g + 3] * rstd * gn.w / (1.0f + __expf(-pg8::bf_hi(ow.y)));
            u32x2 o; o.x = pk2(r0, r1); o.y = pk2(r2, r3); *(u32x2*)(orow + v0) = o; }
}
}


namespace at {
using namespace mm;
constexpr int PK = 144;
constexpr int OFF_K = 0, OFF_V = 256 * PK;
__device__ __forceinline__ void unpack8(const u32x4 v, float (&x)[8]) { x[0] = pg8::bf_lo(v.x); x[1] = pg8::bf_hi(v.x); x[2] = pg8::bf_lo(v.y); x[3] = pg8::bf_hi(v.y); x[4] = pg8::bf_lo(v.z); x[5] = pg8::bf_hi(v.z); x[6] = pg8::bf_lo(v.w); x[7] = pg8::bf_hi(v.w); }
__device__ __forceinline__ void load8f(const float* p, float (&x)[8]) { const f32x4 a = *(const f32x4*)p, b = *(const f32x4*)(p + 4); x[0] = a.x; x[1] = a.y; x[2] = a.z; x[3] = a.w; x[4] = b.x; x[5] = b.y; x[6] = b.z; x[7] = b.w; }
__device__ __forceinline__ bf16x8 cvt8(const float (&y)[8]) { f32x8 v;
#pragma unroll
    for (int e = 0; e < 8; ++e) v[e] = y[e];
    return __builtin_bit_cast(bf16x8, __builtin_convertvector(v, bfv8)); }
__device__ __forceinline__ void attn_item(bf16* z, const float* rope_cos, const float* rope_sin, const float* sinks, int item, LAS unsigned char* L, int tid, int lane, int wave) {
    const int hk = item & 3, n = (item >> 2) & 63, b = item >> 8;
    const size_t tok0 = (size_t)b * SEQ + (size_t)n * 128;
    LAS unsigned char* kimg = L + OFF_K; LAS unsigned char* vimg = L + OFF_V;
    __syncthreads();
    for (int idx = tid; idx < 1024; idx += 512) {
        const int key = idx >> 2, c8 = (idx & 3) * 8;
        bf16x8 o1 = {0, 0, 0, 0, 0, 0, 0, 0}, o2 = {0, 0, 0, 0, 0, 0, 0, 0};
        if (n > 0 || key >= 128) {
            const bf16* zr = z + (tok0 + key - 128) * ZP + ZKA + hk * 64;
            float x1[8], x2[8], cs[8], sn[8], y1[8], y2[8];
            unpack8(*(const u32x4*)(zr + c8), x1); unpack8(*(const u32x4*)(zr + c8 + 32), x2);
            const int pos = n * 128 + key - 128;
            load8f(rope_cos + pos * 32 + c8, cs); load8f(rope_sin + pos * 32 + c8, sn);
#pragma unroll
            for (int e = 0; e < 8; ++e) { y1[e] = x1[e] * cs[e] - x2[e] * sn[e]; y2[e] = x2[e] * cs[e] + x1[e] * sn[e]; }
            o1 = cvt8(y1); o2 = cvt8(y2);
        }
        *(LAS bf16x8*)(kimg + key * PK + c8 * 2) = o1; *(LAS bf16x8*)(kimg + key * PK + (c8 + 32) * 2) = o2;
    }
    for (int idx = tid; idx < 2048; idx += 512) {
        const int key = idx >> 3, c8 = (idx & 7) * 8; u32x4 v = {0u, 0u, 0u, 0u};
        if (n > 0 || key >= 128) v = *(const u32x4*)(z + (tok0 + key - 128) * ZP + ZVA + hk * 64 + c8);
        *(LAS u32x4*)(vimg + key * PK + c8 * 2) = v;
    }
    __syncthreads();
    const int r = lane & 31, hh = lane >> 5;
#pragma unroll 1
    for (int gsel = 0; gsel < 2; ++gsel) {
        const int gi = wave + 8 * gsel, g = gi >> 2, j = gi & 3, head = hk * 4 + g;
        bf16* qrow = z + (tok0 + 32 * j + r) * ZP + ZQA + head * 64; const int pos = n * 128 + 32 * j + r;
        u32x4 raw[4];
#pragma unroll
        for (int ks = 0; ks < 4; ++ks) raw[ks] = *(const u32x4*)(qrow + 16 * ks + 8 * hh);
        bf16x8 qf[4];
#pragma unroll
        for (int k2 = 0; k2 < 2; ++k2) { float x1[8], x2[8], cs[8], sn[8], y1[8], y2[8];
            unpack8(raw[k2], x1); unpack8(raw[k2 + 2], x2); load8f(rope_cos + pos * 32 + 16 * k2 + 8 * hh, cs); load8f(rope_sin + pos * 32 + 16 * k2 + 8 * hh, sn);
#pragma unroll
            for (int e = 0; e < 8; ++e) { y1[e] = (x1[e] * cs[e] - x2[e] * sn[e]) * 0.125f; y2[e] = (x2[e] * cs[e] + x1[e] * sn[e]) * 0.125f; }
            qf[k2] = cvt8(y1); qf[k2 + 2] = cvt8(y2); }
        f32x16 S[5];
#pragma unroll
        for (int kt = 0; kt < 5; ++kt)
#pragma unroll
            for (int i = 0; i < 16; ++i) S[kt][i] = 0.f;
#pragma unroll
        for (int ks = 0; ks < 4; ++ks)
#pragma unroll
            for (int kt = 0; kt < 5; ++kt) { const bf16x8 ak = rowread(kimg, PK, 32 * (j + kt), 16 * ks, lane); S[kt] = MFMA32(ak, qf[ks], S[kt]); }
        const float sink = sinks[head]; float mx = sink;
#pragma unroll
        for (int kt = 0; kt < 5; ++kt)
#pragma unroll
            for (int i = 0; i < 16; ++i) { const int cr = (i & 3) + 8 * (i >> 2) + 4 * hh; bool ok = (kt == 0) ? (cr > r) : (kt == 4) ? (cr <= r) : true; if (n == 0 && j + kt < 4) ok = false;
                const float s = ok ? S[kt][i] : -INFINITY; S[kt][i] = s; mx = fmaxf(mx, s); }
        mx = fmaxf(mx, __shfl_xor(mx, 32));
        float sum = 0.f;
#pragma unroll
        for (int kt = 0; kt < 5; ++kt)
#pragma unroll
            for (int i = 0; i < 16; ++i) { const float p = __expf(S[kt][i] - mx); S[kt][i] = p; sum += p; }
        sum += __shfl_xor(sum, 32); sum += __expf(sink - mx);
        const float inv = 1.0f / sum;
        f32x16 O[2];
#pragma unroll
        for (int dt = 0; dt < 2; ++dt)
#pragma unroll
            for (int i = 0; i < 16; ++i) O[dt][i] = 0.f;
#pragma unroll
        for (int kt = 0; kt < 5; ++kt)
#pragma unroll
            for (int s2 = 0; s2 < 2; ++s2) { const bf16x8 pf = pack8(S[kt], s2);
#pragma unroll
                for (int dt = 0; dt < 2; ++dt) { const bf16x8 av = trread<true>(vimg, PK, 32 * (j + kt) + 16 * s2, 32 * dt, lane); O[dt] = MFMA32(av, pf, O[dt]); } }
#pragma unroll
        for (int dt = 0; dt < 2; ++dt)
#pragma unroll
            for (int g4 = 0; g4 < 4; ++g4) { u32x2 o; o.x = pk2(O[dt][4 * g4] * inv, O[dt][4 * g4 + 1] * inv); o.y = pk2(O[dt][4 * g4 + 2] * inv, O[dt][4 * g4 + 3] * inv); *(u32x2*)(qrow + 32 * dt + 8 * g4 + 4 * hh) = o; }
    }
}
}


#define XB_TMO      128
#define XB_XCNT(j)  (256  + 64 * (j))
#define XB_XSUB(j)  (1280 + 64 * (j))
#define XB_XGEN(j)  (2304 + 64 * (j))
#define XB_TOP      3328
#define XB_TOPGEN   3392
#define XCD_BAR_WORDS 3456
#define XB_SPIN_CAP (1u << 18)
__device__ __forceinline__ unsigned xb_ld(unsigned* p)              { return __hip_atomic_load(p, __ATOMIC_RELAXED, __HIP_MEMORY_SCOPE_AGENT); }
__device__ __forceinline__ unsigned xb_add(unsigned* p, unsigned v) { return __hip_atomic_fetch_add(p, v, __ATOMIC_RELAXED, __HIP_MEMORY_SCOPE_AGENT); }
__device__ __forceinline__ unsigned xb_xcc_id() { return (unsigned)__builtin_amdgcn_s_getreg((3 << 11) | 20) & 0xFu; }
#define XB_SPIN(cond, bar) do { unsigned _sp = 0; while (cond) { __builtin_amdgcn_s_sleep(1); \
    if ((++_sp & 255u) == 0u) { if (xb_ld(&(bar)[XB_TMO])) break; if (_sp > XB_SPIN_CAP) { atomicAdd(&(bar)[XB_TMO], 1u); break; } } } } while (0)
struct XcdBarrier { unsigned* bar; unsigned x; volatile LAS unsigned* st; };
__device__ __forceinline__ XcdBarrier xcd_barrier_post(unsigned* bar, volatile LAS unsigned* st) {
    XcdBarrier b; b.bar = bar; b.x = xb_xcc_id(); b.st = st;
    if (threadIdx.x == 0) (void)xb_add(&bar[XB_XCNT(b.x)], 1u);
    return b;
}
__device__ __forceinline__ void xcd_barrier_complete(unsigned* bar, unsigned x, unsigned& nloc, unsigned& nx) {
    const unsigned G = gridDim.x * gridDim.y * gridDim.z;
    unsigned sum, cnt, mine, sp = 0u;
    for (;;) {
        sum = 0u; cnt = 0u; mine = 0u;
#pragma unroll
        for (unsigned j = 0; j < 16; ++j) { const unsigned c = xb_ld(&bar[XB_XCNT(j)]); sum += c; cnt += (c > 0u) ? 1u : 0u; mine = (j == x) ? c : mine; }
        if (sum == G) break;
        __builtin_amdgcn_s_sleep(1);
        if ((++sp & 255u) == 0u) { if (xb_ld(&bar[XB_TMO])) break; if (sp > XB_SPIN_CAP) { atomicAdd(&bar[XB_TMO], 1u); break; } }
    }
    nloc = mine > 0u ? mine : 1u; nx = cnt > 0u ? cnt : 1u;
}
__device__ __forceinline__ void xcd_barrier(const XcdBarrier& b) {
    asm volatile("s_waitcnt vmcnt(0)" ::: "memory");
    __syncthreads();
    if (threadIdx.x == 0) {
        unsigned* bar = b.bar;
        __builtin_amdgcn_s_waitcnt(0);
        unsigned nloc = b.st[0], nx = b.st[1];
        if (nloc == 0u) { xcd_barrier_complete(bar, b.x, nloc, nx); b.st[0] = nloc; b.st[1] = nx; }
        const unsigned old = xb_add(&bar[XB_XSUB(b.x)], 1u);
        const unsigned gen = old / nloc;
        if (old + 1u == (gen + 1u) * nloc) {
            __builtin_amdgcn_fence(__ATOMIC_RELEASE, "agent");
            asm volatile("s_waitcnt vmcnt(0)" ::: "memory");
            const unsigned og = xb_add(&bar[XB_TOP], 1u);
            const unsigned tg = og / nx;
            if (og + 1u == (tg + 1u) * nx) xb_add(&bar[XB_TOPGEN], 1u);
            else XB_SPIN(xb_ld(&bar[XB_TOPGEN]) == tg, bar);
            __builtin_amdgcn_fence(__ATOMIC_ACQUIRE, "agent");
            xb_add(&bar[XB_XGEN(b.x)], 1u);
            asm volatile("s_waitcnt vmcnt(0)" ::: "memory");
        } else {
            XB_SPIN(xb_ld(&bar[XB_XGEN(b.x)]) == gen, bar);
            __builtin_amdgcn_fence(__ATOMIC_ACQUIRE, "agent");
            asm volatile("s_waitcnt vmcnt(0)" ::: "memory");
        }
    }
    __syncthreads();
}

__global__ void __launch_bounds__(512, 2) mega_fwd(Args args) {
    extern __shared__ __attribute__((aligned(16))) unsigned char lds[];
    cg::grid_group grid = cg::this_grid();
    const int tid = threadIdx.x, lane = tid & 63, wave = __builtin_amdgcn_readfirstlane(tid >> 6);
    const int G = gridDim.x, gw = blockIdx.x * 8 + wave, NGW = G * 8;
    unsigned char* ws = args.ws;
    const float* x = args.in[0];
    float* out = args.out;
    bf16* WA = (bf16*)(ws + WS_WA); bf16* Wgu = (bf16*)(ws + WS_WA + WA_GU); bf16* Wdn = (bf16*)(ws + WS_WA + WA_DN);
    bf16* Watt = (bf16*)(ws + WS_WP); bf16* Wml = (bf16*)(ws + WS_WP + 2 * MiB); bf16* Wout = (bf16*)(ws + WS_WP + 4 * MiB);
    float* rope_cos = (float*)(ws + WS_ROPE); float* rope_sin = rope_cos + SEQ * 32;
    float* gates = (float*)(ws + WS_GATE);
    float* dnb = (float*)(ws + WS_MISC); float* mlocb = dnb + 1024 * 128; float* bendb = mlocb + 1024; float* mprevb = bendb + 1024;
    bf16* hA = (bf16*)(ws + WS_HA); bf16* Z = (bf16*)(ws + WS_Z); bf16* HID = (bf16*)(ws + WS_Z);
    LAS float* scr = (LAS float*)((LAS unsigned char*)lds + wave * 16384);
    const int lo = args.ph_lo, hi = args.ph_hi;
#define IN(k) (lo <= (k) && (k) < hi)
    unsigned* barw = (unsigned*)(ws + WS_MISC + MiB);
    volatile LAS unsigned* bst = (volatile LAS unsigned*)((LAS unsigned char*)lds + LDS_BYTES - 16);
    if (lo == 0) {
        if (blockIdx.x == 0) for (int u = tid; u < XCD_BAR_WORDS; u += 512) barw[u] = 0u;
        if (tid < 2) bst[tid] = 0u;
    }
    XcdBarrier xbar; xbar.bar = barw; xbar.x = 0; xbar.st = bst;
#define SEAM(k) do { if (IN(k) && IN((k) + 1)) { if ((k) == 0) { grid.sync(); xbar = xcd_barrier_post(barw, bst); } else xcd_barrier(xbar); } } while (0)

    if (IN(0)) {
        convert_weight(args.in[2], FF, D, FF / 32, Wgu, 1, gw, NGW, scr, lane);
        convert_weight(args.in[3], FF, D, FF / 32, Wgu, 2, gw, NGW, scr, lane);
        convert_weight(args.in[4], D, FF, D / 32, Wdn, 0, gw, NGW, scr, lane);
        convert_weight(args.in[13], D, D, D / 32, Watt, 0, gw, NGW, scr, lane);
        convert_weight(args.in[14], D, D, D / 32, Wml, 0, gw, NGW, scr, lane);
        convert_weight(args.in[15], D, D, D / 32, Wout, 0, gw, NGW, scr, lane);
        for (int idx = blockIdx.x * 512 + tid; idx < SEQ * 32; idx += G * 512) {
            const int pos = idx >> 5, i = idx & 31;
            const float angf = (float)pos * args.inv_freq[i];
            const double ang = (double)angf;
            const double kq = rint(ang * 0.63661977236758134308);
            const double y = (ang - kq * 1.57079632679489655800) - kq * 6.123233995736766e-17;
            const double y2 = y * y;
            const double sy = y * (1.0 + y2 * (-1.0 / 6 + y2 * (1.0 / 120 + y2 * (-1.0 / 5040 + y2 * (1.0 / 362880 + y2 * (-1.0 / 39916800 + y2 * (1.0 / 6227020800.0)))))));
            const double cy = 1.0 + y2 * (-0.5 + y2 * (1.0 / 24 + y2 * (-1.0 / 720 + y2 * (1.0 / 40320 + y2 * (-1.0 / 3628800 + y2 * (1.0 / 479001600.0 + y2 * (-1.0 / 87178291200.0)))))));
            const long long qi = (long long)kq; const int qd = (int)(qi & 3);
            const double sn = qd == 0 ? sy : qd == 1 ? cy : qd == 2 ? -sy : -cy;
            const double cs = qd == 0 ? cy : qd == 1 ? -sy : qd == 2 ? -cy : sy;
            rope_cos[idx] = (float)cs; rope_sin[idx] = (float)sn;
        }
        for (int r = gw; r < T; r += NGW) { f32x4 v[4]; norm_row(x + (size_t)r * D, args.in[1], hA + (size_t)r * D, lane, v); }
    }
    SEAM(0);
    if (IN(1)) {
        pg8::Gemm g{hA, hA, Wgu, Wgu, D, D}; pg8::StaticOrder S; S.init(T, NGU, G, (int)blockIdx.x);
        pg8::EpiSwiGLU E{HID, FF};
        pg8::gemm_phase<pg8::EpiSwiGLU, pg8::StaticOrder>((PG8_LAS unsigned char*)lds, g, S, E);
    }
    SEAM(1);
    if (IN(2)) {
        pg8::Gemm g{HID, HID, Wdn, Wdn, FF, FF}; pg8::StaticOrder S; S.init(T, D, G, (int)blockIdx.x);
        pg8::EpiResid E{x, out, D, 0.5f};
        pg8::gemm_phase<pg8::EpiResid, pg8::StaticOrder>((PG8_LAS unsigned char*)lds, g, S, E);
    }
    SEAM(2);
    if (IN(3)) {
        convert_weight(args.in[6], INW, D, ZP / 32, WA, 3, gw, NGW, scr, lane);
        const float* win = args.in[6];
        for (int r = gw; r < T; r += NGW) {
            f32x4 v[4]; norm_row(out + (size_t)r * D, args.in[5], hA + (size_t)r * D, lane, v);
            float gsum[8];
#pragma unroll
            for (int e = 0; e < 8; ++e) gsum[e] = 0.f;
#pragma unroll
            for (int j = 0; j < 4; ++j)
#pragma unroll
                for (int e = 0; e < 4; ++e) { const int k = 256 * j + 4 * lane + e; const f32x4 wa = *(const f32x4*)(win + (size_t)k * INW + 4608), wb = *(const f32x4*)(win + (size_t)k * INW + 4612); const float hv = v[j][e];
                    gsum[0] += hv * wa.x; gsum[1] += hv * wa.y; gsum[2] += hv * wa.z; gsum[3] += hv * wa.w; gsum[4] += hv * wb.x; gsum[5] += hv * wb.y; gsum[6] += hv * wb.z; gsum[7] += hv * wb.w; }
#pragma unroll
            for (int e = 0; e < 8; ++e) gsum[e] = wave_sum(gsum[e]);
            if (lane < 8) {
                float val = lane == 0 ? gsum[0] : lane == 1 ? gsum[1] : lane == 2 ? gsum[2] : lane == 3 ? gsum[3] : lane == 4 ? gsum[4] : lane == 5 ? gsum[5] : lane == 6 ? gsum[6] : gsum[7];
                if (lane < 4) val += args.in[7][lane];
                else { const float xx = val + args.in[8][lane - 4]; val = fminf(xx, 0.f) - log1pf(expf(-fabsf(xx))); }
                gates[(size_t)r * 8 + lane] = val;
            }
        }
    }
    SEAM(3);
    if (IN(4)) {
        pg8::Gemm g{hA, hA, WA, WA, D, D}; pg8::StaticOrder S; S.init(T, ZP, G, (int)blockIdx.x);
        pg8::EpiBf16 E{Z, ZP};
        pg8::gemm_phase<pg8::EpiBf16, pg8::StaticOrder>((PG8_LAS unsigned char*)lds, g, S, E);
    }
    SEAM(4);
    if (IN(5)) {
        for (int it = blockIdx.x; it < 1024; it += G) if ((it & 63) != 63) mm::dc_item(Z, gates, args.in[10], args.in[11], hA, dnb, mlocb, bendb, it, (LAS unsigned char*)lds, tid, lane, wave);
        for (int it = blockIdx.x; it < 1024; it += G) at::attn_item(Z, rope_cos, rope_sin, args.in[9], it, (LAS unsigned char*)lds, tid, lane, wave);
    }
    SEAM(5);
    if (IN(6)) {
        __syncthreads();
        mm::scan_phase(hA, dnb, mlocb, bendb, mprevb, G, tid);
        convert_weight(args.in[17], FF, D, FF / 32, Wgu, 1, gw, NGW, scr, lane);
        convert_weight(args.in[18], FF, D, FF / 32, Wgu, 2, gw, NGW, scr, lane);
        convert_weight(args.in[19], D, FF, D / 32, Wdn, 0, gw, NGW, scr, lane);
    }
    SEAM(6);
    if (IN(7)) {
        for (int it = blockIdx.x; it < 1024; it += G) mm::out_item(Z, gates, args.in[10], args.in[11], hA, dnb, mprevb, args.in[12], it, (LAS unsigned char*)lds, tid, lane, wave);
    }
    SEAM(7);
    if (IN(8)) {
        pg8::Gemm g{Z + ZQA, Z + ZOM, Watt, Wml, ZP, D}; pg8::PairOrder S; S.so.init(T, D, G, (int)blockIdx.x);
        pg8::EpiMix E{Z, Z + ZQM, ZP, ZGA, ZGM};
        pg8::gemm_phase<pg8::EpiMix, pg8::PairOrder>((PG8_LAS unsigned char*)lds, g, S, E);
    }
    SEAM(8);
    if (IN(9)) {
        pg8::Gemm g{Z + ZQM, Z + ZQM, Wout, Wout, ZP, D}; pg8::StaticOrder S; S.init(T, D, G, (int)blockIdx.x);
        pg8::EpiResid E{out, out, D, 1.0f};
        pg8::gemm_phase<pg8::EpiResid, pg8::StaticOrder>((PG8_LAS unsigned char*)lds, g, S, E);
    }
    SEAM(9);
    if (IN(10)) {
        for (int r = gw; r < T; r += NGW) { f32x4 v[4]; norm_row(out + (size_t)r * D, args.in[16], hA + (size_t)r * D, lane, v); }
    }
    SEAM(10);
    if (IN(11)) {
        pg8::Gemm g{hA, hA, Wgu, Wgu, D, D}; pg8::StaticOrder S; S.init(T, NGU, G, (int)blockIdx.x);
        pg8::EpiSwiGLU E{HID, FF};
        pg8::gemm_phase<pg8::EpiSwiGLU, pg8::StaticOrder>((PG8_LAS unsigned char*)lds, g, S, E);
    }
    SEAM(11);
    if (IN(12)) {
        pg8::Gemm g{HID, HID, Wdn, Wdn, FF, FF}; pg8::StaticOrder S; S.init(T, D, G, (int)blockIdx.x);
        pg8::EpiResid E{out, out, D, 0.5f};
        pg8::gemm_phase<pg8::EpiResid, pg8::StaticOrder>((PG8_LAS unsigned char*)lds, g, S, E);
    }
    SEAM(12);
    if (IN(13)) {
        const float* gain = args.in[20];
        for (int r = gw; r < T; r += NGW) {
            f32x4* xr = (f32x4*)(out + (size_t)r * D) + lane; const f32x4* gr = (const f32x4*)gain + lane;
            f32x4 v[4]; float s = 0.f;
#pragma unroll
            for (int j = 0; j < 4; ++j) { v[j] = xr[64 * j]; s += (v[j].x * v[j].x + v[j].y * v[j].y) + (v[j].z * v[j].z + v[j].w * v[j].w); }
            const float rstd = 1.0f / sqrtf(wave_sum(s) * (1.0f / D) + RMS_EPS);
#pragma unroll
            for (int j = 0; j < 4; ++j) xr[64 * j] = v[j] * rstd * gr[64 * j];
        }
    }
#undef IN
#undef SEAM
}

extern "C" void kernel_launch(void* const* d_in, const int* in_sizes, int n_in, void* d_out, int out_size, void* d_ws, size_t ws_size, hipStream_t stream) {
    static int grid = 0;
    if (grid == 0) {
        if (n_in != 21 || out_size != T * D || ws_size < WS_END) { fprintf(stderr, "kernel_launch: unexpected shapes (n_in %d out %d ws %zu)\n", n_in, out_size, ws_size); grid = -1; return; }
        int dev = 0, cus = 0, per_cu = 0;
        hipGetDevice(&dev); hipDeviceGetAttribute(&cus, hipDeviceAttributeMultiprocessorCount, dev);
        if (hipFuncSetAttribute((const void*)mega_fwd, hipFuncAttributeMaxDynamicSharedMemorySize, LDS_BYTES) != hipSuccess) { fprintf(stderr, "kernel_launch: hipFuncSetAttribute failed\n"); grid = -1; return; }
        if (hipOccupancyMaxActiveBlocksPerMultiprocessor(&per_cu, (const void*)mega_fwd, 512, LDS_BYTES) != hipSuccess || per_cu < 1) { fprintf(stderr, "kernel_launch: occupancy query failed (%d)\n", per_cu); per_cu = 1; }
        (void)hipGetLastError();
        grid = cus * per_cu;
    }
    if (grid < 0) return;
    Args a{};
    for (int i = 0; i < 21; ++i) a.in[i] = (const float*)d_in[i];
    a.out = (float*)d_out; a.ws = (unsigned char*)d_ws;
    for (int i = 0; i < 32; ++i) a.inv_freq[i] = (float)pow(10000.0, -(double)i / 32.0);
#if MK_PER_PHASE_LAUNCH
    for (int ph = 0; ph < NPHASE; ++ph) { a.ph_lo = ph; a.ph_hi = ph + 1; hipLaunchKernelGGL(mega_fwd, dim3(grid), dim3(512), LDS_BYTES, stream, a); }
#else
    a.ph_lo = 0; a.ph_hi = NPHASE;
    void* kargs[] = {&a};
    hipError_t e = hipLaunchCooperativeKernel((const void*)mega_fwd, dim3(grid), dim3(512), kargs, LDS_BYTES, stream);
    if (e != hipSuccess) fprintf(stderr, "kernel_launch: cooperative launch failed: %s (grid %d)\n", hipGetErrorString(e), grid);
#endif
}
```

```cpp
#include <hip/hip_runtime.h>
#include <hip/hip_cooperative_groups.h>
#include <cstdio>
#include <cstdint>
#include <cmath>
namespace cg = cooperative_groups;

#ifndef MK_PER_PHASE_LAUNCH
#define MK_PER_PHASE_LAUNCH 0
#endif

namespace pg8 {
#define PG8_LAS __attribute__((address_space(3)))
typedef unsigned short bf16_t;
typedef short bf16x8 __attribute__((ext_vector_type(8)));
typedef float f32x4 __attribute__((ext_vector_type(4)));
typedef unsigned u32x4 __attribute__((ext_vector_type(4)));
constexpr int BM = 256, BK = 64, HALF = 128, HTB = HALF * BK * 2, STAGE_BYTES = 8 * HTB, NXCD = 8, WGM = 8;

__host__ __device__ __forceinline__ int lds_byte(int r, int c) { const int st = (r >> 4) * 2 + (c >> 5), rr = r & 15, cc = c & 31, ob = rr * 64 + cc * 2; return st * 1024 + (ob ^ (((ob >> 9) & 1) << 5)); }
__host__ __device__ __forceinline__ void stage_rc(int b, int& R, int& C) { const int st = b / 1024, sb = b % 1024, swz = sb ^ (((sb >> 9) & 1) << 5); R = (st >> 1) * 16 + swz / 64; C = (st & 1) * 32 + (swz % 64) / 2; }
__host__ __device__ __forceinline__ int perm32(int rho) { const int n = rho >> 4, i = rho & 15; return 8 * (i >> 2) + 4 * n + (i & 3); }

struct Unit { int pm, pn, kind; };
struct Gemm { const bf16_t* A0; const bf16_t* A1; const bf16_t* B0; const bf16_t* B1; int lda, K; };

struct StaticOrder {
    int nM, nN, nwg, G, c;
    __host__ __device__ void init(int M, int N, int G_, int c_) { nM = M / BM; nN = N / BM; nwg = nM * nN; G = G_; c = c_; }
    __host__ __device__ bool next(int i, Unit& u) const {
        const long L = (long)i * G + c; if (L >= nwg) return false;
        int wgid = (int)L; { const int q = nwg / NXCD, r = nwg % NXCD, xcd = wgid % NXCD, off = wgid / NXCD; wgid = (xcd < r ? xcd * (q + 1) : r * (q + 1) + (xcd - r) * q) + off; }
        const int nig = WGM * nN, gid = wgid / nig, fm = gid * WGM, gsz = (nM - fm) < WGM ? (nM - fm) : WGM;
        u.pm = fm + ((wgid % nig) % gsz); u.pn = (wgid % nig) / gsz; u.kind = 0; return true;
    }
};
struct PairOrder {
    StaticOrder so;
    __host__ __device__ bool next(int i, Unit& u) const { if (!so.next(i >> 1, u)) return false; u.kind = i & 1; return true; }
};

__device__ __forceinline__ unsigned cvt_pk_bf16(float lo, float hi) { unsigned r; asm volatile("v_cvt_pk_bf16_f32 %0, %1, %2" : "=v"(r) : "v"(lo), "v"(hi)); return r; }
__device__ __forceinline__ float bf_lo(unsigned w) { return __uint_as_float(w << 16); }
__device__ __forceinline__ float bf_hi(unsigned w) { return __uint_as_float(w & 0xffff0000u); }
__device__ __forceinline__ float sigmoid_den(float x) { return 1.0f + __expf(-x); }


struct EpiBf16 {
    bf16_t* O; int ldc;
    __device__ __forceinline__ bool operator()(f32x4 (&acc)[2][2][4][2], const Unit& u, int wr, int wc, int fr, int fq) const {
        const int row0 = u.pm * BM + wr * 64 + fr, col0 = u.pn * BM + wc * 32 + 8 * fq;
#pragma unroll
        for (int ai = 0; ai < 2; ++ai)
#pragma unroll
            for (int m = 0; m < 4; ++m) { bf16_t* rowp = O + (size_t)(row0 + ai * HALF + m * 16) * ldc + col0;
#pragma unroll
                for (int bj = 0; bj < 2; ++bj) { const f32x4 v0 = acc[ai][bj][m][0], v1 = acc[ai][bj][m][1];
                    u32x4 w; w.x = cvt_pk_bf16(v0[0], v0[1]); w.y = cvt_pk_bf16(v0[2], v0[3]); w.z = cvt_pk_bf16(v1[0], v1[1]); w.w = cvt_pk_bf16(v1[2], v1[3]);
                    *(u32x4*)(rowp + bj * HALF) = w; } }
        return true;
    }
};
struct EpiSwiGLU {
    bf16_t* O; int ldc;
    __device__ __forceinline__ bool operator()(f32x4 (&acc)[2][2][4][2], const Unit& u, int wr, int wc, int fr, int fq) const {
        const int row0 = u.pm * BM + wr * 64 + fr, col0 = u.pn * HALF + wc * 32 + 8 * fq;
#pragma unroll
        for (int ai = 0; ai < 2; ++ai)
#pragma unroll
            for (int m = 0; m < 4; ++m) { bf16_t* rowp = O + (size_t)(row0 + ai * HALF + m * 16) * ldc + col0;
                float r[8];
#pragma unroll
                for (int n = 0; n < 2; ++n)
#pragma unroll
                    for (int e = 0; e < 4; ++e) { const float g = acc[ai][0][m][n][e], up = acc[ai][1][m][n][e]; r[4 * n + e] = g * __builtin_amdgcn_rcpf(1.0f + __expf(-g)) * up; }
                u32x4 w; w.x = cvt_pk_bf16(r[0], r[1]); w.y = cvt_pk_bf16(r[2], r[3]); w.z = cvt_pk_bf16(r[4], r[5]); w.w = cvt_pk_bf16(r[6], r[7]);
                *(u32x4*)rowp = w; }
        return true;
    }
};
struct EpiResid {
    const float* base; float* out; int ldc; float alpha;
    __device__ __forceinline__ bool operator()(f32x4 (&acc)[2][2][4][2], const Unit& u, int wr, int wc, int fr, int fq) const {
        const int row0 = u.pm * BM + wr * 64 + fr, col0 = u.pn * BM + wc * 32 + 8 * fq;
#pragma unroll
        for (int ai = 0; ai < 2; ++ai)
#pragma unroll
            for (int m = 0; m < 4; ++m) { const size_t off = (size_t)(row0 + ai * HALF + m * 16) * ldc + col0;
#pragma unroll
                for (int bj = 0; bj < 2; ++bj)
#pragma unroll
                    for (int n = 0; n < 2; ++n) { const f32x4 b = *(const f32x4*)(base + off + bj * HALF + 4 * n); *(f32x4*)(out + off + bj * HALF + 4 * n) = b + acc[ai][bj][m][n] * alpha; } }
        return true;
    }
};
struct EpiMix {
    const bf16_t* Z; bf16_t* Y; int ldz; int cga, cgm;
    __device__ __forceinline__ bool operator()(f32x4 (&acc)[2][2][4][2], const Unit& u, int wr, int wc, int fr, int fq) const {
        const int row0 = u.pm * BM + wr * 64 + fr, col0 = u.pn * BM + wc * 32 + 8 * fq;
#pragma unroll
        for (int ai = 0; ai < 2; ++ai)
#pragma unroll
            for (int m = 0; m < 4; ++m) { const size_t off = (size_t)(row0 + ai * HALF + m * 16) * ldz + col0;
#pragma unroll
                for (int bj = 0; bj < 2; ++bj) {
                    const u32x4 gm = *(const u32x4*)(Z + off + cgm + bj * HALF);
                    float dm[8] = {sigmoid_den(bf_lo(gm.x)), sigmoid_den(bf_hi(gm.x)), sigmoid_den(bf_lo(gm.y)), sigmoid_den(bf_hi(gm.y)), sigmoid_den(bf_lo(gm.z)), sigmoid_den(bf_hi(gm.z)), sigmoid_den(bf_lo(gm.w)), sigmoid_den(bf_hi(gm.w))};
                    if (u.kind == 0) {
                        const u32x4 ga = *(const u32x4*)(Z + off + cga + bj * HALF);
                        float da[8] = {sigmoid_den(bf_lo(ga.x)), sigmoid_den(bf_hi(ga.x)), sigmoid_den(bf_lo(ga.y)), sigmoid_den(bf_hi(ga.y)), sigmoid_den(bf_lo(ga.z)), sigmoid_den(bf_hi(ga.z)), sigmoid_den(bf_lo(ga.w)), sigmoid_den(bf_hi(ga.w))};
#pragma unroll
                        for (int n = 0; n < 2; ++n)
#pragma unroll
                            for (int e = 0; e < 4; ++e) acc[ai][bj][m][n][e] *= dm[4 * n + e] / da[4 * n + e];
                    } else {
                        float r[8];
#pragma unroll
                        for (int n = 0; n < 2; ++n)
#pragma unroll
                            for (int e = 0; e < 4; ++e) r[4 * n + e] = acc[ai][bj][m][n][e] / dm[4 * n + e];
                        u32x4 w; w.x = cvt_pk_bf16(r[0], r[1]); w.y = cvt_pk_bf16(r[2], r[3]); w.z = cvt_pk_bf16(r[4], r[5]); w.w = cvt_pk_bf16(r[6], r[7]);
                        *(u32x4*)(Y + off + bj * HALF) = w;
                    }
                } }
        return u.kind != 0;
    }
};

template <class Epi, class Sched>
__device__ __forceinline__ void gemm_phase(PG8_LAS unsigned char* lds, const Gemm g, const Sched& S, const Epi& E) {
    const int tid = threadIdx.x, wid = __builtin_amdgcn_readfirstlane(tid >> 6), lane = tid & 63, wr = wid >> 2, wc = wid & 3, fr = lane & 15, fq = lane >> 4;
    const int K = g.K, nt = K / BK, lda = g.lda;
    unsigned voffA[2], voffB[2];
#pragma unroll
    for (int i = 0; i < 2; ++i) { int R, C; stage_rc(tid * 16 + i * 8192, R, C); const int Rb = (R & ~31) + perm32(R & 31);
        voffA[i] = (unsigned)(R * lda + C) * 2u; voffB[i] = (unsigned)(Rb * K + C) * 2u; }
    const size_t kstep = (size_t)(BK * 2);
    const size_t hstepA = (size_t)HALF * lda * 2, hstepB = (size_t)HALF * K * 2;
    const size_t tstepA = 2 * hstepA, tstepB = 2 * hstepB;
    const unsigned ldsw = (unsigned)wid * 1024u;
    const int aoff = lds_byte(wr * 64 + fr, fq * 8), boff = lds_byte(wc * 32 + fr, fq * 8);
#define PG8_SA(b, h) (((b) * 2 + (h)) * HTB)
#define PG8_SB(b, h) ((4 + (b) * 2 + (h)) * HTB)
#define PG8_STAGE(bufoff, gbase, voff) do { _Pragma("unroll") for (int _i = 0; _i < 2; ++_i) \
        __builtin_amdgcn_global_load_lds((const unsigned*)((const char*)(gbase) + (voff)[_i]), (PG8_LAS unsigned*)(lds + (bufoff) + ldsw + _i * 8192), 16, 0, 0); } while (0)
#define PG8_LDA(dst, b, h) do { _Pragma("unroll") for (int m = 0; m < 4; ++m) _Pragma("unroll") for (int k = 0; k < 2; ++k) dst[m][k] = *(const PG8_LAS bf16x8*)(lds + PG8_SA(b, h) + aoff + m * 2048 + k * 1024); } while (0)
#define PG8_LDB(dst, b, h) do { _Pragma("unroll") for (int n = 0; n < 2; ++n) _Pragma("unroll") for (int k = 0; k < 2; ++k) dst[n][k] = *(const PG8_LAS bf16x8*)(lds + PG8_SB(b, h) + boff + n * 2048 + k * 1024); } while (0)
#define PG8_MMA(ai, bj, At, Bt) do { __builtin_amdgcn_s_setprio(1); _Pragma("unroll") for (int m = 0; m < 4; ++m) _Pragma("unroll") for (int n = 0; n < 2; ++n) _Pragma("unroll") for (int k = 0; k < 2; ++k) \
        acc[ai][bj][m][n] = __builtin_amdgcn_mfma_f32_16x16x32_bf16(Bt[n][k], At[m][k], acc[ai][bj][m][n], 0, 0, 0); __builtin_amdgcn_s_setprio(0); } while (0)
#define PG8_WAIT_V(n) asm volatile("s_waitcnt vmcnt(" #n ")" ::: "memory")
#define PG8_WAIT_L(n) asm volatile("s_waitcnt lgkmcnt(" #n ")" ::: "memory")
#define PG8_BAR __builtin_amdgcn_s_barrier()
#define PG8_SCHED __builtin_amdgcn_sched_barrier(0)
    Unit cur, nxt; int ui = 0;
    if (!S.next(0, cur)) return;
    f32x4 acc[2][2][4][2];
#pragma unroll
    for (int a = 0; a < 2; ++a)
#pragma unroll
        for (int b = 0; b < 2; ++b)
#pragma unroll
            for (int m = 0; m < 4; ++m)
#pragma unroll
                for (int n = 0; n < 2; ++n) acc[a][b][m][n] = (f32x4){0.f, 0.f, 0.f, 0.f};
    bf16x8 At[4][2], B0[2][2], B1[2][2];
    const char* cA = (const char*)(cur.kind ? g.A1 : g.A0) + (size_t)cur.pm * tstepA; const char* cB = (const char*)(cur.kind ? g.B1 : g.B0) + (size_t)cur.pn * tstepB;
    PG8_STAGE(PG8_SB(0, 0), cB, voffB); PG8_STAGE(PG8_SB(0, 1), cB + hstepB, voffB); PG8_STAGE(PG8_SA(0, 0), cA, voffA); PG8_STAGE(PG8_SA(0, 1), cA + hstepA, voffA);
    if (wr == 1) PG8_BAR;
    PG8_WAIT_V(2); PG8_BAR;
    PG8_STAGE(PG8_SB(1, 0), cB + kstep, voffB); PG8_STAGE(PG8_SA(1, 0), cA + kstep, voffA); PG8_STAGE(PG8_SB(1, 1), cB + hstepB + kstep, voffB);
    PG8_WAIT_V(6); PG8_BAR;
    for (;;) {
        const bool has_next = S.next(ui + 1, nxt);
        const char* nA = has_next ? (const char*)(nxt.kind ? g.A1 : g.A0) + (size_t)nxt.pm * tstepA : cA; const char* nB = has_next ? (const char*)(nxt.kind ? g.B1 : g.B0) + (size_t)nxt.pn * tstepB : cB;
        for (int t = 0; t < nt; t += 2) {
            const bool last = (t == nt - 2);
            const char* a1 = cA + (size_t)(t + 1) * kstep;
            const char* a2 = last ? nA : cA + (size_t)(t + 2) * kstep; const char* b2 = last ? nB : cB + (size_t)(t + 2) * kstep;
            const char* a3 = a2 + kstep; const char* b3 = b2 + kstep;
            PG8_LDB(B0, 0, 0); PG8_LDB(B1, 0, 1); PG8_SCHED; PG8_LDA(At, 0, 0); PG8_STAGE(PG8_SA(1, 1), a1 + hstepA, voffA);
            PG8_WAIT_V(8); PG8_WAIT_L(0); PG8_BAR; PG8_MMA(0, 0, At, B0); PG8_MMA(0, 1, At, B1); PG8_BAR; PG8_SCHED;
            PG8_LDA(At, 0, 1); PG8_STAGE(PG8_SB(0, 0), b2, voffB); PG8_STAGE(PG8_SB(0, 1), b2 + hstepB, voffB); PG8_STAGE(PG8_SA(0, 0), a2, voffA);
            PG8_WAIT_V(8); PG8_WAIT_L(0); PG8_BAR; PG8_MMA(1, 0, At, B0); PG8_MMA(1, 1, At, B1); PG8_BAR; PG8_SCHED;
            PG8_LDB(B0, 1, 0); PG8_LDB(B1, 1, 1); PG8_SCHED; PG8_LDA(At, 1, 0); PG8_STAGE(PG8_SA(0, 1), a2 + hstepA, voffA);
            PG8_WAIT_V(8); PG8_WAIT_L(0); PG8_BAR; PG8_MMA(0, 0, At, B0); PG8_MMA(0, 1, At, B1); PG8_BAR; PG8_SCHED;
            PG8_LDA(At, 1, 1); PG8_STAGE(PG8_SB(1, 0), b3, voffB); PG8_STAGE(PG8_SB(1, 1), b3 + hstepB, voffB); PG8_STAGE(PG8_SA(1, 0), a3, voffA);
            PG8_WAIT_V(8); PG8_WAIT_L(0); PG8_BAR; PG8_MMA(1, 0, At, B0); PG8_MMA(1, 1, At, B1); PG8_BAR; PG8_SCHED;
        }
        if (wr == 0) PG8_BAR;
        const bool zero = E(acc, cur, wr, wc, fr, fq);
        if (!has_next) break;
        if (zero) {
#pragma unroll
            for (int a = 0; a < 2; ++a)
#pragma unroll
                for (int b = 0; b < 2; ++b)
#pragma unroll
                    for (int m = 0; m < 4; ++m)
#pragma unroll
                        for (int n = 0; n < 2; ++n) acc[a][b][m][n] = (f32x4){0.f, 0.f, 0.f, 0.f};
        }
        cur = nxt; cA = nA; cB = nB; ++ui;
        if (wr == 1) PG8_BAR;
    }
    PG8_WAIT_V(0);
    PG8_BAR;
#undef PG8_SA
#undef PG8_SB
#undef PG8_STAGE
#undef PG8_LDA
#undef PG8_LDB
#undef PG8_MMA
#undef PG8_WAIT_V
#undef PG8_WAIT_L
#undef PG8_BAR
#undef PG8_SCHED
}
}

typedef unsigned short bf16;
typedef float f32x4 __attribute__((ext_vector_type(4)));
typedef unsigned u32x4 __attribute__((ext_vector_type(4)));
typedef unsigned u32x2 __attribute__((ext_vector_type(2)));
#define LAS __attribute__((address_space(3)))

constexpr int BATCH = 4, SEQ = 8192, T = BATCH * SEQ, D = 1024, FF = 2816, NGU = 2 * FF, ZP = 6656, INW = 6664;
constexpr int ZQA = 0, ZKA = 1024, ZVA = 1280, ZQM = 1536, ZKM = 2048, ZVM = 2560, ZOM = 3584, ZGA = 4608, ZGM = 5632;
constexpr float RMS_EPS = 1e-5f;
constexpr size_t MiB = (size_t)1 << 20;
constexpr size_t WS_WA = 0, WS_WP = 17 * MiB, WS_ROPE = 23 * MiB, WS_GATE = 25 * MiB, WS_MISC = 26 * MiB, WS_HA = 28 * MiB, WS_Z = 92 * MiB, WS_END = 508 * MiB;
constexpr size_t WA_GU = 0, WA_DN = 11 * MiB;
constexpr int LDS_BYTES = 147456;
constexpr int NPHASE = 14;

struct Args {
    const float* in[21]; float* out; unsigned char* ws; float inv_freq[32]; int ph_lo, ph_hi;
};

__device__ __forceinline__ unsigned f2bf(float f) { unsigned u = __builtin_bit_cast(unsigned, f); return (u + 0x7fffu + ((u >> 16) & 1u)) >> 16; }
__device__ __forceinline__ unsigned pk2(float lo, float hi) { return f2bf(lo) | (f2bf(hi) << 16); }
__device__ __forceinline__ float bf2f(bf16 b) { return __uint_as_float((unsigned)b << 16); }
__device__ __forceinline__ float wave_sum(float v) {
#pragma unroll
    for (int o = 1; o < 64; o <<= 1) v += __shfl_xor(v, o);
    return v;
}

__device__ __forceinline__ void transpose_item(const float* W, int pitch, int src_col0, int K, bf16* WT, int dst_row0, int k0, LAS float* scr, int lane) {
#pragma unroll 8
    for (int i = 0; i < 32; ++i) { const int kk = 2 * i + (lane >> 5); scr[kk * 33 + (lane & 31)] = W[(size_t)(k0 + kk) * pitch + src_col0 + (lane & 31)]; }
    asm volatile("s_waitcnt lgkmcnt(0)" ::: "memory");
    const int c = lane & 7;
#pragma unroll
    for (int j = 0; j < 4; ++j) { const int n = (lane >> 3) + 8 * j; const LAS float* s = scr + (8 * c) * 33 + n;
        u32x4 o; o.x = pk2(s[0 * 33], s[1 * 33]); o.y = pk2(s[2 * 33], s[3 * 33]); o.z = pk2(s[4 * 33], s[5 * 33]); o.w = pk2(s[6 * 33], s[7 * 33]);
        *(u32x4*)(WT + (size_t)(dst_row0 + n) * K + k0 + 8 * c) = o; }
    asm volatile("s_waitcnt lgkmcnt(0)" ::: "memory");
}
__device__ __forceinline__ void convert_weight(const float* W, int pitch, int K, int nblk, bf16* WT, int mode, int gw, int NGW, LAS float* scr, int lane) {
    const int nitems = (K / 64) * nblk;
    for (int it = gw; it < nitems; it += NGW) {
        const int kb = it / nblk, nb = it % nblk; int src = 32 * nb, dst = 32 * nb;
        if (mode == 1) dst = 256 * (src >> 7) + (src & 127);
        else if (mode == 2) dst = 256 * (src >> 7) + (src & 127) + 128;
        else if (mode == 3) src = dst < 4608 ? dst : dst + 8;
        transpose_item(W, pitch, src, K, WT, dst, 64 * kb, scr, lane);
    }
}

__device__ __forceinline__ void norm_row(const float* xrow, const float* gain, bf16* orow, int lane, f32x4 (&v)[4]) {
    const f32x4* xr = (const f32x4*)xrow + lane; const f32x4* gr = (const f32x4*)gain + lane;
    float s = 0.f;
#pragma unroll
    for (int j = 0; j < 4; ++j) { v[j] = xr[64 * j]; s += (v[j].x * v[j].x + v[j].y * v[j].y) + (v[j].z * v[j].z + v[j].w * v[j].w); }
    const float rstd = 1.0f / sqrtf(wave_sum(s) * (1.0f / D) + RMS_EPS);
    unsigned long long* o8 = (unsigned long long*)orow + lane;
#pragma unroll
    for (int j = 0; j < 4; ++j) { const f32x4 g = gr[64 * j]; v[j] = v[j] * rstd * g;
        o8[64 * j] = (unsigned long long)pk2(v[j].x, v[j].y) | ((unsigned long long)pk2(v[j].z, v[j].w) << 32); }
}

namespace mm {
typedef short bf16x8 __attribute__((ext_vector_type(8)));
typedef short s16x4 __attribute__((ext_vector_type(4)));
typedef short v4i16_t __attribute__((ext_vector_type(4)));
typedef float f32x16 __attribute__((ext_vector_type(16)));
typedef float f32x8 __attribute__((ext_vector_type(8)));
typedef __bf16 bfv8 __attribute__((ext_vector_type(8)));
#define MFMA32(a, b, c) __builtin_amdgcn_mfma_f32_32x32x16_bf16((a), (b), (c), 0, 0, 0)
constexpr int PQ = 272, PV = 528;
__device__ __forceinline__ s16x4 vtr(const LAS unsigned char* p) { return __builtin_bit_cast(s16x4, __builtin_amdgcn_ds_read_tr16_b64_v4i16((LAS v4i16_t*)p)); }
__device__ __forceinline__ bf16x8 rowread(const LAS unsigned char* img, int pitch, int r0, int k0, int lane) { return *(const LAS bf16x8*)(img + (r0 + (lane & 31)) * pitch + (k0 + 8 * (lane >> 5)) * 2); }
template <bool PERM> __device__ __forceinline__ bf16x8 trread(const LAS unsigned char* img, int pitch, int k0, int c0, int lane) {
    const int h = lane >> 5, blk = (lane >> 4) & 1, q = (lane & 15) >> 2, p = lane & 3;
    const int rlo = PERM ? k0 + 4 * h + q : k0 + 8 * h + q, rhi = PERM ? k0 + 8 + 4 * h + q : k0 + 8 * h + 4 + q;
    const int cb = (c0 + 16 * blk + 4 * p) * 2;
    const s16x4 lo = vtr(img + rlo * pitch + cb), hi = vtr(img + rhi * pitch + cb);
    return __builtin_shufflevector(lo, hi, 0, 1, 2, 3, 4, 5, 6, 7);
}
__device__ __forceinline__ bf16x8 pack8(const f32x16& x, int s) {
    f32x8 v;
#pragma unroll
    for (int j = 0; j < 8; ++j) v[j] = x[8 * s + j];
    return __builtin_bit_cast(bf16x8, __builtin_convertvector(v, bfv8));
}
__device__ __forceinline__ void stage_conv(LAS unsigned char* img, const bf16* z, size_t tokb, int t0, int zcol0, const float* cw, const float* cbias, float scale, int tid) {
    const int cg8 = (tid & 15) * 8, lr = tid >> 4;
    float w[4][8], bb[8];
#pragma unroll
    for (int j = 0; j < 4; ++j) { const f32x4 a = *(const f32x4*)(cw + j * 1024 + cg8), b = *(const f32x4*)(cw + j * 1024 + cg8 + 4); w[j][0] = a.x; w[j][1] = a.y; w[j][2] = a.z; w[j][3] = a.w; w[j][4] = b.x; w[j][5] = b.y; w[j][6] = b.z; w[j][7] = b.w; }
    { const f32x4 a = *(const f32x4*)(cbias + cg8), b = *(const f32x4*)(cbias + cg8 + 4); bb[0] = a.x; bb[1] = a.y; bb[2] = a.z; bb[3] = a.w; bb[4] = b.x; bb[5] = b.y; bb[6] = b.z; bb[7] = b.w; }
    float r[7][8];
#pragma unroll
    for (int jj = 0; jj < 7; ++jj) { const int t = t0 + 4 * lr - 3 + jj; u32x4 v = {0u, 0u, 0u, 0u};
        if (t >= 0) v = *(const u32x4*)(z + (tokb + t) * ZP + zcol0 + cg8);
        r[jj][0] = pg8::bf_lo(v.x); r[jj][1] = pg8::bf_hi(v.x); r[jj][2] = pg8::bf_lo(v.y); r[jj][3] = pg8::bf_hi(v.y); r[jj][4] = pg8::bf_lo(v.z); r[jj][5] = pg8::bf_hi(v.z); r[jj][6] = pg8::bf_lo(v.w); r[jj][7] = pg8::bf_hi(v.w); }
#pragma unroll
    for (int i = 0; i < 4; ++i) { float y[8];
#pragma unroll
        for (int e = 0; e < 8; ++e) { float s = w[0][e] * r[i][e] + w[1][e] * r[i + 1][e] + w[2][e] * r[i + 2][e] + w[3][e] * r[i + 3][e] + bb[e]; y[e] = s / (1.0f + __expf(-s)) * scale; }
        u32x4 o; o.x = pk2(y[0], y[1]); o.y = pk2(y[2], y[3]); o.z = pk2(y[4], y[5]); o.w = pk2(y[6], y[7]);
        *(LAS u32x4*)(img + (4 * lr + i) * PQ + cg8 * 2) = o; }
}
template <bool SCALE> __device__ __forceinline__ void stage_v(LAS unsigned char* img, const bf16* z, size_t tok0, int h, const LAS float* aa, int tid) {
    const int v8 = (tid & 31) * 8, l0 = tid >> 5;
#pragma unroll
    for (int i = 0; i < 8; ++i) { const int l = l0 + 16 * i; u32x4 v = *(const u32x4*)(z + (tok0 + l) * ZP + ZVM + h * 256 + v8);
        if (SCALE) { const float a = aa[l]; v.x = pk2(pg8::bf_lo(v.x) * a, pg8::bf_hi(v.x) * a); v.y = pk2(pg8::bf_lo(v.y) * a, pg8::bf_hi(v.y) * a); v.z = pk2(pg8::bf_lo(v.z) * a, pg8::bf_hi(v.z) * a); v.w = pk2(pg8::bf_lo(v.w) * a, pg8::bf_hi(v.w) * a); }
        *(LAS u32x4*)(img + l * PV + v8 * 2) = v; }
}
__device__ __forceinline__ void scan_add2(float a0, float a1, int lane, float& s0, float& s1) {
    float p = a0 + a1;
#pragma unroll
    for (int o = 1; o < 64; o <<= 1) { const float t = __shfl_up(p, o); if (lane >= o) p += t; }
    s1 = p; s0 = p - a1;
}
__device__ __forceinline__ void scan_max2(float a0, float a1, int lane, float& s0, float& s1) {
    float p = fmaxf(a0, a1);
#pragma unroll
    for (int o = 1; o < 64; o <<= 1) { const float t = __shfl_up(p, o); if (lane >= o) p = fmaxf(p, t); }
    s1 = p; const float prev = __shfl_up(p, 1); s0 = lane > 0 ? fmaxf(prev, a0) : a0;
}
constexpr int OFF_K1 = 0, OFF_V1 = 34816, OFF_F1 = 34816 + 67584;
__device__ __forceinline__ void dc_item(const bf16* z, const float* gates, const float* conv_w, const float* conv_b, bf16* dC, float* dn, float* mloc, float* bend, int item, LAS unsigned char* L, int tid, int lane, int wave) {
    const int b = item >> 8, h = (item >> 6) & 3, c = item & 63;
    const size_t tokb = (size_t)b * SEQ, tok0 = tokb + (size_t)c * 128;
    LAS unsigned char* kimg = L + OFF_K1; LAS unsigned char* vimg = L + OFF_V1; LAS float* lf = (LAS float*)(L + OFF_F1); LAS float* ig = lf + 128; LAS float* bc = lf + 256; LAS float* aa = lf + 384;
    __syncthreads();
    if (wave == 0) {
        const float lf0 = gates[(tok0 + 2 * lane) * 8 + 4 + h], lf1 = gates[(tok0 + 2 * lane + 1) * 8 + 4 + h], ig0 = gates[(tok0 + 2 * lane) * 8 + h], ig1 = gates[(tok0 + 2 * lane + 1) * 8 + h];
        float b0, b1; scan_add2(lf0, lf1, lane, b0, b1);
        const float be = __shfl(b1, 63), w0 = be - b0 + ig0, w1 = be - b1 + ig1;
        float ml = fmaxf(w0, w1);
#pragma unroll
        for (int o = 1; o < 64; o <<= 1) ml = fmaxf(ml, __shfl_xor(ml, o));
        aa[2 * lane] = __expf(w0 - ml); aa[2 * lane + 1] = __expf(w1 - ml);
        if (lane == 0) { mloc[item] = ml; bend[item] = be; }
    }
    stage_conv(kimg, z, tokb, c * 128, ZKM + h * 128, conv_w + 512 + h * 128, conv_b + 512 + h * 128, 0.08838834764831845f, tid);
    __syncthreads();
    stage_v<true>(vimg, z, tok0, h, aa, tid);
    __syncthreads();
    { const int d = tid >> 2, part = tid & 3; float s = 0.f;
#pragma unroll 4
      for (int l = part * 32; l < part * 32 + 32; ++l) s += aa[l] * bf2f(*(const LAS bf16*)(kimg + l * PQ + d * 2));
      s += __shfl_xor(s, 1); s += __shfl_xor(s, 2);
      if (part == 0) dn[(size_t)item * 128 + d] = s; }
    f32x16 acc[4];
#pragma unroll
    for (int dt = 0; dt < 4; ++dt)
#pragma unroll
        for (int i = 0; i < 16; ++i) acc[dt][i] = 0.f;
#pragma unroll
    for (int ks = 0; ks < 8; ++ks) { const bf16x8 bv = trread<false>(vimg, PV, 16 * ks, 32 * wave, lane);
#pragma unroll
        for (int dt = 0; dt < 4; ++dt) { const bf16x8 ak = trread<false>(kimg, PQ, 16 * ks, 32 * dt, lane); acc[dt] = MFMA32(ak, bv, acc[dt]); } }
    const int r = lane & 31, hh = lane >> 5;
    bf16* orow = dC + (size_t)item * 32768 + (size_t)(32 * wave + r) * 128;
#pragma unroll
    for (int dt = 0; dt < 4; ++dt)
#pragma unroll
        for (int g = 0; g < 4; ++g) { u32x2 o; o.x = pk2(acc[dt][4 * g], acc[dt][4 * g + 1]); o.y = pk2(acc[dt][4 * g + 2], acc[dt][4 * g + 3]); *(u32x2*)(orow + 32 * dt + 8 * g + 4 * hh) = o; }
}
__device__ __forceinline__ void scan_phase(bf16* dC, float* dn, const float* mloc, const float* bend, float* mprev, int G, int tid) {
    for (int gidx = blockIdx.x * 512 + tid; gidx < 16 * 8192; gidx += G * 512) {
        const int bh = gidx >> 13, e4 = gidx & 8191;
        bf16* base = dC + (size_t)bh * 64 * 32768 + (size_t)e4 * 4;
        float C0 = 0.f, C1 = 0.f, C2 = 0.f, C3 = 0.f, m = 0.f;
        for (int c0 = 0; c0 < 64; c0 += 8) {
            u32x2 ld[8];
#pragma unroll
            for (int k = 0; k < 8; ++k) { const int c = c0 + k; ld[k] = (u32x2){0u, 0u}; if (c < 63) ld[k] = *(const u32x2*)(base + (size_t)c * 32768); }
#pragma unroll
            for (int k = 0; k < 8; ++k) { const int c = c0 + k;
                u32x2 o; o.x = pk2(C0, C1); o.y = pk2(C2, C3); *(u32x2*)(base + (size_t)c * 32768) = o;
                if (e4 == 0) mprev[bh * 64 + c] = m;
                if (c < 63) { const float ml = mloc[bh * 64 + c], be = bend[bh * 64 + c]; const float mn = fmaxf(be + m, ml), so = __expf(be + m - mn), sn = __expf(ml - mn);
                    C0 = so * C0 + sn * pg8::bf_lo(ld[k].x); C1 = so * C1 + sn * pg8::bf_hi(ld[k].x); C2 = so * C2 + sn * pg8::bf_lo(ld[k].y); C3 = so * C3 + sn * pg8::bf_hi(ld[k].y); m = mn; } }
        }
        if (gidx < 16 * 128) {
            const int bh2 = gidx >> 7, d = gidx & 127; float n = 0.f, m2 = 0.f;
            for (int c = 0; c < 64; ++c) { float* p = dn + (size_t)(bh2 * 64 + c) * 128 + d; const float dv = (c < 63) ? *p : 0.f; *p = n;
                if (c < 63) { const float ml = mloc[bh2 * 64 + c], be = bend[bh2 * 64 + c]; const float mn = fmaxf(be + m2, ml); n = __expf(be + m2 - mn) * n + __expf(ml - mn) * dv; m2 = mn; } }
        }
    }
}
constexpr int OFF_Q3 = 0, OFF_K3 = 34816, OFF_V3 = 69632, OFF_F3 = 69632 + 67584;
__device__ __forceinline__ void out_item(bf16* z, const float* gates, const float* conv_w, const float* conv_b, const bf16* Cprev, const float* nprev, const float* mprev, const float* hn, int item, LAS unsigned char* L, int tid, int lane, int wave) {
    const int b = item >> 8, h = (item >> 6) & 3, c = item & 63;
    const size_t tokb = (size_t)b * SEQ, tok0 = tokb + (size_t)c * 128;
    LAS unsigned char* qimg = L + OFF_Q3; LAS unsigned char* kimg = L + OFF_K3; LAS unsigned char* vimg = L + OFF_V3;
    LAS float* lf = (LAS float*)(L + OFF_F3); LAS float* ig = lf + 128; LAS float* bc = lf + 256; LAS float* uu = lf + 384; LAS float* gm = lf + 512; LAS float* np = lf + 640; LAS float* part = lf + 768;
    __syncthreads();
    if (wave == 0) {
        const float lf0 = gates[(tok0 + 2 * lane) * 8 + 4 + h], lf1 = gates[(tok0 + 2 * lane + 1) * 8 + 4 + h], ig0 = gates[(tok0 + 2 * lane) * 8 + h], ig1 = gates[(tok0 + 2 * lane + 1) * 8 + h];
        float b0, b1; scan_add2(lf0, lf1, lane, b0, b1);
        const float u0 = ig0 - b0, u1 = ig1 - b1; float g0, g1; scan_max2(u0, u1, lane, g0, g1);
        bc[2 * lane] = b0; bc[2 * lane + 1] = b1; uu[2 * lane] = u0; uu[2 * lane + 1] = u1; gm[2 * lane] = g0; gm[2 * lane + 1] = g1;
    } else if (wave == 1 || wave == 2) np[tid - 64] = nprev[(size_t)item * 128 + tid - 64];
    stage_conv(qimg, z, tokb, c * 128, ZQM + h * 128, conv_w + h * 128, conv_b + h * 128, 1.0f, tid);
    stage_conv(kimg, z, tokb, c * 128, ZKM + h * 128, conv_w + 512 + h * 128, conv_b + 512 + h * 128, 0.08838834764831845f, tid);
    stage_v<false>(vimg, z, tok0, h, nullptr, tid);
    __syncthreads();
    const float mp = mprev[item];
    const int lw = wave & 3, vw = wave >> 2, r = lane & 31, hh = lane >> 5, l = 32 * lw + r;
    const float b_l = bc[l], mt = fmaxf(b_l + gm[l], b_l + mp), inter = __expf(b_l + mp - mt), e0 = b_l - mt;
    f32x16 S[4];
#pragma unroll
    for (int st = 0; st < 4; ++st)
#pragma unroll
        for (int i = 0; i < 16; ++i) S[st][i] = 0.f;
#pragma unroll
    for (int ks = 0; ks < 8; ++ks) { const bf16x8 bq = rowread(qimg, PQ, 32 * lw, 16 * ks, lane);
#pragma unroll
        for (int st = 0; st < 4; ++st) if (st <= lw) { const bf16x8 ak = rowread(kimg, PQ, 32 * st, 16 * ks, lane); S[st] = MFMA32(ak, bq, S[st]); } }
    float dsum = 0.f;
#pragma unroll
    for (int st = 0; st < 4; ++st) if (st <= lw) {
#pragma unroll
        for (int g = 0; g < 4; ++g) { const int s0 = 32 * st + 8 * g + 4 * hh; const f32x4 u4 = *(const LAS f32x4*)(uu + s0);
#pragma unroll
            for (int e = 0; e < 4; ++e) { const float w = (s0 + e <= l) ? __expf(e0 + u4[e]) : 0.f; const float v = S[st][4 * g + e] * w; S[st][4 * g + e] = v; dsum += v; } } }
    dsum += __shfl_xor(dsum, 32);
    bf16x8 fr[4][2];
#pragma unroll
    for (int st = 0; st < 4; ++st) { fr[st][0] = pack8(S[st], 0); fr[st][1] = pack8(S[st], 1); }
    float qn = 0.f;
#pragma unroll
    for (int d8 = 0; d8 < 8; ++d8) { const bf16x8 qf = *(const LAS bf16x8*)(qimg + l * PQ + (64 * hh + 8 * d8) * 2); const f32x4 na = *(const LAS f32x4*)(np + 64 * hh + 8 * d8), nb = *(const LAS f32x4*)(np + 64 * hh + 8 * d8 + 4);
        qn += bf2f((bf16)qf[0]) * na.x + bf2f((bf16)qf[1]) * na.y + bf2f((bf16)qf[2]) * na.z + bf2f((bf16)qf[3]) * na.w + bf2f((bf16)qf[4]) * nb.x + bf2f((bf16)qf[5]) * nb.y + bf2f((bf16)qf[6]) * nb.z + bf2f((bf16)qf[7]) * nb.w; }
    qn += __shfl_xor(qn, 32);
    const float den = dsum + inter * qn, rden = 1.0f / fmaxf(fabsf(den), __expf(-mt));
    f32x16 O[4];
#pragma unroll
    for (int vt = 0; vt < 4; ++vt)
#pragma unroll
        for (int i = 0; i < 16; ++i) O[vt][i] = 0.f;
    const bf16* cp = Cprev + (size_t)item * 32768 + (size_t)(128 * vw + r) * 128 + 8 * hh;
#pragma unroll
    for (int ks = 0; ks < 8; ++ks) { const bf16x8 bq = rowread(qimg, PQ, 32 * lw, 16 * ks, lane);
#pragma unroll
        for (int vt = 0; vt < 4; ++vt) { const bf16x8 ac = *(const bf16x8*)(cp + vt * 4096 + 16 * ks); O[vt] = MFMA32(ac, bq, O[vt]); } }
#pragma unroll
    for (int vt = 0; vt < 4; ++vt)
#pragma unroll
        for (int i = 0; i < 16; ++i) O[vt][i] *= inter;
#pragma unroll
    for (int st = 0; st < 4; ++st) if (st <= lw) {
#pragma unroll
        for (int s2 = 0; s2 < 2; ++s2)
#pragma unroll
            for (int vt = 0; vt < 4; ++vt) { const bf16x8 av = trread<true>(vimg, PV, 32 * st + 16 * s2, 128 * vw + 32 * vt, lane); O[vt] = MFMA32(av, fr[st][s2], O[vt]); } }
    float ss = 0.f;
#pragma unroll
    for (int vt = 0; vt < 4; ++vt)
#pragma unroll
        for (int i = 0; i < 16; ++i) { const float v = O[vt][i] * rden; O[vt][i] = v; ss += v * v; }
    ss += __shfl_xor(ss, 32);
    if (hh == 0) part[vw * 128 + l] = ss;
    __syncthreads();
    const float rstd = 1.0f / sqrtf((part[l] + part[128 + l]) * (1.0f / 256.0f) + RMS_EPS);
    bf16* orow = z + (tok0 + l) * ZP + ZOM + h * 256;
#pragma unroll
    for (int vt = 0; vt < 4; ++vt)
#pragma unroll
        for (int g = 0; g < 4; ++g) { const int v0 = 128 * vw + 32 * vt + 8 * g + 4 * hh; const u32x2 ow = *(const u32x2*)(orow + v0); const f32x4 gn = *(const f32x4*)(hn + h * 256 + v0);
            const float r0 = O[vt][4 * g] * rstd * gn.x / (1.0f + __expf(-pg8::bf_lo(ow.x))), r1 = O[vt][4 * g + 1] * rstd * gn.y / (1.0f + __expf(-pg8::bf_hi(ow.x)));
            const float r2 = O[vt][4 * g + 2] * rstd * gn.z / (1.0f + __expf(-pg8::bf_lo(ow.y))), r3 = O[vt][4 * g + 3] * rstd * gn.w / (1.0f + __expf(-pg8::bf_hi(ow.y)));
            u32x2 o; o.x = pk2(r0, r1); o.y = pk2(r2, r3); *(u32x2*)(orow + v0) = o; }
}
}


namespace at {
using namespace mm;
constexpr int PK = 144;
constexpr int OFF_K = 0, OFF_V = 256 * PK;
__device__ __forceinline__ void unpack8(const u32x4 v, float (&x)[8]) { x[0] = pg8::bf_lo(v.x); x[1] = pg8::bf_hi(v.x); x[2] = pg8::bf_lo(v.y); x[3] = pg8::bf_hi(v.y); x[4] = pg8::bf_lo(v.z); x[5] = pg8::bf_hi(v.z); x[6] = pg8::bf_lo(v.w); x[7] = pg8::bf_hi(v.w); }
__device__ __forceinline__ void load8f(const float* p, float (&x)[8]) { const f32x4 a = *(const f32x4*)p, b = *(const f32x4*)(p + 4); x[0] = a.x; x[1] = a.y; x[2] = a.z; x[3] = a.w; x[4] = b.x; x[5] = b.y; x[6] = b.z; x[7] = b.w; }
__device__ __forceinline__ bf16x8 cvt8(const float (&y)[8]) { f32x8 v;
#pragma unroll
    for (int e = 0; e < 8; ++e) v[e] = y[e];
    return __builtin_bit_cast(bf16x8, __builtin_convertvector(v, bfv8)); }
__device__ __forceinline__ void attn_item(bf16* z, const float* rope_cos, const float* rope_sin, const float* sinks, int item, LAS unsigned char* L, int tid, int lane, int wave) {
    const int hk = item & 3, n = (item >> 2) & 63, b = item >> 8;
    const size_t tok0 = (size_t)b * SEQ + (size_t)n * 128;
    LAS unsigned char* kimg = L + OFF_K; LAS unsigned char* vimg = L + OFF_V;
    __syncthreads();
    for (int idx = tid; idx < 1024; idx += 512) {
        const int key = idx >> 2, c8 = (idx & 3) * 8;
        bf16x8 o1 = {0, 0, 0, 0, 0, 0, 0, 0}, o2 = {0, 0, 0, 0, 0, 0, 0, 0};
        if (n > 0 || key >= 128) {
            const bf16* zr = z + (tok0 + key - 128) * ZP + ZKA + hk * 64;
            float x1[8], x2[8], cs[8], sn[8], y1[8], y2[8];
            unpack8(*(const u32x4*)(zr + c8), x1); unpack8(*(const u32x4*)(zr + c8 + 32), x2);
            const int pos = n * 128 + key - 128;
            load8f(rope_cos + pos * 32 + c8, cs); load8f(rope_sin + pos * 32 + c8, sn);
#pragma unroll
            for (int e = 0; e < 8; ++e) { y1[e] = x1[e] * cs[e] - x2[e] * sn[e]; y2[e] = x2[e] * cs[e] + x1[e] * sn[e]; }
            o1 = cvt8(y1); o2 = cvt8(y2);
        }
        *(LAS bf16x8*)(kimg + key * PK + c8 * 2) = o1; *(LAS bf16x8*)(kimg + key * PK + (c8 + 32) * 2) = o2;
    }
    for (int idx = tid; idx < 2048; idx += 512) {
        const int key = idx >> 3, c8 = (idx & 7) * 8; u32x4 v = {0u, 0u, 0u, 0u};
        if (n > 0 || key >= 128) v = *(const u32x4*)(z + (tok0 + key - 128) * ZP + ZVA + hk * 64 + c8);
        *(LAS u32x4*)(vimg + key * PK + c8 * 2) = v;
    }
    __syncthreads();
    const int r = lane & 31, hh = lane >> 5;
#pragma unroll 1
    for (int gsel = 0; gsel < 2; ++gsel) {
        const int gi = wave + 8 * gsel, g = gi >> 2, j = gi & 3, head = hk * 4 + g;
        bf16* qrow = z + (tok0 + 32 * j + r) * ZP + ZQA + head * 64; const int pos = n * 128 + 32 * j + r;
        u32x4 raw[4];
#pragma unroll
        for (int ks = 0; ks < 4; ++ks) raw[ks] = *(const u32x4*)(qrow + 16 * ks + 8 * hh);
        bf16x8 qf[4];
#pragma unroll
        for (int k2 = 0; k2 < 2; ++k2) { float x1[8], x2[8], cs[8], sn[8], y1[8], y2[8];
            unpack8(raw[k2], x1); unpack8(raw[k2 + 2], x2); load8f(rope_cos + pos * 32 + 16 * k2 + 8 * hh, cs); load8f(rope_sin + pos * 32 + 16 * k2 + 8 * hh, sn);
#pragma unroll
            for (int e = 0; e < 8; ++e) { y1[e] = (x1[e] * cs[e] - x2[e] * sn[e]) * 0.125f; y2[e] = (x2[e] * cs[e] + x1[e] * sn[e]) * 0.125f; }
            qf[k2] = cvt8(y1); qf[k2 + 2] = cvt8(y2); }
        f32x16 S[5];
#pragma unroll
        for (int kt = 0; kt < 5; ++kt)
#pragma unroll
            for (int i = 0; i < 16; ++i) S[kt][i] = 0.f;
#pragma unroll
        for (int ks = 0; ks < 4; ++ks)
#pragma unroll
            for (int kt = 0; kt < 5; ++kt) { const bf16x8 ak = rowread(kimg, PK, 32 * (j + kt), 16 * ks, lane); S[kt] = MFMA32(ak, qf[ks], S[kt]); }
        const float sink = sinks[head]; float mx = sink;
#pragma unroll
        for (int kt = 0; kt < 5; ++kt)
#pragma unroll
            for (int i = 0; i < 16; ++i) { const int cr = (i & 3) + 8 * (i >> 2) + 4 * hh; bool ok = (kt == 0) ? (cr > r) : (kt == 4) ? (cr <= r) : true; if (n == 0 && j + kt < 4) ok = false;
                const float s = ok ? S[kt][i] : -INFINITY; S[kt][i] = s; mx = fmaxf(mx, s); }
        mx = fmaxf(mx, __shfl_xor(mx, 32));
        float sum = 0.f;
#pragma unroll
        for (int kt = 0; kt < 5; ++kt)
#pragma unroll
            for (int i = 0; i < 16; ++i) { const float p = __expf(S[kt][i] - mx); S[kt][i] = p; sum += p; }
        sum += __shfl_xor(sum, 32); sum += __expf(sink - mx);
        const float inv = 1.0f / sum;
        f32x16 O[2];
#pragma unroll
        for (int dt = 0; dt < 2; ++dt)
#pragma unroll
            for (int i = 0; i < 16; ++i) O[dt][i] = 0.f;
#pragma unroll
        for (int kt = 0; kt < 5; ++kt)
#pragma unroll
            for (int s2 = 0; s2 < 2; ++s2) { const bf16x8 pf = pack8(S[kt], s2);
#pragma unroll
                for (int dt = 0; dt < 2; ++dt) { const bf16x8 av = trread<true>(vimg, PK, 32 * (j + kt) + 16 * s2, 32 * dt, lane); O[dt] = MFMA32(av, pf, O[dt]); } }
#pragma unroll
        for (int dt = 0; dt < 2; ++dt)
#pragma unroll
            for (int g4 = 0; g4 < 4; ++g4) { u32x2 o; o.x = pk2(O[dt][4 * g4] * inv, O[dt][4 * g4 + 1] * inv); o.y = pk2(O[dt][4 * g4 + 2] * inv, O[dt][4 * g4 + 3] * inv); *(u32x2*)(qrow + 32 * dt + 8 * g4 + 4 * hh) = o; }
    }
}
}


#define XB_TMO      128
#define XB_XCNT(j)  (256  + 64 * (j))
#define XB_XSUB(j)  (1280 + 64 * (j))
#define XB_XGEN(j)  (2304 + 64 * (j))
#define XB_TOP      3328
#define XB_TOPGEN   3392
#define XCD_BAR_WORDS 3456
#define XB_SPIN_CAP (1u << 18)
__device__ __forceinline__ unsigned xb_ld(unsigned* p)              { return __hip_atomic_load(p, __ATOMIC_RELAXED, __HIP_MEMORY_SCOPE_AGENT); }
__device__ __forceinline__ unsigned xb_add(unsigned* p, unsigned v) { return __hip_atomic_fetch_add(p, v, __ATOMIC_RELAXED, __HIP_MEMORY_SCOPE_AGENT); }
__device__ __forceinline__ unsigned xb_xcc_id() { return (unsigned)__builtin_amdgcn_s_getreg((3 << 11) | 20) & 0xFu; }
#define XB_SPIN(cond, bar) do { unsigned _sp = 0; while (cond) { __builtin_amdgcn_s_sleep(1); \
    if ((++_sp & 255u) == 0u) { if (xb_ld(&(bar)[XB_TMO])) break; if (_sp > XB_SPIN_CAP) { atomicAdd(&(bar)[XB_TMO], 1u); break; } } } } while (0)
struct XcdBarrier { unsigned* bar; unsigned x; volatile LAS unsigned* st; };
__device__ __forceinline__ XcdBarrier xcd_barrier_post(unsigned* bar, volatile LAS unsigned* st) {
    XcdBarrier b; b.bar = bar; b.x = xb_xcc_id(); b.st = st;
    if (threadIdx.x == 0) (void)xb_add(&bar[XB_XCNT(b.x)], 1u);
    return b;
}
__device__ __forceinline__ void xcd_barrier_complete(unsigned* bar, unsigned x, unsigned& nloc, unsigned& nx) {
    const unsigned G = gridDim.x * gridDim.y * gridDim.z;
    unsigned sum, cnt, mine, sp = 0u;
    for (;;) {
        sum = 0u; cnt = 0u; mine = 0u;
#pragma unroll
        for (unsigned j = 0; j < 16; ++j) { const unsigned c = xb_ld(&bar[XB_XCNT(j)]); sum += c; cnt += (c > 0u) ? 1u : 0u; mine = (j == x) ? c : mine; }
        if (sum == G) break;
        __builtin_amdgcn_s_sleep(1);
        if ((++sp & 255u) == 0u) { if (xb_ld(&bar[XB_TMO])) break; if (sp > XB_SPIN_CAP) { atomicAdd(&bar[XB_TMO], 1u); break; } }
    }
    nloc = mine > 0u ? mine : 1u; nx = cnt > 0u ? cnt : 1u;
}
__device__ __forceinline__ void xcd_barrier(const XcdBarrier& b) {
    asm volatile("s_waitcnt vmcnt(0)" ::: "memory");
    __syncthreads();
    if (threadIdx.x == 0) {
        unsigned* bar = b.bar;
        __builtin_amdgcn_s_waitcnt(0);
        unsigned nloc = b.st[0], nx = b.st[1];
        if (nloc == 0u) { xcd_barrier_complete(bar, b.x, nloc, nx); b.st[0] = nloc; b.st[1] = nx; }
        const unsigned old = xb_add(&bar[XB_XSUB(b.x)], 1u);
        const unsigned gen = old / nloc;
        if (old + 1u == (gen + 1u) * nloc) {
            __builtin_amdgcn_fence(__ATOMIC_RELEASE, "agent");
            asm volatile("s_waitcnt vmcnt(0)" ::: "memory");
            const unsigned og = xb_add(&bar[XB_TOP], 1u);
            const unsigned tg = og / nx;
            if (og + 1u == (tg + 1u) * nx) xb_add(&bar[XB_TOPGEN], 1u);
            else XB_SPIN(xb_ld(&bar[XB_TOPGEN]) == tg, bar);
            __builtin_amdgcn_fence(__ATOMIC_ACQUIRE, "agent");
            xb_add(&bar[XB_XGEN(b.x)], 1u);
            asm volatile("s_waitcnt vmcnt(0)" ::: "memory");
        } else {
            XB_SPIN(xb_ld(&bar[XB_XGEN(b.x)]) == gen, bar);
            __builtin_amdgcn_fence(__ATOMIC_ACQUIRE, "agent");
            asm volatile("s_waitcnt vmcnt(0)" ::: "memory");
        }
    }
    __syncthreads();
}

__global__ void __launch_bounds__(512, 2) mega_fwd(Args args) {
    extern __shared__ __attribute__((aligned(16))) unsigned char lds[];
    cg::grid_group grid = cg::this_grid();
    const int tid = threadIdx.x, lane = tid & 63, wave = __builtin_amdgcn_readfirstlane(tid >> 6);
    const int G = gridDim.x, gw = blockIdx.x * 8 + wave, NGW = G * 8;
    unsigned char* ws = args.ws;
    const float* x = args.in[0];
    float* out = args.out;
    bf16* WA = (bf16*)(ws + WS_WA); bf16* Wgu = (bf16*)(ws + WS_WA + WA_GU); bf16* Wdn = (bf16*)(ws + WS_WA + WA_DN);
    bf16* Watt = (bf16*)(ws + WS_WP); bf16* Wml = (bf16*)(ws + WS_WP + 2 * MiB); bf16* Wout = (bf16*)(ws + WS_WP + 4 * MiB);
    float* rope_cos = (float*)(ws + WS_ROPE); float* rope_sin = rope_cos + SEQ * 32;
    float* gates = (float*)(ws + WS_GATE);
    float* dnb = (float*)(ws + WS_MISC); float* mlocb = dnb + 1024 * 128; float* bendb = mlocb + 1024; float* mprevb = bendb + 1024;
    bf16* hA = (bf16*)(ws + WS_HA); bf16* Z = (bf16*)(ws + WS_Z); bf16* HID = (bf16*)(ws + WS_Z);
    LAS float* scr = (LAS float*)((LAS unsigned char*)lds + wave * 16384);
    const int lo = args.ph_lo, hi = args.ph_hi;
#define IN(k) (lo <= (k) && (k) < hi)
    unsigned* barw = (unsigned*)(ws + WS_MISC + MiB);
    volatile LAS unsigned* bst = (volatile LAS unsigned*)((LAS unsigned char*)lds + LDS_BYTES - 16);
    if (lo == 0) {
        if (blockIdx.x == 0) for (int u = tid; u < XCD_BAR_WORDS; u += 512) barw[u] = 0u;
        if (tid < 2) bst[tid] = 0u;
    }
    XcdBarrier xbar; xbar.bar = barw; xbar.x = 0; xbar.st = bst;
#define SEAM(k) do { if (IN(k) && IN((k) + 1)) { if ((k) == 0) { grid.sync(); xbar = xcd_barrier_post(barw, bst); } else xcd_barrier(xbar); } } while (0)

    if (IN(0)) {
        convert_weight(args.in[2], FF, D, FF / 32, Wgu, 1, gw, NGW, scr, lane);
        convert_weight(args.in[3], FF, D, FF / 32, Wgu, 2, gw, NGW, scr, lane);
        convert_weight(args.in[4], D, FF, D / 32, Wdn, 0, gw, NGW, scr, lane);
        convert_weight(args.in[13], D, D, D / 32, Watt, 0, gw, NGW, scr, lane);
        convert_weight(args.in[14], D, D, D / 32, Wml, 0, gw, NGW, scr, lane);
        convert_weight(args.in[15], D, D, D / 32, Wout, 0, gw, NGW, scr, lane);
        for (int idx = blockIdx.x * 512 + tid; idx < SEQ * 32; idx += G * 512) {
            const int pos = idx >> 5, i = idx & 31;
            const float angf = (float)pos * args.inv_freq[i];
            const double ang = (double)angf;
            const double kq = rint(ang * 0.63661977236758134308);
            const double y = (ang - kq * 1.57079632679489655800) - kq * 6.123233995736766e-17;
            const double y2 = y * y;
            const double sy = y * (1.0 + y2 * (-1.0 / 6 + y2 * (1.0 / 120 + y2 * (-1.0 / 5040 + y2 * (1.0 / 362880 + y2 * (-1.0 / 39916800 + y2 * (1.0 / 6227020800.0)))))));
            const double cy = 1.0 + y2 * (-0.5 + y2 * (1.0 / 24 + y2 * (-1.0 / 720 + y2 * (1.0 / 40320 + y2 * (-1.0 / 3628800 + y2 * (1.0 / 479001600.0 + y2 * (-1.0 / 87178291200.0)))))));
            const long long qi = (long long)kq; const int qd = (int)(qi & 3);
            const double sn = qd == 0 ? sy : qd == 1 ? cy : qd == 2 ? -sy : -cy;
            const double cs = qd == 0 ? cy : qd == 1 ? -sy : qd == 2 ? -cy : sy;
            rope_cos[idx] = (float)cs; rope_sin[idx] = (float)sn;
        }
        for (int r = gw; r < T; r += NGW) { f32x4 v[4]; norm_row(x + (size_t)r * D, args.in[1], hA + (size_t)r * D, lane, v); }
    }
    SEAM(0);
    if (IN(1)) {
        pg8::Gemm g{hA, hA, Wgu, Wgu, D, D}; pg8::StaticOrder S; S.init(T, NGU, G, (int)blockIdx.x);
        pg8::EpiSwiGLU E{HID, FF};
        pg8::gemm_phase<pg8::EpiSwiGLU, pg8::StaticOrder>((PG8_LAS unsigned char*)lds, g, S, E);
    }
    SEAM(1);
    if (IN(2)) {
        pg8::Gemm g{HID, HID, Wdn, Wdn, FF, FF}; pg8::StaticOrder S; S.init(T, D, G, (int)blockIdx.x);
        pg8::EpiResid E{x, out, D, 0.5f};
        pg8::gemm_phase<pg8::EpiResid, pg8::StaticOrder>((PG8_LAS unsigned char*)lds, g, S, E);
    }
    SEAM(2);
    if (IN(3)) {
        convert_weight(args.in[6], INW, D, ZP / 32, WA, 3, gw, NGW, scr, lane);
        const float* win = args.in[6];
        for (int r = gw; r < T; r += NGW) {
            f32x4 v[4]; norm_row(out + (size_t)r * D, args.in[5], hA + (size_t)r * D, lane, v);
            float gsum[8];
#pragma unroll
            for (int e = 0; e < 8; ++e) gsum[e] = 0.f;
#pragma unroll
            for (int j = 0; j < 4; ++j)
#pragma unroll
                for (int e = 0; e < 4; ++e) { const int k = 256 * j + 4 * lane + e; const f32x4 wa = *(const f32x4*)(win + (size_t)k * INW + 4608), wb = *(const f32x4*)(win + (size_t)k * INW + 4612); const float hv = v[j][e];
                    gsum[0] += hv * wa.x; gsum[1] += hv * wa.y; gsum[2] += hv * wa.z; gsum[3] += hv * wa.w; gsum[4] += hv * wb.x; gsum[5] += hv * wb.y; gsum[6] += hv * wb.z; gsum[7] += hv * wb.w; }
#pragma unroll
            for (int e = 0; e < 8; ++e) gsum[e] = wave_sum(gsum[e]);
            if (lane < 8) {
                float val = lane == 0 ? gsum[0] : lane == 1 ? gsum[1] : lane == 2 ? gsum[2] : lane == 3 ? gsum[3] : lane == 4 ? gsum[4] : lane == 5 ? gsum[5] : lane == 6 ? gsum[6] : gsum[7];
                if (lane < 4) val += args.in[7][lane];
                else { const float xx = val + args.in[8][lane - 4]; val = fminf(xx, 0.f) - log1pf(expf(-fabsf(xx))); }
                gates[(size_t)r * 8 + lane] = val;
            }
        }
    }
    SEAM(3);
    if (IN(4)) {
        pg8::Gemm g{hA, hA, WA, WA, D, D}; pg8::StaticOrder S; S.init(T, ZP, G, (int)blockIdx.x);
        pg8::EpiBf16 E{Z, ZP};
        pg8::gemm_phase<pg8::EpiBf16, pg8::StaticOrder>((PG8_LAS unsigned char*)lds, g, S, E);
    }
    SEAM(4);
    if (IN(5)) {
        for (int it = blockIdx.x; it < 1024; it += G) if ((it & 63) != 63) mm::dc_item(Z, gates, args.in[10], args.in[11], hA, dnb, mlocb, bendb, it, (LAS unsigned char*)lds, tid, lane, wave);
        for (int it = blockIdx.x; it < 1024; it += G) at::attn_item(Z, rope_cos, rope_sin, args.in[9], it, (LAS unsigned char*)lds, tid, lane, wave);
    }
    SEAM(5);
    if (IN(6)) {
        __syncthreads();
        mm::scan_phase(hA, dnb, mlocb, bendb, mprevb, G, tid);
        convert_weight(args.in[17], FF, D, FF / 32, Wgu, 1, gw, NGW, scr, lane);
        convert_weight(args.in[18], FF, D, FF / 32, Wgu, 2, gw, NGW, scr, lane);
        convert_weight(args.in[19], D, FF, D / 32, Wdn, 0, gw, NGW, scr, lane);
    }
    SEAM(6);
    if (IN(7)) {
        for (int it = blockIdx.x; it < 1024; it += G) mm::out_item(Z, gates, args.in[10], args.in[11], hA, dnb, mprevb, args.in[12], it, (LAS unsigned char*)lds, tid, lane, wave);
    }
    SEAM(7);
    if (IN(8)) {
        pg8::Gemm g{Z + ZQA, Z + ZOM, Watt, Wml, ZP, D}; pg8::PairOrder S; S.so.init(T, D, G, (int)blockIdx.x);
        pg8::EpiMix E{Z, Z + ZQM, ZP, ZGA, ZGM};
        pg8::gemm_phase<pg8::EpiMix, pg8::PairOrder>((PG8_LAS unsigned char*)lds, g, S, E);
    }
    SEAM(8);
    if (IN(9)) {
        pg8::Gemm g{Z + ZQM, Z + ZQM, Wout, Wout, ZP, D}; pg8::StaticOrder S; S.init(T, D, G, (int)blockIdx.x);
        pg8::EpiResid E{out, out, D, 1.0f};
        pg8::gemm_phase<pg8::EpiResid, pg8::StaticOrder>((PG8_LAS unsigned char*)lds, g, S, E);
    }
    SEAM(9);
    if (IN(10)) {
        for (int r = gw; r < T; r += NGW) { f32x4 v[4]; norm_row(out + (size_t)r * D, args.in[16], hA + (size_t)r * D, lane, v); }
    }
    SEAM(10);
    if (IN(11)) {
        pg8::Gemm g{hA, hA, Wgu, Wgu, D, D}; pg8::StaticOrder S; S.init(T, NGU, G, (int)blockIdx.x);
        pg8::EpiSwiGLU E{HID, FF};
        pg8::gemm_phase<pg8::EpiSwiGLU, pg8::StaticOrder>((PG8_LAS unsigned char*)lds, g, S, E);
    }
    SEAM(11);
    if (IN(12)) {
        pg8::Gemm g{HID, HID, Wdn, Wdn, FF, FF}; pg8::StaticOrder S; S.init(T, D, G, (int)blockIdx.x);
        pg8::EpiResid E{out, out, D, 0.5f};
        pg8::gemm_phase<pg8::EpiResid, pg8::StaticOrder>((PG8_LAS unsigned char*)lds, g, S, E);
    }
    SEAM(12);
    if (IN(13)) {
        const float* gain = args.in[20];
        for (int r = gw; r < T; r += NGW) {
            f32x4* xr = (f32x4*)(out + (size_t)r * D) + lane; const f32x4* gr = (const f32x4*)gain + lane;
            f32x4 v[4]; float s = 0.f;
#pragma unroll
            for (int j = 0; j < 4; ++j) { v[j] = xr[64 * j]; s += (v[j].x * v[j].x + v[j].y * v[j].y) + (v[j].z * v[j].z + v[j].w * v[j].w); }
            const float rstd = 1.0f / sqrtf(wave_sum(s) * (1.0f / D) + RMS_EPS);
#pragma unroll
            for (int j = 0; j < 4; ++j) xr[64 * j] = v[j] * rstd * gr[64 * j];
        }
    }
#undef IN
#undef SEAM
}

extern "C" void kernel_launch(void* const* d_in, const int* in_sizes, int n_in, void* d_out, int out_size, void* d_ws, size_t ws_size, hipStream_t stream) {
    static int grid = 0;
    if (grid == 0) {
        if (n_in != 21 || out_size != T * D || ws_size < WS_END) { fprintf(stderr, "kernel_launch: unexpected shapes (n_in %d out %d ws %zu)\n", n_in, out_size, ws_size); grid = -1; return; }
        int dev = 0, cus = 0, per_cu = 0;
        hipGetDevice(&dev); hipDeviceGetAttribute(&cus, hipDeviceAttributeMultiprocessorCount, dev);
        if (hipFuncSetAttribute((const void*)mega_fwd, hipFuncAttributeMaxDynamicSharedMemorySize, LDS_BYTES) != hipSuccess) { fprintf(stderr, "kernel_launch: hipFuncSetAttribute failed\n"); grid = -1; return; }
        if (hipOccupancyMaxActiveBlocksPerMultiprocessor(&per_cu, (const void*)mega_fwd, 512, LDS_BYTES) != hipSuccess || per_cu < 1) { fprintf(stderr, "kernel_launch: occupancy query failed (%d)\n", per_cu); per_cu = 1; }
        (void)hipGetLastError();
        grid = cus * per_cu;
    }
    if (grid < 0) return;
    Args a{};
    for (int i = 0; i < 21; ++i) a.in[i] = (const float*)d_in[i];
    a.out = (float*)d_out; a.ws = (unsigned char*)d_ws;
    for (int i = 0; i < 32; ++i) a.inv_freq[i] = (float)pow(10000.0, -(double)i / 32.0);
#if MK_PER_PHASE_LAUNCH
    for (int ph = 0; ph < NPHASE; ++ph) { a.ph_lo = ph; a.ph_hi = ph + 1; hipLaunchKernelGGL(mega_fwd, dim3(grid), dim3(512), LDS_BYTES, stream, a); }
#else
    a.ph_lo = 0; a.ph_hi = NPHASE;
    void* kargs[] = {&a};
    hipError_t e = hipLaunchCooperativeKernel((const void*)mega_fwd, dim3(grid), dim3(512), kargs, LDS_BYTES, stream);
    if (e != hipSuccess) fprintf(stderr, "kernel_launch: cooperative launch failed: %s (grid %d)\n", hipGetErrorString(e), grid);
#endif
}
```

```cpp
#include <hip/hip_runtime.h>
#include <hip/hip_cooperative_groups.h>
#include <cstdio>
#include <cstdint>
#include <cmath>
namespace cg = cooperative_groups;

#ifndef MK_PER_PHASE_LAUNCH
#define MK_PER_PHASE_LAUNCH 0
#endif

namespace pg8 {
#define PG8_LAS __attribute__((address_space(3)))
typedef unsigned short bf16_t;
typedef short bf16x8 __attribute__((ext_vector_type(8)));
typedef float f32x4 __attribute__((ext_vector_type(4)));
typedef unsigned u32x4 __attribute__((ext_vector_type(4)));
constexpr int BM = 256, BK = 64, HALF = 128, HTB = HALF * BK * 2, STAGE_BYTES = 8 * HTB, NXCD = 8, WGM = 8;

__host__ __device__ __forceinline__ int lds_byte(int r, int c) { const int st = (r >> 4) * 2 + (c >> 5), rr = r & 15, cc = c & 31, ob = rr * 64 + cc * 2; return st * 1024 + (ob ^ (((ob >> 9) & 1) << 5)); }
__host__ __device__ __forceinline__ void stage_rc(int b, int& R, int& C) { const int st = b / 1024, sb = b % 1024, swz = sb ^ (((sb >> 9) & 1) << 5); R = (st >> 1) * 16 + swz / 64; C = (st & 1) * 32 + (swz % 64) / 2; }
__host__ __device__ __forceinline__ int perm32(int rho) { const int n = rho >> 4, i = rho & 15; return 8 * (i >> 2) + 4 * n + (i & 3); }

struct Unit { int pm, pn, kind; };
struct Gemm { const bf16_t* A0; const bf16_t* A1; const bf16_t* B0; const bf16_t* B1; int lda, K; };

struct StaticOrder {
    int nM, nN, nwg, G, c;
    __host__ __device__ void init(int M, int N, int G_, int c_) { nM = M / BM; nN = N / BM; nwg = nM * nN; G = G_; c = c_; }
    __host__ __device__ bool next(int i, Unit& u) const {
        const long L = (long)i * G + c; if (L >= nwg) return false;
        int wgid = (int)L; { const int q = nwg / NXCD, r = nwg % NXCD, xcd = wgid % NXCD, off = wgid / NXCD; wgid = (xcd < r ? xcd * (q + 1) : r * (q + 1) + (xcd - r) * q) + off; }
        const int nig = WGM * nN, gid = wgid / nig, fm = gid * WGM, gsz = (nM - fm) < WGM ? (nM - fm) : WGM;
        u.pm = fm + ((wgid % nig) % gsz); u.pn = (wgid % nig) / gsz; u.kind = 0; return true;
    }
};
struct PairOrder {
    StaticOrder so;
    __host__ __device__ bool next(int i, Unit& u) const { if (!so.next(i >> 1, u)) return false; u.kind = i & 1; return true; }
};

__device__ __forceinline__ unsigned cvt_pk_bf16(float lo, float hi) { unsigned r; asm volatile("v_cvt_pk_bf16_f32 %0, %1, %2" : "=v"(r) : "v"(lo), "v"(hi)); return r; }
__device__ __forceinline__ float bf_lo(unsigned w) { return __uint_as_float(w << 16); }
__device__ __forceinline__ float bf_hi(unsigned w) { return __uint_as_float(w & 0xffff0000u); }
__device__ __forceinline__ float sigmoid_den(float x) { return 1.0f + __expf(-x); }


struct EpiBf16 {
    bf16_t* O; int ldc;
    __device__ __forceinline__ bool operator()(f32x4 (&acc)[2][2][4][2], const Unit& u, int wr, int wc, int fr, int fq) const {
        const int row0 = u.pm * BM + wr * 64 + fr, col0 = u.pn * BM + wc * 32 + 8 * fq;
#pragma unroll
        for (int ai = 0; ai < 2; ++ai)
#pragma unroll
            for (int m = 0; m < 4; ++m) { bf16_t* rowp = O + (size_t)(row0 + ai * HALF + m * 16) * ldc + col0;
#pragma unroll
                for (int bj = 0; bj < 2; ++bj) { const f32x4 v0 = acc[ai][bj][m][0], v1 = acc[ai][bj][m][1];
                    u32x4 w; w.x = cvt_pk_bf16(v0[0], v0[1]); w.y = cvt_pk_bf16(v0[2], v0[3]); w.z = cvt_pk_bf16(v1[0], v1[1]); w.w = cvt_pk_bf16(v1[2], v1[3]);
                    *(u32x4*)(rowp + bj * HALF) = w; } }
        return true;
    }
};
struct EpiSwiGLU {
    bf16_t* O; int ldc;
    __device__ __forceinline__ bool operator()(f32x4 (&acc)[2][2][4][2], const Unit& u, int wr, int wc, int fr, int fq) const {
        const int row0 = u.pm * BM + wr * 64 + fr, col0 = u.pn * HALF + wc * 32 + 8 * fq;
#pragma unroll
        for (int ai = 0; ai < 2; ++ai)
#pragma unroll
            for (int m = 0; m < 4; ++m) { bf16_t* rowp = O + (size_t)(row0 + ai * HALF + m * 16) * ldc + col0;
                float r[8];
#pragma unroll
                for (int n = 0; n < 2; ++n)
#pragma unroll
                    for (int e = 0; e < 4; ++e) { const float g = acc[ai][0][m][n][e], up = acc[ai][1][m][n][e]; r[4 * n + e] = g * __builtin_amdgcn_rcpf(1.0f + __expf(-g)) * up; }
                u32x4 w; w.x = cvt_pk_bf16(r[0], r[1]); w.y = cvt_pk_bf16(r[2], r[3]); w.z = cvt_pk_bf16(r[4], r[5]); w.w = cvt_pk_bf16(r[6], r[7]);
                *(u32x4*)rowp = w; }
        return true;
    }
};
struct EpiResid {
    const float* base; float* out; int ldc; float alpha;
    __device__ __forceinline__ bool operator()(f32x4 (&acc)[2][2][4][2], const Unit& u, int wr, int wc, int fr, int fq) const {
        const int row0 = u.pm * BM + wr * 64 + fr, col0 = u.pn * BM + wc * 32 + 8 * fq;
#pragma unroll
        for (int ai = 0; ai < 2; ++ai)
#pragma unroll
            for (int m = 0; m < 4; ++m) { const size_t off = (size_t)(row0 + ai * HALF + m * 16) * ldc + col0;
#pragma unroll
                for (int bj = 0; bj < 2; ++bj)
#pragma unroll
                    for (int n = 0; n < 2; ++n) { const f32x4 b = *(const f32x4*)(base + off + bj * HALF + 4 * n); *(f32x4*)(out + off + bj * HALF + 4 * n) = b + acc[ai][bj][m][n] * alpha; } }
        return true;
    }
};
struct EpiMix {
    const bf16_t* Z; bf16_t* Y; int ldz; int cga, cgm;
    __device__ __forceinline__ bool operator()(f32x4 (&acc)[2][2][4][2], const Unit& u, int wr, int wc, int fr, int fq) const {
        const int row0 = u.pm * BM + wr * 64 + fr, col0 = u.pn * BM + wc * 32 + 8 * fq;
#pragma unroll
        for (int ai = 0; ai < 2; ++ai)
#pragma unroll
            for (int m = 0; m < 4; ++m) { const size_t off = (size_t)(row0 + ai * HALF + m * 16) * ldz + col0;
#pragma unroll
                for (int bj = 0; bj < 2; ++bj) {
                    const u32x4 gm = *(const u32x4*)(Z + off + cgm + bj * HALF);
                    float dm[8] = {sigmoid_den(bf_lo(gm.x)), sigmoid_den(bf_hi(gm.x)), sigmoid_den(bf_lo(gm.y)), sigmoid_den(bf_hi(gm.y)), sigmoid_den(bf_lo(gm.z)), sigmoid_den(bf_hi(gm.z)), sigmoid_den(bf_lo(gm.w)), sigmoid_den(bf_hi(gm.w))};
                    if (u.kind == 0) {
                        const u32x4 ga = *(const u32x4*)(Z + off + cga + bj * HALF);
                        float da[8] = {sigmoid_den(bf_lo(ga.x)), sigmoid_den(bf_hi(ga.x)), sigmoid_den(bf_lo(ga.y)), sigmoid_den(bf_hi(ga.y)), sigmoid_den(bf_lo(ga.z)), sigmoid_den(bf_hi(ga.z)), sigmoid_den(bf_lo(ga.w)), sigmoid_den(bf_hi(ga.w))};
#pragma unroll
                        for (int n = 0; n < 2; ++n)
#pragma unroll
                            for (int e = 0; e < 4; ++e) acc[ai][bj][m][n][e] *= dm[4 * n + e] * __builtin_amdgcn_rcpf(da[4 * n + e]);
                    } else {
                        float r[8];
#pragma unroll
                        for (int n = 0; n < 2; ++n)
#pragma unroll
                            for (int e = 0; e < 4; ++e) r[4 * n + e] = acc[ai][bj][m][n][e] * __builtin_amdgcn_rcpf(dm[4 * n + e]);
                        u32x4 w; w.x = cvt_pk_bf16(r[0], r[1]); w.y = cvt_pk_bf16(r[2], r[3]); w.z = cvt_pk_bf16(r[4], r[5]); w.w = cvt_pk_bf16(r[6], r[7]);
                        *(u32x4*)(Y + off + bj * HALF) = w;
                    }
                } }
        return u.kind != 0;
    }
};

template <class Epi, class Sched>
__device__ __forceinline__ void gemm_phase(PG8_LAS unsigned char* lds, const Gemm g, const Sched& S, const Epi& E) {
    const int tid = threadIdx.x, wid = __builtin_amdgcn_readfirstlane(tid >> 6), lane = tid & 63, wr = wid >> 2, wc = wid & 3, fr = lane & 15, fq = lane >> 4;
    const int K = g.K, nt = K / BK, lda = g.lda;
    unsigned voffA[2], voffB[2];
#pragma unroll
    for (int i = 0; i < 2; ++i) { int R, C; stage_rc(tid * 16 + i * 8192, R, C); const int Rb = (R & ~31) + perm32(R & 31);
        voffA[i] = (unsigned)(R * lda + C) * 2u; voffB[i] = (unsigned)(Rb * K + C) * 2u; }
    const size_t kstep = (size_t)(BK * 2);
    const size_t hstepA = (size_t)HALF * lda * 2, hstepB = (size_t)HALF * K * 2;
    const size_t tstepA = 2 * hstepA, tstepB = 2 * hstepB;
    const unsigned ldsw = (unsigned)wid * 1024u;
    const int aoff = lds_byte(wr * 64 + fr, fq * 8), boff = lds_byte(wc * 32 + fr, fq * 8);
#define PG8_SA(b, h) (((b) * 2 + (h)) * HTB)
#define PG8_SB(b, h) ((4 + (b) * 2 + (h)) * HTB)
#define PG8_STAGE(bufoff, gbase, voff) do { _Pragma("unroll") for (int _i = 0; _i < 2; ++_i) \
        __builtin_amdgcn_global_load_lds((const unsigned*)((const char*)(gbase) + (voff)[_i]), (PG8_LAS unsigned*)(lds + (bufoff) + ldsw + _i * 8192), 16, 0, 0); } while (0)
#define PG8_LDA(dst, b, h) do { _Pragma("unroll") for (int m = 0; m < 4; ++m) _Pragma("unroll") for (int k = 0; k < 2; ++k) dst[m][k] = *(const PG8_LAS bf16x8*)(lds + PG8_SA(b, h) + aoff + m * 2048 + k * 1024); } while (0)
#define PG8_LDB(dst, b, h) do { _Pragma("unroll") for (int n = 0; n < 2; ++n) _Pragma("unroll") for (int k = 0; k < 2; ++k) dst[n][k] = *(const PG8_LAS bf16x8*)(lds + PG8_SB(b, h) + boff + n * 2048 + k * 1024); } while (0)
#define PG8_MMA(ai, bj, At, Bt) do { __builtin_amdgcn_s_setprio(1); _Pragma("unroll") for (int m = 0; m < 4; ++m) _Pragma("unroll") for (int n = 0; n < 2; ++n) _Pragma("unroll") for (int k = 0; k < 2; ++k) \
        acc[ai][bj][m][n] = __builtin_amdgcn_mfma_f32_16x16x32_bf16(Bt[n][k], At[m][k], acc[ai][bj][m][n], 0, 0, 0); __builtin_amdgcn_s_setprio(0); } while (0)
#define PG8_WAIT_V(n) asm volatile("s_waitcnt vmcnt(" #n ")" ::: "memory")
#define PG8_WAIT_L(n) asm volatile("s_waitcnt lgkmcnt(" #n ")" ::: "memory")
#define PG8_BAR __builtin_amdgcn_s_barrier()
#define PG8_SCHED __builtin_amdgcn_sched_barrier(0)
    Unit cur, nxt; int ui = 0;
    if (!S.next(0, cur)) return;
    f32x4 acc[2][2][4][2];
#pragma unroll
    for (int a = 0; a < 2; ++a)
#pragma unroll
        for (int b = 0; b < 2; ++b)
#pragma unroll
            for (int m = 0; m < 4; ++m)
#pragma unroll
                for (int n = 0; n < 2; ++n) acc[a][b][m][n] = (f32x4){0.f, 0.f, 0.f, 0.f};
    bf16x8 At[4][2], B0[2][2], B1[2][2];
    const char* cA = (const char*)(cur.kind ? g.A1 : g.A0) + (size_t)cur.pm * tstepA; const char* cB = (const char*)(cur.kind ? g.B1 : g.B0) + (size_t)cur.pn * tstepB;
    PG8_STAGE(PG8_SB(0, 0), cB, voffB); PG8_STAGE(PG8_SB(0, 1), cB + hstepB, voffB); PG8_STAGE(PG8_SA(0, 0), cA, voffA); PG8_STAGE(PG8_SA(0, 1), cA + hstepA, voffA);
    if (wr == 1) PG8_BAR;
    PG8_WAIT_V(2); PG8_BAR;
    PG8_STAGE(PG8_SB(1, 0), cB + kstep, voffB); PG8_STAGE(PG8_SA(1, 0), cA + kstep, voffA); PG8_STAGE(PG8_SB(1, 1), cB + hstepB + kstep, voffB);
    PG8_WAIT_V(6); PG8_BAR;
    for (;;) {
        const bool has_next = S.next(ui + 1, nxt);
        const char* nA = has_next ? (const char*)(nxt.kind ? g.A1 : g.A0) + (size_t)nxt.pm * tstepA : cA; const char* nB = has_next ? (const char*)(nxt.kind ? g.B1 : g.B0) + (size_t)nxt.pn * tstepB : cB;
        for (int t = 0; t < nt; t += 2) {
            const bool last = (t == nt - 2);
            const char* a1 = cA + (size_t)(t + 1) * kstep;
            const char* a2 = last ? nA : cA + (size_t)(t + 2) * kstep; const char* b2 = last ? nB : cB + (size_t)(t + 2) * kstep;
            const char* a3 = a2 + kstep; const char* b3 = b2 + kstep;
            PG8_LDB(B0, 0, 0); PG8_LDB(B1, 0, 1); PG8_SCHED; PG8_LDA(At, 0, 0); PG8_STAGE(PG8_SA(1, 1), a1 + hstepA, voffA);
            PG8_WAIT_V(8); PG8_WAIT_L(0); PG8_BAR; PG8_MMA(0, 0, At, B0); PG8_MMA(0, 1, At, B1); PG8_BAR; PG8_SCHED;
            PG8_LDA(At, 0, 1); PG8_STAGE(PG8_SB(0, 0), b2, voffB); PG8_STAGE(PG8_SB(0, 1), b2 + hstepB, voffB); PG8_STAGE(PG8_SA(0, 0), a2, voffA);
            PG8_WAIT_V(8); PG8_WAIT_L(0); PG8_BAR; PG8_MMA(1, 0, At, B0); PG8_MMA(1, 1, At, B1); PG8_BAR; PG8_SCHED;
            PG8_LDB(B0, 1, 0); PG8_LDB(B1, 1, 1); PG8_SCHED; PG8_LDA(At, 1, 0); PG8_STAGE(PG8_SA(0, 1), a2 + hstepA, voffA);
            PG8_WAIT_V(8); PG8_WAIT_L(0); PG8_BAR; PG8_MMA(0, 0, At, B0); PG8_MMA(0, 1, At, B1); PG8_BAR; PG8_SCHED;
            PG8_LDA(At, 1, 1); PG8_STAGE(PG8_SB(1, 0), b3, voffB); PG8_STAGE(PG8_SB(1, 1), b3 + hstepB, voffB); PG8_STAGE(PG8_SA(1, 0), a3, voffA);
            PG8_WAIT_V(8); PG8_WAIT_L(0); PG8_BAR; PG8_MMA(1, 0, At, B0); PG8_MMA(1, 1, At, B1); PG8_BAR; PG8_SCHED;
        }
        if (wr == 0) PG8_BAR;
        const bool zero = E(acc, cur, wr, wc, fr, fq);
        if (!has_next) break;
        if (zero) {
#pragma unroll
            for (int a = 0; a < 2; ++a)
#pragma unroll
                for (int b = 0; b < 2; ++b)
#pragma unroll
                    for (int m = 0; m < 4; ++m)
#pragma unroll
                        for (int n = 0; n < 2; ++n) acc[a][b][m][n] = (f32x4){0.f, 0.f, 0.f, 0.f};
        }
        cur = nxt; cA = nA; cB = nB; ++ui;
        if (wr == 1) PG8_BAR;
    }
    PG8_WAIT_V(0);
    PG8_BAR;
#undef PG8_SA
#undef PG8_SB
#undef PG8_STAGE
#undef PG8_LDA
#undef PG8_LDB
#undef PG8_MMA
#undef PG8_WAIT_V
#undef PG8_WAIT_L
#undef PG8_BAR
#undef PG8_SCHED
}
}

typedef unsigned short bf16;
typedef float f32x4 __attribute__((ext_vector_type(4)));
typedef unsigned u32x4 __attribute__((ext_vector_type(4)));
typedef unsigned u32x2 __attribute__((ext_vector_type(2)));
#define LAS __attribute__((address_space(3)))

constexpr int BATCH = 4, SEQ = 8192, T = BATCH * SEQ, D = 1024, FF = 2816, NGU = 2 * FF, ZP = 6656, INW = 6664;
constexpr int ZQA = 0, ZKA = 1024, ZVA = 1280, ZQM = 1536, ZKM = 2048, ZVM = 2560, ZOM = 3584, ZGA = 4608, ZGM = 5632;
constexpr float RMS_EPS = 1e-5f;
constexpr size_t MiB = (size_t)1 << 20;
constexpr size_t WS_WA = 0, WS_WP = 17 * MiB, WS_ROPE = 23 * MiB, WS_GATE = 25 * MiB, WS_MISC = 26 * MiB, WS_HA = 28 * MiB, WS_Z = 92 * MiB, WS_END = 508 * MiB;
constexpr size_t WA_GU = 0, WA_DN = 11 * MiB;
constexpr int LDS_BYTES = 147456;
constexpr int NPHASE = 14;

struct Args {
    const float* in[21]; float* out; unsigned char* ws; float inv_freq[32]; int ph_lo, ph_hi;
};

__device__ __forceinline__ unsigned f2bf(float f) { unsigned u = __builtin_bit_cast(unsigned, f); return (u + 0x7fffu + ((u >> 16) & 1u)) >> 16; }
__device__ __forceinline__ unsigned pk2(float lo, float hi) { return f2bf(lo) | (f2bf(hi) << 16); }
__device__ __forceinline__ float bf2f(bf16 b) { return __uint_as_float((unsigned)b << 16); }
__device__ __forceinline__ float wave_sum(float v) {
#pragma unroll
    for (int o = 1; o < 64; o <<= 1) v += __shfl_xor(v, o);
    return v;
}

__device__ __forceinline__ void transpose_item(const float* W, int pitch, int src_col0, int K, bf16* WT, int dst_row0, int k0, LAS float* scr, int lane) {
    typedef float f32x2v __attribute__((ext_vector_type(2)));
#pragma unroll 8
    for (int i = 0; i < 32; ++i) { const int kk = 2 * i + (lane >> 5), cc = 2 * (lane & 31); const f32x2v v = *(const f32x2v*)(W + (size_t)(k0 + kk) * pitch + src_col0 + cc); scr[kk * 65 + cc] = v.x; scr[kk * 65 + cc + 1] = v.y; }
    asm volatile("s_waitcnt lgkmcnt(0)" ::: "memory");
    const int c = lane & 7;
#pragma unroll
    for (int j = 0; j < 8; ++j) { const int n = (lane >> 3) + 8 * j; const LAS float* s = scr + (8 * c) * 65 + n;
        u32x4 o; o.x = pk2(s[0 * 65], s[1 * 65]); o.y = pk2(s[2 * 65], s[3 * 65]); o.z = pk2(s[4 * 65], s[5 * 65]); o.w = pk2(s[6 * 65], s[7 * 65]);
        *(u32x4*)(WT + (size_t)(dst_row0 + n) * K + k0 + 8 * c) = o; }
    asm volatile("s_waitcnt lgkmcnt(0)" ::: "memory");
}
__device__ __forceinline__ void convert_weight(const float* W, int pitch, int K, int nblk, bf16* WT, int mode, int gw, int NGW, LAS float* scr, int lane) {
    const int nitems = (K / 64) * nblk;
    for (int it = gw; it < nitems; it += NGW) {
        const int kb = it / nblk, nb = it % nblk; int src = 64 * nb, dst = 64 * nb;
        if (mode == 1) dst = 256 * (src >> 7) + (src & 127);
        else if (mode == 2) dst = 256 * (src >> 7) + (src & 127) + 128;
        else if (mode == 3) src = dst < 4608 ? dst : dst + 8;
        transpose_item(W, pitch, src, K, WT, dst, 64 * kb, scr, lane);
    }
}

__device__ __forceinline__ void norm_row(const float* xrow, const float* gain, bf16* orow, int lane, f32x4 (&v)[4]) {
    const f32x4* xr = (const f32x4*)xrow + lane; const f32x4* gr = (const f32x4*)gain + lane;
    float s = 0.f;
#pragma unroll
    for (int j = 0; j < 4; ++j) { v[j] = xr[64 * j]; s += (v[j].x * v[j].x + v[j].y * v[j].y) + (v[j].z * v[j].z + v[j].w * v[j].w); }
    const float rstd = 1.0f / sqrtf(wave_sum(s) * (1.0f / D) + RMS_EPS);
    unsigned long long* o8 = (unsigned long long*)orow + lane;
#pragma unroll
    for (int j = 0; j < 4; ++j) { const f32x4 g = gr[64 * j]; v[j] = v[j] * rstd * g;
        o8[64 * j] = (unsigned long long)pk2(v[j].x, v[j].y) | ((unsigned long long)pk2(v[j].z, v[j].w) << 32); }
}

namespace mm {
typedef short bf16x8 __attribute__((ext_vector_type(8)));
typedef short s16x4 __attribute__((ext_vector_type(4)));
typedef short v4i16_t __attribute__((ext_vector_type(4)));
typedef float f32x16 __attribute__((ext_vector_type(16)));
typedef float f32x8 __attribute__((ext_vector_type(8)));
typedef __bf16 bfv8 __attribute__((ext_vector_type(8)));
#define MFMA32(a, b, c) __builtin_amdgcn_mfma_f32_32x32x16_bf16((a), (b), (c), 0, 0, 0)
constexpr int PQ = 272, PV = 528;
__device__ __forceinline__ s16x4 vtr(const LAS unsigned char* p) { return __builtin_bit_cast(s16x4, __builtin_amdgcn_ds_read_tr16_b64_v4i16((LAS v4i16_t*)p)); }
__device__ __forceinline__ bf16x8 rowread(const LAS unsigned char* img, int pitch, int r0, int k0, int lane) { return *(const LAS bf16x8*)(img + (r0 + (lane & 31)) * pitch + (k0 + 8 * (lane >> 5)) * 2); }
template <bool PERM> __device__ __forceinline__ bf16x8 trread(const LAS unsigned char* img, int pitch, int k0, int c0, int lane) {
    const int h = lane >> 5, blk = (lane >> 4) & 1, q = (lane & 15) >> 2, p = lane & 3;
    const int rlo = PERM ? k0 + 4 * h + q : k0 + 8 * h + q, rhi = PERM ? k0 + 8 + 4 * h + q : k0 + 8 * h + 4 + q;
    const int cb = (c0 + 16 * blk + 4 * p) * 2;
    const s16x4 lo = vtr(img + rlo * pitch + cb), hi = vtr(img + rhi * pitch + cb);
    return __builtin_shufflevector(lo, hi, 0, 1, 2, 3, 4, 5, 6, 7);
}
__device__ __forceinline__ bf16x8 pack8(const f32x16& x, int s) {
    f32x8 v;
#pragma unroll
    for (int j = 0; j < 8; ++j) v[j] = x[8 * s + j];
    return __builtin_bit_cast(bf16x8, __builtin_convertvector(v, bfv8));
}
__device__ __forceinline__ void stage_conv(LAS unsigned char* img, const bf16* z, size_t tokb, int t0, int zcol0, const float* cw, const float* cbias, float scale, int tid) {
    const int cg8 = (tid & 15) * 8, lr = tid >> 4;
    float w[4][8], bb[8];
#pragma unroll
    for (int j = 0; j < 4; ++j) { const f32x4 a = *(const f32x4*)(cw + j * 1024 + cg8), b = *(const f32x4*)(cw + j * 1024 + cg8 + 4); w[j][0] = a.x; w[j][1] = a.y; w[j][2] = a.z; w[j][3] = a.w; w[j][4] = b.x; w[j][5] = b.y; w[j][6] = b.z; w[j][7] = b.w; }
    { const f32x4 a = *(const f32x4*)(cbias + cg8), b = *(const f32x4*)(cbias + cg8 + 4); bb[0] = a.x; bb[1] = a.y; bb[2] = a.z; bb[3] = a.w; bb[4] = b.x; bb[5] = b.y; bb[6] = b.z; bb[7] = b.w; }
    float r[7][8];
#pragma unroll
    for (int jj = 0; jj < 7; ++jj) { const int t = t0 + 4 * lr - 3 + jj; u32x4 v = {0u, 0u, 0u, 0u};
        if (t >= 0) v = *(const u32x4*)(z + (tokb + t) * ZP + zcol0 + cg8);
        r[jj][0] = pg8::bf_lo(v.x); r[jj][1] = pg8::bf_hi(v.x); r[jj][2] = pg8::bf_lo(v.y); r[jj][3] = pg8::bf_hi(v.y); r[jj][4] = pg8::bf_lo(v.z); r[jj][5] = pg8::bf_hi(v.z); r[jj][6] = pg8::bf_lo(v.w); r[jj][7] = pg8::bf_hi(v.w); }
#pragma unroll
    for (int i = 0; i < 4; ++i) { float y[8];
#pragma unroll
        for (int e = 0; e < 8; ++e) { float s = w[0][e] * r[i][e] + w[1][e] * r[i + 1][e] + w[2][e] * r[i + 2][e] + w[3][e] * r[i + 3][e] + bb[e]; y[e] = s / (1.0f + __expf(-s)) * scale; }
        u32x4 o; o.x = pk2(y[0], y[1]); o.y = pk2(y[2], y[3]); o.z = pk2(y[4], y[5]); o.w = pk2(y[6], y[7]);
        *(LAS u32x4*)(img + (4 * lr + i) * PQ + cg8 * 2) = o; }
}
template <bool SCALE> __device__ __forceinline__ void stage_v(LAS unsigned char* img, const bf16* z, size_t tok0, int h, const LAS float* aa, int tid) {
    const int v8 = (tid & 31) * 8, l0 = tid >> 5;
#pragma unroll
    for (int i = 0; i < 8; ++i) { const int l = l0 + 16 * i; u32x4 v = *(const u32x4*)(z + (tok0 + l) * ZP + ZVM + h * 256 + v8);
        if (SCALE) { const float a = aa[l]; v.x = pk2(pg8::bf_lo(v.x) * a, pg8::bf_hi(v.x) * a); v.y = pk2(pg8::bf_lo(v.y) * a, pg8::bf_hi(v.y) * a); v.z = pk2(pg8::bf_lo(v.z) * a, pg8::bf_hi(v.z) * a); v.w = pk2(pg8::bf_lo(v.w) * a, pg8::bf_hi(v.w) * a); }
        *(LAS u32x4*)(img + l * PV + v8 * 2) = v; }
}
__device__ __forceinline__ void scan_add2(float a0, float a1, int lane, float& s0, float& s1) {
    float p = a0 + a1;
#pragma unroll
    for (int o = 1; o < 64; o <<= 1) { const float t = __shfl_up(p, o); if (lane >= o) p += t; }
    s1 = p; s0 = p - a1;
}
__device__ __forceinline__ void scan_max2(float a0, float a1, int lane, float& s0, float& s1) {
    float p = fmaxf(a0, a1);
#pragma unroll
    for (int o = 1; o < 64; o <<= 1) { const float t = __shfl_up(p, o); if (lane >= o) p = fmaxf(p, t); }
    s1 = p; const float prev = __shfl_up(p, 1); s0 = lane > 0 ? fmaxf(prev, a0) : a0;
}
constexpr int OFF_K1 = 0, OFF_V1 = 34816, OFF_F1 = 34816 + 67584;
__device__ __forceinline__ void dc_item(const bf16* z, const float* gates, const float* conv_w, const float* conv_b, bf16* dC, float* dn, float* mloc, float* bend, int item, LAS unsigned char* L, int tid, int lane, int wave) {
    const int b = item >> 8, h = (item >> 6) & 3, c = item & 63;
    const size_t tokb = (size_t)b * SEQ, tok0 = tokb + (size_t)c * 128;
    LAS unsigned char* kimg = L + OFF_K1; LAS unsigned char* vimg = L + OFF_V1; LAS float* lf = (LAS float*)(L + OFF_F1); LAS float* ig = lf + 128; LAS float* bc = lf + 256; LAS float* aa = lf + 384;
    __syncthreads();
    if (wave == 0) {
        const float lf0 = gates[(tok0 + 2 * lane) * 8 + 4 + h], lf1 = gates[(tok0 + 2 * lane + 1) * 8 + 4 + h], ig0 = gates[(tok0 + 2 * lane) * 8 + h], ig1 = gates[(tok0 + 2 * lane + 1) * 8 + h];
        float b0, b1; scan_add2(lf0, lf1, lane, b0, b1);
        const float be = __shfl(b1, 63), w0 = be - b0 + ig0, w1 = be - b1 + ig1;
        float ml = fmaxf(w0, w1);
#pragma unroll
        for (int o = 1; o < 64; o <<= 1) ml = fmaxf(ml, __shfl_xor(ml, o));
        aa[2 * lane] = __expf(w0 - ml); aa[2 * lane + 1] = __expf(w1 - ml);
        if (lane == 0) { mloc[item] = ml; bend[item] = be; }
    }
    stage_conv(kimg, z, tokb, c * 128, ZKM + h * 128, conv_w + 512 + h * 128, conv_b + 512 + h * 128, 0.08838834764831845f, tid);
    __syncthreads();
    stage_v<true>(vimg, z, tok0, h, aa, tid);
    __syncthreads();
    { const int d = tid >> 2, part = tid & 3; float s = 0.f;
#pragma unroll 4
      for (int l = part * 32; l < part * 32 + 32; ++l) s += aa[l] * bf2f(*(const LAS bf16*)(kimg + l * PQ + d * 2));
      s += __shfl_xor(s, 1); s += __shfl_xor(s, 2);
      if (part == 0) dn[(size_t)item * 128 + d] = s; }
    f32x16 acc[4];
#pragma unroll
    for (int dt = 0; dt < 4; ++dt)
#pragma unroll
        for (int i = 0; i < 16; ++i) acc[dt][i] = 0.f;
#pragma unroll 2
    for (int ks = 0; ks < 8; ++ks) { const bf16x8 bv = trread<false>(vimg, PV, 16 * ks, 32 * wave, lane);
#pragma unroll
        for (int dt = 0; dt < 4; ++dt) { const bf16x8 ak = trread<false>(kimg, PQ, 16 * ks, 32 * dt, lane); acc[dt] = MFMA32(ak, bv, acc[dt]); } }
    const int r = lane & 31, hh = lane >> 5;
    bf16* orow = dC + (size_t)item * 32768 + (size_t)(32 * wave + r) * 128;
#pragma unroll
    for (int dt = 0; dt < 4; ++dt)
#pragma unroll
        for (int g = 0; g < 4; ++g) { u32x2 o; o.x = pk2(acc[dt][4 * g], acc[dt][4 * g + 1]); o.y = pk2(acc[dt][4 * g + 2], acc[dt][4 * g + 3]); *(u32x2*)(orow + 32 * dt + 8 * g + 4 * hh) = o; }
}
__device__ __forceinline__ void scan_phase(bf16* dC, float* dn, const float* mloc, const float* bend, float* mprev, int G, int tid) {
    for (int gidx = blockIdx.x * 512 + tid; gidx < 16 * 8192; gidx += G * 512) {
        const int bh = gidx >> 13, e4 = gidx & 8191;
        bf16* base = dC + (size_t)bh * 64 * 32768 + (size_t)e4 * 4;
        float C0 = 0.f, C1 = 0.f, C2 = 0.f, C3 = 0.f, m = 0.f;
        u32x2 ld[8];
#pragma unroll
        for (int k = 0; k < 8; ++k) ld[k] = *(const u32x2*)(base + (size_t)k * 32768);
        for (int c0 = 0; c0 < 64; c0 += 8) {
            u32x2 nx[8];
#pragma unroll
            for (int k = 0; k < 8; ++k) { const int c = c0 + 8 + k; nx[k] = (u32x2){0u, 0u}; if (c < 63) nx[k] = *(const u32x2*)(base + (size_t)c * 32768); }
#pragma unroll
            for (int k = 0; k < 8; ++k) { const int c = c0 + k;
                u32x2 o; o.x = pk2(C0, C1); o.y = pk2(C2, C3); *(u32x2*)(base + (size_t)c * 32768) = o;
                if (e4 == 0) mprev[bh * 64 + c] = m;
                if (c < 63) { const float ml = mloc[bh * 64 + c], be = bend[bh * 64 + c]; const float mn = fmaxf(be + m, ml), so = __expf(be + m - mn), sn = __expf(ml - mn);
                    C0 = so * C0 + sn * pg8::bf_lo(ld[k].x); C1 = so * C1 + sn * pg8::bf_hi(ld[k].x); C2 = so * C2 + sn * pg8::bf_lo(ld[k].y); C3 = so * C3 + sn * pg8::bf_hi(ld[k].y); m = mn; } }
#pragma unroll
            for (int k = 0; k < 8; ++k) ld[k] = nx[k];
        }
        if (gidx < 16 * 128) {
            const int bh2 = gidx >> 7, d = gidx & 127; float n = 0.f, m2 = 0.f;
            for (int c = 0; c < 64; ++c) { float* p = dn + (size_t)(bh2 * 64 + c) * 128 + d; const float dv = (c < 63) ? *p : 0.f; *p = n;
                if (c < 63) { const float ml = mloc[bh2 * 64 + c], be = bend[bh2 * 64 + c]; const float mn = fmaxf(be + m2, ml); n = __expf(be + m2 - mn) * n + __expf(ml - mn) * dv; m2 = mn; } }
        }
    }
}
constexpr int OFF_Q3 = 0, OFF_K3 = 34816, OFF_V3 = 69632, OFF_F3 = 69632 + 67584;
__device__ __forceinline__ void out_item(bf16* z, const float* gates, const float* conv_w, const float* conv_b, const bf16* Cprev, const float* nprev, const float* mprev, const float* hn, int item, LAS unsigned char* L, int tid, int lane, int wave) {
    const int b = item >> 8, h = (item >> 6) & 3, c = item & 63;
    const size_t tokb = (size_t)b * SEQ, tok0 = tokb + (size_t)c * 128;
    LAS unsigned char* qimg = L + OFF_Q3; LAS unsigned char* kimg = L + OFF_K3; LAS unsigned char* vimg = L + OFF_V3;
    LAS float* lf = (LAS float*)(L + OFF_F3); LAS float* ig = lf + 128; LAS float* bc = lf + 256; LAS float* uu = lf + 384; LAS float* gm = lf + 512; LAS float* np = lf + 640; LAS float* part = lf + 768;
    __syncthreads();
    if (wave == 0) {
        const float lf0 = gates[(tok0 + 2 * lane) * 8 + 4 + h], lf1 = gates[(tok0 + 2 * lane + 1) * 8 + 4 + h], ig0 = gates[(tok0 + 2 * lane) * 8 + h], ig1 = gates[(tok0 + 2 * lane + 1) * 8 + h];
        float b0, b1; scan_add2(lf0, lf1, lane, b0, b1);
        const float u0 = ig0 - b0, u1 = ig1 - b1; float g0, g1; scan_max2(u0, u1, lane, g0, g1);
        bc[2 * lane] = b0; bc[2 * lane + 1] = b1; uu[2 * lane] = u0; uu[2 * lane + 1] = u1; gm[2 * lane] = g0; gm[2 * lane + 1] = g1;
    } else if (wave == 1 || wave == 2) np[tid - 64] = nprev[(size_t)item * 128 + tid - 64];
    stage_conv(qimg, z, tokb, c * 128, ZQM + h * 128, conv_w + h * 128, conv_b + h * 128, 1.0f, tid);
    stage_conv(kimg, z, tokb, c * 128, ZKM + h * 128, conv_w + 512 + h * 128, conv_b + 512 + h * 128, 0.08838834764831845f, tid);
    stage_v<false>(vimg, z, tok0, h, nullptr, tid);
    __syncthreads();
    const float mp = mprev[item];
    const int lw = wave & 3, vw = wave >> 2, r = lane & 31, hh = lane >> 5, l = 32 * lw + r;
    const float b_l = bc[l], mt = fmaxf(b_l + gm[l], b_l + mp), inter = __expf(b_l + mp - mt), e0 = b_l - mt;
    f32x16 S[4];
#pragma unroll
    for (int st = 0; st < 4; ++st)
#pragma unroll
        for (int i = 0; i < 16; ++i) S[st][i] = 0.f;
#pragma unroll
    for (int ks = 0; ks < 8; ++ks) { const bf16x8 bq = rowread(qimg, PQ, 32 * lw, 16 * ks, lane);
#pragma unroll
        for (int st = 0; st < 4; ++st) if (st <= lw) { const bf16x8 ak = rowread(kimg, PQ, 32 * st, 16 * ks, lane); S[st] = MFMA32(ak, bq, S[st]); } }
    float dsum = 0.f;
#pragma unroll
    for (int st = 0; st < 4; ++st) if (st <= lw) {
#pragma unroll
        for (int g = 0; g < 4; ++g) { const int s0 = 32 * st + 8 * g + 4 * hh; const f32x4 u4 = *(const LAS f32x4*)(uu + s0);
#pragma unroll
            for (int e = 0; e < 4; ++e) { const float w = (s0 + e <= l) ? __expf(e0 + u4[e]) : 0.f; const float v = S[st][4 * g + e] * w; S[st][4 * g + e] = v; dsum += v; } } }
    dsum += __shfl_xor(dsum, 32);
    bf16x8 fr[4][2];
#pragma unroll
    for (int st = 0; st < 4; ++st) { fr[st][0] = pack8(S[st], 0); fr[st][1] = pack8(S[st], 1); }
    float qn = 0.f;
#pragma unroll
    for (int d8 = 0; d8 < 8; ++d8) { const bf16x8 qf = *(const LAS bf16x8*)(qimg + l * PQ + (64 * hh + 8 * d8) * 2); const f32x4 na = *(const LAS f32x4*)(np + 64 * hh + 8 * d8), nb = *(const LAS f32x4*)(np + 64 * hh + 8 * d8 + 4);
        qn += bf2f((bf16)qf[0]) * na.x + bf2f((bf16)qf[1]) * na.y + bf2f((bf16)qf[2]) * na.z + bf2f((bf16)qf[3]) * na.w + bf2f((bf16)qf[4]) * nb.x + bf2f((bf16)qf[5]) * nb.y + bf2f((bf16)qf[6]) * nb.z + bf2f((bf16)qf[7]) * nb.w; }
    qn += __shfl_xor(qn, 32);
    const float den = dsum + inter * qn, rden = 1.0f / fmaxf(fabsf(den), __expf(-mt));
    f32x16 O[4];
#pragma unroll
    for (int vt = 0; vt < 4; ++vt)
#pragma unroll
        for (int i = 0; i < 16; ++i) O[vt][i] = 0.f;
    const bf16* cp = Cprev + (size_t)item * 32768 + (size_t)(128 * vw + r) * 128 + 8 * hh;
#pragma unroll
    for (int ks = 0; ks < 8; ++ks) { const bf16x8 bq = rowread(qimg, PQ, 32 * lw, 16 * ks, lane);
#pragma unroll
        for (int vt = 0; vt < 4; ++vt) { const bf16x8 ac = *(const bf16x8*)(cp + vt * 4096 + 16 * ks); O[vt] = MFMA32(ac, bq, O[vt]); } }
#pragma unroll
    for (int vt = 0; vt < 4; ++vt)
#pragma unroll
        for (int i = 0; i < 16; ++i) O[vt][i] *= inter;
#pragma unroll
    for (int st = 0; st < 4; ++st) if (st <= lw) {
#pragma unroll
        for (int s2 = 0; s2 < 2; ++s2)
#pragma unroll
            for (int vt = 0; vt < 4; ++vt) { const bf16x8 av = trread<true>(vimg, PV, 32 * st + 16 * s2, 128 * vw + 32 * vt, lane); O[vt] = MFMA32(av, fr[st][s2], O[vt]); } }
    float ss = 0.f;
#pragma unroll
    for (int vt = 0; vt < 4; ++vt)
#pragma unroll
        for (int i = 0; i < 16; ++i) { const float v = O[vt][i] * rden; O[vt][i] = v; ss += v * v; }
    ss += __shfl_xor(ss, 32);
    if (hh == 0) part[vw * 128 + l] = ss;
    __syncthreads();
    const float rstd = 1.0f / sqrtf((part[l] + part[128 + l]) * (1.0f / 256.0f) + RMS_EPS);
    bf16* orow = z + (tok0 + l) * ZP + ZOM + h * 256;
#pragma unroll
    for (int vt = 0; vt < 4; ++vt)
#pragma unroll
        for (int g = 0; g < 4; ++g) { const int v0 = 128 * vw + 32 * vt + 8 * g + 4 * hh; const u32x2 ow = *(const u32x2*)(orow + v0); const f32x4 gn = *(const f32x4*)(hn + h * 256 + v0);
            const float r0 = O[vt][4 * g] * rstd * gn.x / (1.0f + __expf(-pg8::bf_lo(ow.x))), r1 = O[vt][4 * g + 1] * rstd * gn.y / (1.0f + __expf(-pg8::bf_hi(ow.x)));
            const float r2 = O[vt][4 * g + 2] * rstd * gn.z / (1.0f + __expf(-pg8::bf_lo(ow.y))), r3 = O[vt][4 * g + 3] * rstd * gn.w / (1.0f + __expf(-pg8::bf_hi(ow.y)));
            u32x2 o; o.x = pk2(r0, r1); o.y = pk2(r2, r3); *(u32x2*)(orow + v0) = o; }
}
}


namespace at {
using namespace mm;
constexpr int PK = 144;
constexpr int OFF_K = 0, OFF_V = 256 * PK;
__device__ __forceinline__ void unpack8(const u32x4 v, float (&x)[8]) { x[0] = pg8::bf_lo(v.x); x[1] = pg8::bf_hi(v.x); x[2] = pg8::bf_lo(v.y); x[3] = pg8::bf_hi(v.y); x[4] = pg8::bf_lo(v.z); x[5] = pg8::bf_hi(v.z); x[6] = pg8::bf_lo(v.w); x[7] = pg8::bf_hi(v.w); }
__device__ __forceinline__ void load8f(const float* p, float (&x)[8]) { const f32x4 a = *(const f32x4*)p, b = *(const f32x4*)(p + 4); x[0] = a.x; x[1] = a.y; x[2] = a.z; x[3] = a.w; x[4] = b.x; x[5] = b.y; x[6] = b.z; x[7] = b.w; }
__device__ __forceinline__ bf16x8 cvt8(const float (&y)[8]) { f32x8 v;
#pragma unroll
    for (int e = 0; e < 8; ++e) v[e] = y[e];
    return __builtin_bit_cast(bf16x8, __builtin_convertvector(v, bfv8)); }
__device__ __forceinline__ void attn_item(bf16* z, const float* rope_cos, const float* rope_sin, const float* sinks, int item, LAS unsigned char* L, int tid, int lane, int wave) {
    const int hk = item & 3, n = (item >> 2) & 63, b = item >> 8;
    const size_t tok0 = (size_t)b * SEQ + (size_t)n * 128;
    LAS unsigned char* kimg = L + OFF_K; LAS unsigned char* vimg = L + OFF_V;
    __syncthreads();
    for (int idx = tid; idx < 1024; idx += 512) {
        const int key = idx >> 2, c8 = (idx & 3) * 8;
        bf16x8 o1 = {0, 0, 0, 0, 0, 0, 0, 0}, o2 = {0, 0, 0, 0, 0, 0, 0, 0};
        if (n > 0 || key >= 128) {
            const bf16* zr = z + (tok0 + key - 128) * ZP + ZKA + hk * 64;
            float x1[8], x2[8], cs[8], sn[8], y1[8], y2[8];
            unpack8(*(const u32x4*)(zr + c8), x1); unpack8(*(const u32x4*)(zr + c8 + 32), x2);
            const int pos = n * 128 + key - 128;
            load8f(rope_cos + pos * 32 + c8, cs); load8f(rope_sin + pos * 32 + c8, sn);
#pragma unroll
            for (int e = 0; e < 8; ++e) { y1[e] = x1[e] * cs[e] - x2[e] * sn[e]; y2[e] = x2[e] * cs[e] + x1[e] * sn[e]; }
            o1 = cvt8(y1); o2 = cvt8(y2);
        }
        *(LAS bf16x8*)(kimg + key * PK + c8 * 2) = o1; *(LAS bf16x8*)(kimg + key * PK + (c8 + 32) * 2) = o2;
    }
    for (int idx = tid; idx < 2048; idx += 512) {
        const int key = idx >> 3, c8 = (idx & 7) * 8; u32x4 v = {0u, 0u, 0u, 0u};
        if (n > 0 || key >= 128) v = *(const u32x4*)(z + (tok0 + key - 128) * ZP + ZVA + hk * 64 + c8);
        *(LAS u32x4*)(vimg + key * PK + c8 * 2) = v;
    }
    __syncthreads();
    const int r = lane & 31, hh = lane >> 5;
#pragma unroll 1
    for (int gsel = 0; gsel < 2; ++gsel) {
        const int gi = wave + 8 * gsel, g = gi >> 2, j = gi & 3, head = hk * 4 + g;
        bf16* qrow = z + (tok0 + 32 * j + r) * ZP + ZQA + head * 64; const int pos = n * 128 + 32 * j + r;
        u32x4 raw[4];
#pragma unroll
        for (int ks = 0; ks < 4; ++ks) raw[ks] = *(const u32x4*)(qrow + 16 * ks + 8 * hh);
        bf16x8 qf[4];
#pragma unroll
        for (int k2 = 0; k2 < 2; ++k2) { float x1[8], x2[8], cs[8], sn[8], y1[8], y2[8];
            unpack8(raw[k2], x1); unpack8(raw[k2 + 2], x2); load8f(rope_cos + pos * 32 + 16 * k2 + 8 * hh, cs); load8f(rope_sin + pos * 32 + 16 * k2 + 8 * hh, sn);
#pragma unroll
            for (int e = 0; e < 8; ++e) { y1[e] = (x1[e] * cs[e] - x2[e] * sn[e]) * 0.125f; y2[e] = (x2[e] * cs[e] + x1[e] * sn[e]) * 0.125f; }
            qf[k2] = cvt8(y1); qf[k2 + 2] = cvt8(y2); }
        f32x16 S[5];
#pragma unroll
        for (int kt = 0; kt < 5; ++kt)
#pragma unroll
            for (int i = 0; i < 16; ++i) S[kt][i] = 0.f;
#pragma unroll
        for (int ks = 0; ks < 4; ++ks)
#pragma unroll
            for (int kt = 0; kt < 5; ++kt) { const bf16x8 ak = rowread(kimg, PK, 32 * (j + kt), 16 * ks, lane); S[kt] = MFMA32(ak, qf[ks], S[kt]); }
        const float sink = sinks[head]; float mx = sink;
#pragma unroll
        for (int kt = 0; kt < 5; ++kt)
#pragma unroll
            for (int i = 0; i < 16; ++i) { const int cr = (i & 3) + 8 * (i >> 2) + 4 * hh; bool ok = (kt == 0) ? (cr > r) : (kt == 4) ? (cr <= r) : true; if (n == 0 && j + kt < 4) ok = false;
                const float s = ok ? S[kt][i] : -INFINITY; S[kt][i] = s; mx = fmaxf(mx, s); }
        mx = fmaxf(mx, __shfl_xor(mx, 32));
        float sum = 0.f;
#pragma unroll
        for (int kt = 0; kt < 5; ++kt)
#pragma unroll
            for (int i = 0; i < 16; ++i) { const float p = __expf(S[kt][i] - mx); S[kt][i] = p; sum += p; }
        sum += __shfl_xor(sum, 32); sum += __expf(sink - mx);
        const float inv = 1.0f / sum;
        f32x16 O[2];
#pragma unroll
        for (int dt = 0; dt < 2; ++dt)
#pragma unroll
            for (int i = 0; i < 16; ++i) O[dt][i] = 0.f;
#pragma unroll
        for (int kt = 0; kt < 5; ++kt)
#pragma unroll
            for (int s2 = 0; s2 < 2; ++s2) { const bf16x8 pf = pack8(S[kt], s2);
#pragma unroll
                for (int dt = 0; dt < 2; ++dt) { const bf16x8 av = trread<true>(vimg, PK, 32 * (j + kt) + 16 * s2, 32 * dt, lane); O[dt] = MFMA32(av, pf, O[dt]); } }
#pragma unroll
        for (int dt = 0; dt < 2; ++dt)
#pragma unroll
            for (int g4 = 0; g4 < 4; ++g4) { u32x2 o; o.x = pk2(O[dt][4 * g4] * inv, O[dt][4 * g4 + 1] * inv); o.y = pk2(O[dt][4 * g4 + 2] * inv, O[dt][4 * g4 + 3] * inv); *(u32x2*)(qrow + 32 * dt + 8 * g4 + 4 * hh) = o; }
    }
}
}


#define XB_TMO      128
#define XB_XCNT(j)  (256  + 64 * (j))
#define XB_XSUB(j)  (1280 + 64 * (j))
#define XB_XGEN(j)  (2304 + 64 * (j))
#define XB_TOP      3328
#define XB_TOPGEN   3392
#define XCD_BAR_WORDS 3456
#define XB_SPIN_CAP (1u << 18)
__device__ __forceinline__ unsigned xb_ld(unsigned* p)              { return __hip_atomic_load(p, __ATOMIC_RELAXED, __HIP_MEMORY_SCOPE_AGENT); }
__device__ __forceinline__ unsigned xb_add(unsigned* p, unsigned v) { return __hip_atomic_fetch_add(p, v, __ATOMIC_RELAXED, __HIP_MEMORY_SCOPE_AGENT); }
__device__ __forceinline__ unsigned xb_xcc_id() { return (unsigned)__builtin_amdgcn_s_getreg((3 << 11) | 20) & 0xFu; }
#define XB_SPIN(cond, bar) do { unsigned _sp = 0; while (cond) { __builtin_amdgcn_s_sleep(1); \
    if ((++_sp & 255u) == 0u) { if (xb_ld(&(bar)[XB_TMO])) break; if (_sp > XB_SPIN_CAP) { atomicAdd(&(bar)[XB_TMO], 1u); break; } } } } while (0)
struct XcdBarrier { unsigned* bar; unsigned x; volatile LAS unsigned* st; };
__device__ __forceinline__ XcdBarrier xcd_barrier_post(unsigned* bar, volatile LAS unsigned* st) {
    XcdBarrier b; b.bar = bar; b.x = xb_xcc_id(); b.st = st;
    if (threadIdx.x == 0) (void)xb_add(&bar[XB_XCNT(b.x)], 1u);
    return b;
}
__device__ __forceinline__ void xcd_barrier_complete(unsigned* bar, unsigned x, unsigned& nloc, unsigned& nx) {
    const unsigned G = gridDim.x * gridDim.y * gridDim.z;
    unsigned sum, cnt, mine, sp = 0u;
    for (;;) {
        sum = 0u; cnt = 0u; mine = 0u;
#pragma unroll
        for (unsigned j = 0; j < 16; ++j) { const unsigned c = xb_ld(&bar[XB_XCNT(j)]); sum += c; cnt += (c > 0u) ? 1u : 0u; mine = (j == x) ? c : mine; }
        if (sum == G) break;
        __builtin_amdgcn_s_sleep(1);
        if ((++sp & 255u) == 0u) { if (xb_ld(&bar[XB_TMO])) break; if (sp > XB_SPIN_CAP) { atomicAdd(&bar[XB_TMO], 1u); break; } }
    }
    nloc = mine > 0u ? mine : 1u; nx = cnt > 0u ? cnt : 1u;
}
__device__ __forceinline__ void xcd_barrier(const XcdBarrier& b) {
    asm volatile("s_waitcnt vmcnt(0)" ::: "memory");
    __syncthreads();
    if (threadIdx.x == 0) {
        unsigned* bar = b.bar;
        __builtin_amdgcn_s_waitcnt(0);
        unsigned nloc = b.st[0], nx = b.st[1];
        if (nloc == 0u) { xcd_barrier_complete(bar, b.x, nloc, nx); b.st[0] = nloc; b.st[1] = nx; }
        const unsigned old = xb_add(&bar[XB_XSUB(b.x)], 1u);
        const unsigned gen = old / nloc;
        if (old + 1u == (gen + 1u) * nloc) {
            __builtin_amdgcn_fence(__ATOMIC_RELEASE, "agent");
            asm volatile("s_waitcnt vmcnt(0)" ::: "memory");
            const unsigned og = xb_add(&bar[XB_TOP], 1u);
            const unsigned tg = og / nx;
            if (og + 1u == (tg + 1u) * nx) xb_add(&bar[XB_TOPGEN], 1u);
            else XB_SPIN(xb_ld(&bar[XB_TOPGEN]) == tg, bar);
            __builtin_amdgcn_fence(__ATOMIC_ACQUIRE, "agent");
            xb_add(&bar[XB_XGEN(b.x)], 1u);
            asm volatile("s_waitcnt vmcnt(0)" ::: "memory");
        } else {
            XB_SPIN(xb_ld(&bar[XB_XGEN(b.x)]) == gen, bar);
            __builtin_amdgcn_fence(__ATOMIC_ACQUIRE, "agent");
            asm volatile("s_waitcnt vmcnt(0)" ::: "memory");
        }
    }
    __syncthreads();
}

__global__ void __launch_bounds__(512, 2) mega_fwd(Args args) {
    extern __shared__ __attribute__((aligned(16))) unsigned char lds[];
    cg::grid_group grid = cg::this_grid();
    const int tid = threadIdx.x, lane = tid & 63, wave = __builtin_amdgcn_readfirstlane(tid >> 6);
    const int G = gridDim.x, gw = blockIdx.x * 8 + wave, NGW = G * 8;
    unsigned char* ws = args.ws;
    const float* x = args.in[0];
    float* out = args.out;
    bf16* WA = (bf16*)(ws + WS_WA); bf16* Wgu = (bf16*)(ws + WS_WA + WA_GU); bf16* Wdn = (bf16*)(ws + WS_WA + WA_DN);
    bf16* Watt = (bf16*)(ws + WS_WP); bf16* Wml = (bf16*)(ws + WS_WP + 2 * MiB); bf16* Wout = (bf16*)(ws + WS_WP + 4 * MiB);
    float* rope_cos = (float*)(ws + WS_ROPE); float* rope_sin = rope_cos + SEQ * 32;
    float* gates = (float*)(ws + WS_GATE);
    float* dnb = (float*)(ws + WS_MISC); float* mlocb = dnb + 1024 * 128; float* bendb = mlocb + 1024; float* mprevb = bendb + 1024;
    bf16* hA = (bf16*)(ws + WS_HA); bf16* Z = (bf16*)(ws + WS_Z); bf16* HID = (bf16*)(ws + WS_Z);
    LAS float* scr = (LAS float*)((LAS unsigned char*)lds + wave * 16640);
    const int lo = args.ph_lo, hi = args.ph_hi;
#define IN(k) (lo <= (k) && (k) < hi)
    unsigned* barw = (unsigned*)(ws + WS_MISC + MiB);
    volatile LAS unsigned* bst = (volatile LAS unsigned*)((LAS unsigned char*)lds + LDS_BYTES - 16);
    if (lo == 0) {
        if (blockIdx.x == 0) for (int u = tid; u < XCD_BAR_WORDS; u += 512) barw[u] = 0u;
        if (tid < 2) bst[tid] = 0u;
    }
    XcdBarrier xbar; xbar.bar = barw; xbar.x = 0; xbar.st = bst;
#define SEAM(k) do { if (IN(k) && IN((k) + 1)) { if ((k) == 0) { grid.sync(); xbar = xcd_barrier_post(barw, bst); } else xcd_barrier(xbar); } } while (0)

    if (IN(0)) {
        convert_weight(args.in[2], FF, D, FF / 64, Wgu, 1, gw, NGW, scr, lane);
        convert_weight(args.in[3], FF, D, FF / 64, Wgu, 2, gw, NGW, scr, lane);
        convert_weight(args.in[4], D, FF, D / 64, Wdn, 0, gw, NGW, scr, lane);
        convert_weight(args.in[13], D, D, D / 64, Watt, 0, gw, NGW, scr, lane);
        convert_weight(args.in[14], D, D, D / 64, Wml, 0, gw, NGW, scr, lane);
        convert_weight(args.in[15], D, D, D / 64, Wout, 0, gw, NGW, scr, lane);
        for (int idx = blockIdx.x * 512 + tid; idx < SEQ * 32; idx += G * 512) {
            const int pos = idx >> 5, i = idx & 31;
            const float angf = (float)pos * args.inv_freq[i];
            const double ang = (double)angf;
            const double kq = rint(ang * 0.63661977236758134308);
            const double y = (ang - kq * 1.57079632679489655800) - kq * 6.123233995736766e-17;
            const double y2 = y * y;
            const double sy = y * (1.0 + y2 * (-1.0 / 6 + y2 * (1.0 / 120 + y2 * (-1.0 / 5040 + y2 * (1.0 / 362880 + y2 * (-1.0 / 39916800 + y2 * (1.0 / 6227020800.0)))))));
            const double cy = 1.0 + y2 * (-0.5 + y2 * (1.0 / 24 + y2 * (-1.0 / 720 + y2 * (1.0 / 40320 + y2 * (-1.0 / 3628800 + y2 * (1.0 / 479001600.0 + y2 * (-1.0 / 87178291200.0)))))));
            const long long qi = (long long)kq; const int qd = (int)(qi & 3);
            const double sn = qd == 0 ? sy : qd == 1 ? cy : qd == 2 ? -sy : -cy;
            const double cs = qd == 0 ? cy : qd == 1 ? -sy : qd == 2 ? -cy : sy;
            rope_cos[idx] = (float)cs; rope_sin[idx] = (float)sn;
        }
        for (int r = gw; r < T; r += NGW) { f32x4 v[4]; norm_row(x + (size_t)r * D, args.in[1], hA + (size_t)r * D, lane, v); }
    }
    SEAM(0);
    if (IN(1)) {
        pg8::Gemm g{hA, hA, Wgu, Wgu, D, D}; pg8::StaticOrder S; S.init(T, NGU, G, (int)blockIdx.x);
        pg8::EpiSwiGLU E{HID, FF};
        pg8::gemm_phase<pg8::EpiSwiGLU, pg8::StaticOrder>((PG8_LAS unsigned char*)lds, g, S, E);
    }
    SEAM(1);
    if (IN(2)) {
        pg8::Gemm g{HID, HID, Wdn, Wdn, FF, FF}; pg8::StaticOrder S; S.init(T, D, G, (int)blockIdx.x);
        pg8::EpiResid E{x, out, D, 0.5f};
        pg8::gemm_phase<pg8::EpiResid, pg8::StaticOrder>((PG8_LAS unsigned char*)lds, g, S, E);
    }
    SEAM(2);
    if (IN(3)) {
        convert_weight(args.in[6], INW, D, ZP / 64, WA, 3, gw, NGW, scr, lane);
        const float* win = args.in[6];
        f32x4 wga[16], wgb[16];
#pragma unroll
        for (int j = 0; j < 4; ++j)
#pragma unroll
            for (int e = 0; e < 4; ++e) { const int k = 256 * j + 4 * lane + e; wga[4 * j + e] = *(const f32x4*)(win + (size_t)k * INW + 4608); wgb[4 * j + e] = *(const f32x4*)(win + (size_t)k * INW + 4612); }
        for (int r = gw; r < T; r += NGW) {
            f32x4 v[4]; norm_row(out + (size_t)r * D, args.in[5], hA + (size_t)r * D, lane, v);
            float gsum[8];
#pragma unroll
            for (int e = 0; e < 8; ++e) gsum[e] = 0.f;
#pragma unroll
            for (int j = 0; j < 4; ++j)
#pragma unroll
                for (int e = 0; e < 4; ++e) { const f32x4 wa = wga[4 * j + e], wb = wgb[4 * j + e]; const float hv = v[j][e];
                    gsum[0] += hv * wa.x; gsum[1] += hv * wa.y; gsum[2] += hv * wa.z; gsum[3] += hv * wa.w; gsum[4] += hv * wb.x; gsum[5] += hv * wb.y; gsum[6] += hv * wb.z; gsum[7] += hv * wb.w; }
#pragma unroll
            for (int e = 0; e < 8; ++e) gsum[e] = wave_sum(gsum[e]);
            if (lane < 8) {
                float val = lane == 0 ? gsum[0] : lane == 1 ? gsum[1] : lane == 2 ? gsum[2] : lane == 3 ? gsum[3] : lane == 4 ? gsum[4] : lane == 5 ? gsum[5] : lane == 6 ? gsum[6] : gsum[7];
                if (lane < 4) val += args.in[7][lane];
                else { const float xx = val + args.in[8][lane - 4]; val = fminf(xx, 0.f) - log1pf(expf(-fabsf(xx))); }
                gates[(size_t)r * 8 + lane] = val;
            }
        }
    }
    SEAM(3);
    if (IN(4)) {
        pg8::Gemm g{hA, hA, WA, WA, D, D}; pg8::StaticOrder S; S.init(T, ZP, G, (int)blockIdx.x);
        pg8::EpiBf16 E{Z, ZP};
        pg8::gemm_phase<pg8::EpiBf16, pg8::StaticOrder>((PG8_LAS unsigned char*)lds, g, S, E);
    }
    SEAM(4);
    if (IN(5)) {
        for (int it = blockIdx.x; it < 1024; it += G) if ((it & 63) != 63) mm::dc_item(Z, gates, args.in[10], args.in[11], hA, dnb, mlocb, bendb, it, (LAS unsigned char*)lds, tid, lane, wave);
        for (int it = blockIdx.x; it < 1024; it += G) at::attn_item(Z, rope_cos, rope_sin, args.in[9], it, (LAS unsigned char*)lds, tid, lane, wave);
    }
    SEAM(5);
    if (IN(6)) {
        __syncthreads();
        mm::scan_phase(hA, dnb, mlocb, bendb, mprevb, G, tid);
        convert_weight(args.in[17], FF, D, FF / 64, Wgu, 1, gw, NGW, scr, lane);
        convert_weight(args.in[18], FF, D, FF / 64, Wgu, 2, gw, NGW, scr, lane);
        convert_weight(args.in[19], D, FF, D / 64, Wdn, 0, gw, NGW, scr, lane);
    }
    SEAM(6);
    if (IN(7)) {
        for (int it = blockIdx.x; it < 1024; it += G) mm::out_item(Z, gates, args.in[10], args.in[11], hA, dnb, mprevb, args.in[12], it, (LAS unsigned char*)lds, tid, lane, wave);
    }
    SEAM(7);
    if (IN(8)) {
        pg8::Gemm g{Z + ZQA, Z + ZOM, Watt, Wml, ZP, D}; pg8::PairOrder S; S.so.init(T, D, G, (int)blockIdx.x);
        pg8::EpiMix E{Z, Z + ZQM, ZP, ZGA, ZGM};
        pg8::gemm_phase<pg8::EpiMix, pg8::PairOrder>((PG8_LAS unsigned char*)lds, g, S, E);
    }
    SEAM(8);
    if (IN(9)) {
        pg8::Gemm g{Z + ZQM, Z + ZQM, Wout, Wout, ZP, D}; pg8::StaticOrder S; S.init(T, D, G, (int)blockIdx.x);
        pg8::EpiResid E{out, out, D, 1.0f};
        pg8::gemm_phase<pg8::EpiResid, pg8::StaticOrder>((PG8_LAS unsigned char*)lds, g, S, E);
    }
    SEAM(9);
    if (IN(10)) {
        for (int r = gw; r < T; r += NGW) { f32x4 v[4]; norm_row(out + (size_t)r * D, args.in[16], hA + (size_t)r * D, lane, v); }
    }
    SEAM(10);
    if (IN(11)) {
        pg8::Gemm g{hA, hA, Wgu, Wgu, D, D}; pg8::StaticOrder S; S.init(T, NGU, G, (int)blockIdx.x);
        pg8::EpiSwiGLU E{HID, FF};
        pg8::gemm_phase<pg8::EpiSwiGLU, pg8::StaticOrder>((PG8_LAS unsigned char*)lds, g, S, E);
    }
    SEAM(11);
    if (IN(12)) {
        pg8::Gemm g{HID, HID, Wdn, Wdn, FF, FF}; pg8::StaticOrder S; S.init(T, D, G, (int)blockIdx.x);
        pg8::EpiResid E{out, out, D, 0.5f};
        pg8::gemm_phase<pg8::EpiResid, pg8::StaticOrder>((PG8_LAS unsigned char*)lds, g, S, E);
    }
    SEAM(12);
    if (IN(13)) {
        const float* gain = args.in[20];
        for (int r = gw; r < T; r += NGW) {
            f32x4* xr = (f32x4*)(out + (size_t)r * D) + lane; const f32x4* gr = (const f32x4*)gain + lane;
            f32x4 v[4]; float s = 0.f;
#pragma unroll
            for (int j = 0; j < 4; ++j) { v[j] = xr[64 * j]; s += (v[j].x * v[j].x + v[j].y * v[j].y) + (v[j].z * v[j].z + v[j].w * v[j].w); }
            const float rstd = 1.0f / sqrtf(wave_sum(s) * (1.0f / D) + RMS_EPS);
#pragma unroll
            for (int j = 0; j < 4; ++j) xr[64 * j] = v[j] * rstd * gr[64 * j];
        }
    }
#undef IN
#undef SEAM
}

extern "C" void kernel_launch(void* const* d_in, const int* in_sizes, int n_in, void* d_out, int out_size, void* d_ws, size_t ws_size, hipStream_t stream) {
    static int grid = 0;
    if (grid == 0) {
        if (n_in != 21 || out_size != T * D || ws_size < WS_END) { fprintf(stderr, "kernel_launch: unexpected shapes (n_in %d out %d ws %zu)\n", n_in, out_size, ws_size); grid = -1; return; }
        int dev = 0, cus = 0, per_cu = 0;
        hipGetDevice(&dev); hipDeviceGetAttribute(&cus, hipDeviceAttributeMultiprocessorCount, dev);
        if (hipFuncSetAttribute((const void*)mega_fwd, hipFuncAttributeMaxDynamicSharedMemorySize, LDS_BYTES) != hipSuccess) { fprintf(stderr, "kernel_launch: hipFuncSetAttribute failed\n"); grid = -1; return; }
        if (hipOccupancyMaxActiveBlocksPerMultiprocessor(&per_cu, (const void*)mega_fwd, 512, LDS_BYTES) != hipSuccess || per_cu < 1) { fprintf(stderr, "kernel_launch: occupancy query failed (%d)\n", per_cu); per_cu = 1; }
        (void)hipGetLastError();
        grid = cus * per_cu;
    }
    if (grid < 0) return;
    Args a{};
    for (int i = 0; i < 21; ++i) a.in[i] = (const float*)d_in[i];
    a.out = (float*)d_out; a.ws = (unsigned char*)d_ws;
    for (int i = 0; i < 32; ++i) a.inv_freq[i] = (float)pow(10000.0, -(double)i / 32.0);
#if MK_PER_PHASE_LAUNCH
    for (int ph = 0; ph < NPHASE; ++ph) { a.ph_lo = ph; a.ph_hi = ph + 1; hipLaunchKernelGGL(mega_fwd, dim3(grid), dim3(512), LDS_BYTES, stream, a); }
#else
    a.ph_lo = 0; a.ph_hi = NPHASE;
    void* kargs[] = {&a};
    hipError_t e = hipLaunchCooperativeKernel((const void*)mega_fwd, dim3(grid), dim3(512), kargs, LDS_BYTES, stream);
    if (e != hipSuccess) fprintf(stderr, "kernel_launch: cooperative launch failed: %s (grid %d)\n", hipGetErrorString(e), grid);
#endif
}
```

```cpp
#include <hip/hip_runtime.h>
#include <hip/hip_cooperative_groups.h>
#include <cstdio>
#include <cstdint>
#include <cmath>
namespace cg = cooperative_groups;

#ifndef MK_PER_PHASE_LAUNCH
#define MK_PER_PHASE_LAUNCH 0
#endif

namespace pg8 {
#define PG8_LAS __attribute__((address_space(3)))
typedef unsigned short bf16_t;
typedef short bf16x8 __attribute__((ext_vector_type(8)));
typedef float f32x4 __attribute__((ext_vector_type(4)));
typedef unsigned u32x4 __attribute__((ext_vector_type(4)));
constexpr int BM = 256, BK = 64, HALF = 128, HTB = HALF * BK * 2, STAGE_BYTES = 8 * HTB, NXCD = 8, WGM = 8;

__host__ __device__ __forceinline__ int lds_byte(int r, int c) { const int st = (r >> 4) * 2 + (c >> 5), rr = r & 15, cc = c & 31, ob = rr * 64 + cc * 2; return st * 1024 + (ob ^ (((ob >> 9) & 1) << 5)); }
__host__ __device__ __forceinline__ void stage_rc(int b, int& R, int& C) { const int st = b / 1024, sb = b % 1024, swz = sb ^ (((sb >> 9) & 1) << 5); R = (st >> 1) * 16 + swz / 64; C = (st & 1) * 32 + (swz % 64) / 2; }
__host__ __device__ __forceinline__ int perm32(int rho) { const int n = rho >> 4, i = rho & 15; return 8 * (i >> 2) + 4 * n + (i & 3); }

struct Unit { int pm, pn, kind; };
struct Gemm { const bf16_t* A0; const bf16_t* A1; const bf16_t* B0; const bf16_t* B1; int lda, K; };

struct StaticOrder {
    int nM, nN, nwg, G, c;
    __host__ __device__ void init(int M, int N, int G_, int c_) { nM = M / BM; nN = N / BM; nwg = nM * nN; G = G_; c = c_; }
    __host__ __device__ bool next(int i, Unit& u) const {
        const long L = (long)i * G + c; if (L >= nwg) return false;
        int wgid = (int)L; { const int q = nwg / NXCD, r = nwg % NXCD, xcd = wgid % NXCD, off = wgid / NXCD; wgid = (xcd < r ? xcd * (q + 1) : r * (q + 1) + (xcd - r) * q) + off; }
        const int nig = WGM * nN, gid = wgid / nig, fm = gid * WGM, gsz = (nM - fm) < WGM ? (nM - fm) : WGM;
        u.pm = fm + ((wgid % nig) % gsz); u.pn = (wgid % nig) / gsz; u.kind = 0; return true;
    }
};
struct PairOrder {
    StaticOrder so;
    __host__ __device__ bool next(int i, Unit& u) const { if (!so.next(i >> 1, u)) return false; u.kind = i & 1; return true; }
};

__device__ __forceinline__ unsigned cvt_pk_bf16(float lo, float hi) { unsigned r; asm volatile("v_cvt_pk_bf16_f32 %0, %1, %2" : "=v"(r) : "v"(lo), "v"(hi)); return r; }
__device__ __forceinline__ float bf_lo(unsigned w) { return __uint_as_float(w << 16); }
__device__ __forceinline__ float bf_hi(unsigned w) { return __uint_as_float(w & 0xffff0000u); }
__device__ __forceinline__ float sigmoid_den(float x) { return 1.0f + __expf(-x); }


struct EpiBf16 {
    bf16_t* O; int ldc;
    __device__ __forceinline__ bool operator()(f32x4 (&acc)[2][2][4][2], const Unit& u, int wr, int wc, int fr, int fq) const {
        const int row0 = u.pm * BM + wr * 64 + fr, col0 = u.pn * BM + wc * 32 + 8 * fq;
#pragma unroll
        for (int ai = 0; ai < 2; ++ai)
#pragma unroll
            for (int m = 0; m < 4; ++m) { bf16_t* rowp = O + (size_t)(row0 + ai * HALF + m * 16) * ldc + col0;
#pragma unroll
                for (int bj = 0; bj < 2; ++bj) { const f32x4 v0 = acc[ai][bj][m][0], v1 = acc[ai][bj][m][1];
                    u32x4 w; w.x = cvt_pk_bf16(v0[0], v0[1]); w.y = cvt_pk_bf16(v0[2], v0[3]); w.z = cvt_pk_bf16(v1[0], v1[1]); w.w = cvt_pk_bf16(v1[2], v1[3]);
                    *(u32x4*)(rowp + bj * HALF) = w; } }
        return true;
    }
};
struct EpiSwiGLU {
    bf16_t* O; int ldc;
    __device__ __forceinline__ bool operator()(f32x4 (&acc)[2][2][4][2], const Unit& u, int wr, int wc, int fr, int fq) const {
        const int row0 = u.pm * BM + wr * 64 + fr, col0 = u.pn * HALF + wc * 32 + 8 * fq;
#pragma unroll
        for (int ai = 0; ai < 2; ++ai)
#pragma unroll
            for (int m = 0; m < 4; ++m) { bf16_t* rowp = O + (size_t)(row0 + ai * HALF + m * 16) * ldc + col0;
                float r[8];
#pragma unroll
                for (int n = 0; n < 2; ++n)
#pragma unroll
                    for (int e = 0; e < 4; ++e) { const float g = acc[ai][0][m][n][e], up = acc[ai][1][m][n][e]; r[4 * n + e] = g * __builtin_amdgcn_rcpf(1.0f + __expf(-g)) * up; }
                u32x4 w; w.x = cvt_pk_bf16(r[0], r[1]); w.y = cvt_pk_bf16(r[2], r[3]); w.z = cvt_pk_bf16(r[4], r[5]); w.w = cvt_pk_bf16(r[6], r[7]);
                *(u32x4*)rowp = w; }
        return true;
    }
};
struct EpiResid {
    const float* base; float* out; int ldc; float alpha;
    __device__ __forceinline__ bool operator()(f32x4 (&acc)[2][2][4][2], const Unit& u, int wr, int wc, int fr, int fq) const {
        const int row0 = u.pm * BM + wr * 64 + fr, col0 = u.pn * BM + wc * 32 + 8 * fq;
#pragma unroll
        for (int ai = 0; ai < 2; ++ai)
#pragma unroll
            for (int m = 0; m < 4; ++m) { const size_t off = (size_t)(row0 + ai * HALF + m * 16) * ldc + col0;
#pragma unroll
                for (int bj = 0; bj < 2; ++bj)
#pragma unroll
                    for (int n = 0; n < 2; ++n) { const f32x4 b = *(const f32x4*)(base + off + bj * HALF + 4 * n); *(f32x4*)(out + off + bj * HALF + 4 * n) = b + acc[ai][bj][m][n] * alpha; } }
        return true;
    }
};
struct EpiZG {
    bf16_t* O; int ldc; u32x4* GR; u32x4* GS;
    __device__ __forceinline__ bool operator()(f32x4 (&acc)[2][2][4][2], const Unit& u, int wr, int wc, int fr, int fq) const {
        if (u.pn < 18) {
            const int row0 = u.pm * BM + wr * 64 + fr, col0 = u.pn * BM + wc * 32 + 8 * fq;
#pragma unroll
            for (int ai = 0; ai < 2; ++ai)
#pragma unroll
                for (int m = 0; m < 4; ++m) { bf16_t* rowp = O + (size_t)(row0 + ai * HALF + m * 16) * ldc + col0;
#pragma unroll
                    for (int bj = 0; bj < 2; ++bj) { const f32x4 v0 = acc[ai][bj][m][0], v1 = acc[ai][bj][m][1];
                        u32x4 w; w.x = cvt_pk_bf16(v0[0], v0[1]); w.y = cvt_pk_bf16(v0[2], v0[3]); w.z = cvt_pk_bf16(v1[0], v1[1]); w.w = cvt_pk_bf16(v1[2], v1[3]);
                        *(u32x4*)(rowp + bj * HALF) = w; } }
        } else {
            const int t = u.pn - 18; const size_t base = (size_t)(u.pm * 8 + t) * 8 * 512 + threadIdx.x;
#pragma unroll
            for (int ai = 0; ai < 2; ++ai)
#pragma unroll
                for (int m = 0; m < 4; ++m) { float rho[8], sm[8];
#pragma unroll
                    for (int n = 0; n < 2; ++n)
#pragma unroll
                        for (int e = 0; e < 4; ++e) { const float da = sigmoid_den(acc[ai][0][m][n][e]), dm = sigmoid_den(acc[ai][1][m][n][e]); const float s = __builtin_amdgcn_rcpf(dm); sm[4 * n + e] = s; rho[4 * n + e] = dm * __builtin_amdgcn_rcpf(da); }
                    u32x4 wr_, ws_; wr_.x = cvt_pk_bf16(rho[0], rho[1]); wr_.y = cvt_pk_bf16(rho[2], rho[3]); wr_.z = cvt_pk_bf16(rho[4], rho[5]); wr_.w = cvt_pk_bf16(rho[6], rho[7]);
                    ws_.x = cvt_pk_bf16(sm[0], sm[1]); ws_.y = cvt_pk_bf16(sm[2], sm[3]); ws_.z = cvt_pk_bf16(sm[4], sm[5]); ws_.w = cvt_pk_bf16(sm[6], sm[7]);
                    GR[base + (size_t)(ai * 4 + m) * 512] = wr_; GS[base + (size_t)(ai * 4 + m) * 512] = ws_; }
        }
        return true;
    }
};
struct EpiMix {
    bf16_t* Y; int ldy; const u32x4* GR; const u32x4* GS;
    __device__ __forceinline__ bool operator()(f32x4 (&acc)[2][2][4][2], const Unit& u, int wr, int wc, int fr, int fq) const {
        const int row0 = u.pm * BM + wr * 64 + fr, col0 = u.pn * BM + wc * 32 + 8 * fq;
        const u32x4* G = u.kind == 0 ? GR : GS;
#pragma unroll
        for (int ai = 0; ai < 2; ++ai)
#pragma unroll
            for (int m = 0; m < 4; ++m) { const size_t off = (size_t)(row0 + ai * HALF + m * 16) * ldy + col0;
#pragma unroll
                for (int bj = 0; bj < 2; ++bj) {
                    const u32x4 gv = G[(size_t)((u.pm * 8 + 2 * u.pn + bj) * 8 + ai * 4 + m) * 512 + threadIdx.x];
                    const float f[8] = {bf_lo(gv.x), bf_hi(gv.x), bf_lo(gv.y), bf_hi(gv.y), bf_lo(gv.z), bf_hi(gv.z), bf_lo(gv.w), bf_hi(gv.w)};
                    if (u.kind == 0) {
#pragma unroll
                        for (int n = 0; n < 2; ++n)
#pragma unroll
                            for (int e = 0; e < 4; ++e) acc[ai][bj][m][n][e] *= f[4 * n + e];
                    } else {
                        float r[8];
#pragma unroll
                        for (int n = 0; n < 2; ++n)
#pragma unroll
                            for (int e = 0; e < 4; ++e) r[4 * n + e] = acc[ai][bj][m][n][e] * f[4 * n + e];
                        u32x4 w; w.x = cvt_pk_bf16(r[0], r[1]); w.y = cvt_pk_bf16(r[2], r[3]); w.z = cvt_pk_bf16(r[4], r[5]); w.w = cvt_pk_bf16(r[6], r[7]);
                        *(u32x4*)(Y + off + bj * HALF) = w;
                    }
                } }
        return u.kind != 0;
    }
};

template <class Epi, class Sched>
__device__ __forceinline__ void gemm_phase(PG8_LAS unsigned char* lds, const Gemm g, const Sched& S, const Epi& E) {
    const int tid = threadIdx.x, wid = __builtin_amdgcn_readfirstlane(tid >> 6), lane = tid & 63, wr = wid >> 2, wc = wid & 3, fr = lane & 15, fq = lane >> 4;
    const int K = g.K, nt = K / BK, lda = g.lda;
    unsigned voffA[2], voffB[2];
#pragma unroll
    for (int i = 0; i < 2; ++i) { int R, C; stage_rc(tid * 16 + i * 8192, R, C); const int Rb = (R & ~31) + perm32(R & 31);
        voffA[i] = (unsigned)(R * lda + C) * 2u; voffB[i] = (unsigned)(Rb * K + C) * 2u; }
    const size_t kstep = (size_t)(BK * 2);
    const size_t hstepA = (size_t)HALF * lda * 2, hstepB = (size_t)HALF * K * 2;
    const size_t tstepA = 2 * hstepA, tstepB = 2 * hstepB;
    const unsigned ldsw = (unsigned)wid * 1024u;
    const int aoff = lds_byte(wr * 64 + fr, fq * 8), boff = lds_byte(wc * 32 + fr, fq * 8);
#define PG8_SA(b, h) (((b) * 2 + (h)) * HTB)
#define PG8_SB(b, h) ((4 + (b) * 2 + (h)) * HTB)
#define PG8_STAGE(bufoff, gbase, voff) do { _Pragma("unroll") for (int _i = 0; _i < 2; ++_i) \
        __builtin_amdgcn_global_load_lds((const unsigned*)((const char*)(gbase) + (voff)[_i]), (PG8_LAS unsigned*)(lds + (bufoff) + ldsw + _i * 8192), 16, 0, 0); } while (0)
#define PG8_LDA(dst, b, h) do { _Pragma("unroll") for (int m = 0; m < 4; ++m) _Pragma("unroll") for (int k = 0; k < 2; ++k) dst[m][k] = *(const PG8_LAS bf16x8*)(lds + PG8_SA(b, h) + aoff + m * 2048 + k * 1024); } while (0)
#define PG8_LDB(dst, b, h) do { _Pragma("unroll") for (int n = 0; n < 2; ++n) _Pragma("unroll") for (int k = 0; k < 2; ++k) dst[n][k] = *(const PG8_LAS bf16x8*)(lds + PG8_SB(b, h) + boff + n * 2048 + k * 1024); } while (0)
#define PG8_MMA(ai, bj, At, Bt) do { __builtin_amdgcn_s_setprio(1); _Pragma("unroll") for (int m = 0; m < 4; ++m) _Pragma("unroll") for (int n = 0; n < 2; ++n) _Pragma("unroll") for (int k = 0; k < 2; ++k) \
        acc[ai][bj][m][n] = __builtin_amdgcn_mfma_f32_16x16x32_bf16(Bt[n][k], At[m][k], acc[ai][bj][m][n], 0, 0, 0); __builtin_amdgcn_s_setprio(0); } while (0)
#define PG8_WAIT_V(n) asm volatile("s_waitcnt vmcnt(" #n ")" ::: "memory")
#define PG8_WAIT_L(n) asm volatile("s_waitcnt lgkmcnt(" #n ")" ::: "memory")
#define PG8_BAR __builtin_amdgcn_s_barrier()
#define PG8_SCHED __builtin_amdgcn_sched_barrier(0)
    Unit cur, nxt; int ui = 0;
    if (!S.next(0, cur)) return;
    f32x4 acc[2][2][4][2];
#pragma unroll
    for (int a = 0; a < 2; ++a)
#pragma unroll
        for (int b = 0; b < 2; ++b)
#pragma unroll
            for (int m = 0; m < 4; ++m)
#pragma unroll
                for (int n = 0; n < 2; ++n) acc[a][b][m][n] = (f32x4){0.f, 0.f, 0.f, 0.f};
    bf16x8 At[4][2], B0[2][2], B1[2][2];
    const char* cA = (const char*)(cur.kind ? g.A1 : g.A0) + (size_t)cur.pm * tstepA; const char* cB = (const char*)(cur.kind ? g.B1 : g.B0) + (size_t)cur.pn * tstepB;
    PG8_STAGE(PG8_SB(0, 0), cB, voffB); PG8_STAGE(PG8_SB(0, 1), cB + hstepB, voffB); PG8_STAGE(PG8_SA(0, 0), cA, voffA); PG8_STAGE(PG8_SA(0, 1), cA + hstepA, voffA);
    if (wr == 1) PG8_BAR;
    PG8_WAIT_V(2); PG8_BAR;
    PG8_STAGE(PG8_SB(1, 0), cB + kstep, voffB); PG8_STAGE(PG8_SA(1, 0), cA + kstep, voffA); PG8_STAGE(PG8_SB(1, 1), cB + hstepB + kstep, voffB);
    PG8_WAIT_V(6); PG8_BAR;
    for (;;) {
        const bool has_next = S.next(ui + 1, nxt);
        const char* nA = has_next ? (const char*)(nxt.kind ? g.A1 : g.A0) + (size_t)nxt.pm * tstepA : cA; const char* nB = has_next ? (const char*)(nxt.kind ? g.B1 : g.B0) + (size_t)nxt.pn * tstepB : cB;
        for (int t = 0; t < nt; t += 2) {
            const bool last = (t == nt - 2);
            const char* a1 = cA + (size_t)(t + 1) * kstep;
            const char* a2 = last ? nA : cA + (size_t)(t + 2) * kstep; const char* b2 = last ? nB : cB + (size_t)(t + 2) * kstep;
            const char* a3 = a2 + kstep; const char* b3 = b2 + kstep;
            PG8_LDB(B0, 0, 0); PG8_LDB(B1, 0, 1); PG8_SCHED; PG8_LDA(At, 0, 0); PG8_STAGE(PG8_SA(1, 1), a1 + hstepA, voffA);
            PG8_WAIT_V(8); PG8_WAIT_L(0); PG8_BAR; PG8_MMA(0, 0, At, B0); PG8_MMA(0, 1, At, B1); PG8_BAR; PG8_SCHED;
            PG8_LDA(At, 0, 1); PG8_STAGE(PG8_SB(0, 0), b2, voffB); PG8_STAGE(PG8_SB(0, 1), b2 + hstepB, voffB); PG8_STAGE(PG8_SA(0, 0), a2, voffA);
            PG8_WAIT_V(8); PG8_WAIT_L(0); PG8_BAR; PG8_MMA(1, 0, At, B0); PG8_MMA(1, 1, At, B1); PG8_BAR; PG8_SCHED;
            PG8_LDB(B0, 1, 0); PG8_LDB(B1, 1, 1); PG8_SCHED; PG8_LDA(At, 1, 0); PG8_STAGE(PG8_SA(0, 1), a2 + hstepA, voffA);
            PG8_WAIT_V(8); PG8_WAIT_L(0); PG8_BAR; PG8_MMA(0, 0, At, B0); PG8_MMA(0, 1, At, B1); PG8_BAR; PG8_SCHED;
            PG8_LDA(At, 1, 1); PG8_STAGE(PG8_SB(1, 0), b3, voffB); PG8_STAGE(PG8_SB(1, 1), b3 + hstepB, voffB); PG8_STAGE(PG8_SA(1, 0), a3, voffA);
            PG8_WAIT_V(8); PG8_WAIT_L(0); PG8_BAR; PG8_MMA(1, 0, At, B0); PG8_MMA(1, 1, At, B1); PG8_BAR; PG8_SCHED;
        }
        if (wr == 0) PG8_BAR;
        const bool zero = E(acc, cur, wr, wc, fr, fq);
        if (!has_next) break;
        if (zero) {
#pragma unroll
            for (int a = 0; a < 2; ++a)
#pragma unroll
                for (int b = 0; b < 2; ++b)
#pragma unroll
                    for (int m = 0; m < 4; ++m)
#pragma unroll
                        for (int n = 0; n < 2; ++n) acc[a][b][m][n] = (f32x4){0.f, 0.f, 0.f, 0.f};
        }
        cur = nxt; cA = nA; cB = nB; ++ui;
        if (wr == 1) PG8_BAR;
    }
    PG8_WAIT_V(0);
    PG8_BAR;
#undef PG8_SA
#undef PG8_SB
#undef PG8_STAGE
#undef PG8_LDA
#undef PG8_LDB
#undef PG8_MMA
#undef PG8_WAIT_V
#undef PG8_WAIT_L
#undef PG8_BAR
#undef PG8_SCHED
}
}

typedef unsigned short bf16;
typedef float f32x4 __attribute__((ext_vector_type(4)));
typedef unsigned u32x4 __attribute__((ext_vector_type(4)));
typedef unsigned u32x2 __attribute__((ext_vector_type(2)));
#define LAS __attribute__((address_space(3)))

constexpr int BATCH = 4, SEQ = 8192, T = BATCH * SEQ, D = 1024, FF = 2816, NGU = 2 * FF, ZP = 4608, ZN = 6656, INW = 6664;
constexpr int ZQA = 0, ZKA = 1024, ZVA = 1280, ZQM = 1536, ZKM = 2048, ZVM = 2560, ZOM = 3584, ZGA = 4608, ZGM = 5632;
constexpr float RMS_EPS = 1e-5f;
constexpr size_t MiB = (size_t)1 << 20;
constexpr size_t WS_WA = 0, WS_WP = 17 * MiB, WS_ROPE = 23 * MiB, WS_GATE = 25 * MiB, WS_MISC = 26 * MiB, WS_HA = 28 * MiB, WS_Z = 92 * MiB, WS_GR = 380 * MiB, WS_GS = 444 * MiB, WS_END = 508 * MiB;
constexpr size_t WA_GU = 0, WA_DN = 11 * MiB;
constexpr int LDS_BYTES = 147456;
constexpr int NPHASE = 14;

struct Args {
    const float* in[21]; float* out; unsigned char* ws; float inv_freq[32]; int ph_lo, ph_hi;
};

__device__ __forceinline__ unsigned f2bf(float f) { unsigned u = __builtin_bit_cast(unsigned, f); return (u + 0x7fffu + ((u >> 16) & 1u)) >> 16; }
typedef float f32x2_t __attribute__((ext_vector_type(2)));
typedef __bf16 bf16x2_t __attribute__((ext_vector_type(2)));
__device__ __forceinline__ unsigned pk2(float lo, float hi) { return __builtin_bit_cast(unsigned, __builtin_convertvector((f32x2_t){lo, hi}, bf16x2_t)); }
__device__ __forceinline__ float bf2f(bf16 b) { return __uint_as_float((unsigned)b << 16); }
__device__ __forceinline__ float wave_sum(float v) {
#pragma unroll
    for (int o = 1; o < 64; o <<= 1) v += __shfl_xor(v, o);
    return v;
}

__device__ __forceinline__ void transpose_item(const float* W, int pitch, int src_col0, int K, bf16* WT, int dst_row0, int k0, LAS float* scr, int lane) {
    typedef float f32x2v __attribute__((ext_vector_type(2)));
#pragma unroll 8
    for (int i = 0; i < 32; ++i) { const int kk = 2 * i + (lane >> 5), cc = 2 * (lane & 31); const f32x2v v = *(const f32x2v*)(W + (size_t)(k0 + kk) * pitch + src_col0 + cc); scr[kk * 65 + cc] = v.x; scr[kk * 65 + cc + 1] = v.y; }
    asm volatile("s_waitcnt lgkmcnt(0)" ::: "memory");
    const int c = lane & 7;
#pragma unroll
    for (int j = 0; j < 8; ++j) { const int n = (lane >> 3) + 8 * j; const LAS float* s = scr + (8 * c) * 65 + n;
        u32x4 o; o.x = pk2(s[0 * 65], s[1 * 65]); o.y = pk2(s[2 * 65], s[3 * 65]); o.z = pk2(s[4 * 65], s[5 * 65]); o.w = pk2(s[6 * 65], s[7 * 65]);
        *(u32x4*)(WT + (size_t)(dst_row0 + n) * K + k0 + 8 * c) = o; }
    asm volatile("s_waitcnt lgkmcnt(0)" ::: "memory");
}
__device__ __forceinline__ void convert_weight(const float* W, int pitch, int K, int nblk, bf16* WT, int mode, int gw, int NGW, LAS float* scr, int lane) {
    const int nitems = (K / 64) * nblk;
    for (int it = gw; it < nitems; it += NGW) {
        const int kb = it / nblk, nb = it % nblk; int src = 64 * nb, dst = 64 * nb;
        if (mode == 1) dst = 256 * (src >> 7) + (src & 127);
        else if (mode == 2) dst = 256 * (src >> 7) + (src & 127) + 128;
        else if (mode == 3) { if (dst >= 4608) { const int rel = dst - 4608, t = rel >> 8, w = rel & 255; src = 4616 + ((w & 128) ? 1024 : 0) + 128 * t + (w & 127); } }
        transpose_item(W, pitch, src, K, WT, dst, 64 * kb, scr, lane);
    }
}

__device__ __forceinline__ void norm_row(const float* xrow, const float* gain, bf16* orow, int lane, f32x4 (&v)[4]) {
    const f32x4* xr = (const f32x4*)xrow + lane; const f32x4* gr = (const f32x4*)gain + lane;
    float s = 0.f;
#pragma unroll
    for (int j = 0; j < 4; ++j) { v[j] = xr[64 * j]; s += (v[j].x * v[j].x + v[j].y * v[j].y) + (v[j].z * v[j].z + v[j].w * v[j].w); }
    const float rstd = 1.0f / sqrtf(wave_sum(s) * (1.0f / D) + RMS_EPS);
    unsigned long long* o8 = (unsigned long long*)orow + lane;
#pragma unroll
    for (int j = 0; j < 4; ++j) { const f32x4 g = gr[64 * j]; v[j] = v[j] * rstd * g;
        o8[64 * j] = (unsigned long long)pk2(v[j].x, v[j].y) | ((unsigned long long)pk2(v[j].z, v[j].w) << 32); }
}

namespace mm {
typedef short bf16x8 __attribute__((ext_vector_type(8)));
typedef short s16x4 __attribute__((ext_vector_type(4)));
typedef short v4i16_t __attribute__((ext_vector_type(4)));
typedef float f32x16 __attribute__((ext_vector_type(16)));
typedef float f32x8 __attribute__((ext_vector_type(8)));
typedef __bf16 bfv8 __attribute__((ext_vector_type(8)));
#define MFMA32(a, b, c) __builtin_amdgcn_mfma_f32_32x32x16_bf16((a), (b), (c), 0, 0, 0)
constexpr int PQ = 272, PV = 528;
__device__ __forceinline__ s16x4 vtr(const LAS unsigned char* p) { return __builtin_bit_cast(s16x4, __builtin_amdgcn_ds_read_tr16_b64_v4i16((LAS v4i16_t*)p)); }
__device__ __forceinline__ bf16x8 rowread(const LAS unsigned char* img, int pitch, int r0, int k0, int lane) { return *(const LAS bf16x8*)(img + (r0 + (lane & 31)) * pitch + (k0 + 8 * (lane >> 5)) * 2); }
template <bool PERM> __device__ __forceinline__ bf16x8 trread(const LAS unsigned char* img, int pitch, int k0, int c0, int lane) {
    const int h = lane >> 5, blk = (lane >> 4) & 1, q = (lane & 15) >> 2, p = lane & 3;
    const int rlo = PERM ? k0 + 4 * h + q : k0 + 8 * h + q, rhi = PERM ? k0 + 8 + 4 * h + q : k0 + 8 * h + 4 + q;
    const int cb = (c0 + 16 * blk + 4 * p) * 2;
    const s16x4 lo = vtr(img + rlo * pitch + cb), hi = vtr(img + rhi * pitch + cb);
    return __builtin_shufflevector(lo, hi, 0, 1, 2, 3, 4, 5, 6, 7);
}
__device__ __forceinline__ bf16x8 pack8(const f32x16& x, int s) {
    f32x8 v;
#pragma unroll
    for (int j = 0; j < 8; ++j) v[j] = x[8 * s + j];
    return __builtin_bit_cast(bf16x8, __builtin_convertvector(v, bfv8));
}
__device__ __forceinline__ void stage_conv(LAS unsigned char* img, const bf16* z, size_t tokb, int t0, int zcol0, const float* cw, const float* cbias, float scale, int tid) {
    const int cg8 = (tid & 15) * 8, lr = tid >> 4;
    float w[4][8], bb[8];
#pragma unroll
    for (int j = 0; j < 4; ++j) { const f32x4 a = *(const f32x4*)(cw + j * 1024 + cg8), b = *(const f32x4*)(cw + j * 1024 + cg8 + 4); w[j][0] = a.x; w[j][1] = a.y; w[j][2] = a.z; w[j][3] = a.w; w[j][4] = b.x; w[j][5] = b.y; w[j][6] = b.z; w[j][7] = b.w; }
    { const f32x4 a = *(const f32x4*)(cbias + cg8), b = *(const f32x4*)(cbias + cg8 + 4); bb[0] = a.x; bb[1] = a.y; bb[2] = a.z; bb[3] = a.w; bb[4] = b.x; bb[5] = b.y; bb[6] = b.z; bb[7] = b.w; }
    float r[7][8];
#pragma unroll
    for (int jj = 0; jj < 7; ++jj) { const int t = t0 + 4 * lr - 3 + jj; u32x4 v = {0u, 0u, 0u, 0u};
        if (t >= 0) v = *(const u32x4*)(z + (tokb + t) * ZP + zcol0 + cg8);
        r[jj][0] = pg8::bf_lo(v.x); r[jj][1] = pg8::bf_hi(v.x); r[jj][2] = pg8::bf_lo(v.y); r[jj][3] = pg8::bf_hi(v.y); r[jj][4] = pg8::bf_lo(v.z); r[jj][5] = pg8::bf_hi(v.z); r[jj][6] = pg8::bf_lo(v.w); r[jj][7] = pg8::bf_hi(v.w); }
#pragma unroll
    for (int i = 0; i < 4; ++i) { float y[8];
#pragma unroll
        for (int e = 0; e < 8; ++e) { float s = w[0][e] * r[i][e] + w[1][e] * r[i + 1][e] + w[2][e] * r[i + 2][e] + w[3][e] * r[i + 3][e] + bb[e]; y[e] = s * __builtin_amdgcn_rcpf(1.0f + __expf(-s)) * scale; }
        u32x4 o; o.x = pk2(y[0], y[1]); o.y = pk2(y[2], y[3]); o.z = pk2(y[4], y[5]); o.w = pk2(y[6], y[7]);
        *(LAS u32x4*)(img + (4 * lr + i) * PQ + cg8 * 2) = o; }
}
template <bool SCALE> __device__ __forceinline__ void stage_v(LAS unsigned char* img, const bf16* z, size_t tok0, int h, const LAS float* aa, int tid) {
    const int v8 = (tid & 31) * 8, l0 = tid >> 5;
#pragma unroll
    for (int i = 0; i < 8; ++i) { const int l = l0 + 16 * i; u32x4 v = *(const u32x4*)(z + (tok0 + l) * ZP + ZVM + h * 256 + v8);
        if (SCALE) { const float a = aa[l]; v.x = pk2(pg8::bf_lo(v.x) * a, pg8::bf_hi(v.x) * a); v.y = pk2(pg8::bf_lo(v.y) * a, pg8::bf_hi(v.y) * a); v.z = pk2(pg8::bf_lo(v.z) * a, pg8::bf_hi(v.z) * a); v.w = pk2(pg8::bf_lo(v.w) * a, pg8::bf_hi(v.w) * a); }
        *(LAS u32x4*)(img + l * PV + v8 * 2) = v; }
}
__device__ __forceinline__ void scan_add2(float a0, float a1, int lane, float& s0, float& s1) {
    float p = a0 + a1;
#pragma unroll
    for (int o = 1; o < 64; o <<= 1) { const float t = __shfl_up(p, o); if (lane >= o) p += t; }
    s1 = p; s0 = p - a1;
}
__device__ __forceinline__ void scan_max2(float a0, float a1, int lane, float& s0, float& s1) {
    float p = fmaxf(a0, a1);
#pragma unroll
    for (int o = 1; o < 64; o <<= 1) { const float t = __shfl_up(p, o); if (lane >= o) p = fmaxf(p, t); }
    s1 = p; const float prev = __shfl_up(p, 1); s0 = lane > 0 ? fmaxf(prev, a0) : a0;
}
constexpr int OFF_K1 = 0, OFF_V1 = 34816, OFF_F1 = 34816 + 67584;
__device__ __forceinline__ void dc_item(const bf16* z, const float* gates, const float* conv_w, const float* conv_b, bf16* dC, float* dn, float* mloc, float* bend, int item, LAS unsigned char* L, int tid, int lane, int wave) {
    const int b = item >> 8, h = (item >> 6) & 3, c = item & 63;
    const size_t tokb = (size_t)b * SEQ, tok0 = tokb + (size_t)c * 128;
    LAS unsigned char* kimg = L + OFF_K1; LAS unsigned char* vimg = L + OFF_V1; LAS float* lf = (LAS float*)(L + OFF_F1); LAS float* ig = lf + 128; LAS float* bc = lf + 256; LAS float* aa = lf + 384;
    __syncthreads();
    if (wave == 0) {
        const float lf0 = gates[(tok0 + 2 * lane) * 8 + 4 + h], lf1 = gates[(tok0 + 2 * lane + 1) * 8 + 4 + h], ig0 = gates[(tok0 + 2 * lane) * 8 + h], ig1 = gates[(tok0 + 2 * lane + 1) * 8 + h];
        float b0, b1; scan_add2(lf0, lf1, lane, b0, b1);
        const float be = __shfl(b1, 63), w0 = be - b0 + ig0, w1 = be - b1 + ig1;
        float ml = fmaxf(w0, w1);
#pragma unroll
        for (int o = 1; o < 64; o <<= 1) ml = fmaxf(ml, __shfl_xor(ml, o));
        aa[2 * lane] = __expf(w0 - ml); aa[2 * lane + 1] = __expf(w1 - ml);
        if (lane == 0) { mloc[item] = ml; bend[item] = be; }
    }
    stage_conv(kimg, z, tokb, c * 128, ZKM + h * 128, conv_w + 512 + h * 128, conv_b + 512 + h * 128, 0.08838834764831845f, tid);
    __syncthreads();
    stage_v<true>(vimg, z, tok0, h, aa, tid);
    __syncthreads();
    { const int d = tid >> 2, part = tid & 3; float s = 0.f;
#pragma unroll 4
      for (int l = part * 32; l < part * 32 + 32; ++l) s += aa[l] * bf2f(*(const LAS bf16*)(kimg + l * PQ + d * 2));
      s += __shfl_xor(s, 1); s += __shfl_xor(s, 2);
      if (part == 0) dn[(size_t)item * 128 + d] = s; }
    f32x16 acc[4];
#pragma unroll
    for (int dt = 0; dt < 4; ++dt)
#pragma unroll
        for (int i = 0; i < 16; ++i) acc[dt][i] = 0.f;
    {
        bf16x8 bvc = trread<false>(vimg, PV, 0, 32 * wave, lane), akc[4];
#pragma unroll
        for (int dt = 0; dt < 4; ++dt) akc[dt] = trread<false>(kimg, PQ, 0, 32 * dt, lane);
#pragma unroll
        for (int ks = 0; ks < 8; ++ks) {
            bf16x8 bvn = bvc, akn[4] = {akc[0], akc[1], akc[2], akc[3]};
            if (ks < 7) { bvn = trread<false>(vimg, PV, 16 * (ks + 1), 32 * wave, lane);
#pragma unroll
                for (int dt = 0; dt < 4; ++dt) akn[dt] = trread<false>(kimg, PQ, 16 * (ks + 1), 32 * dt, lane); }
            __builtin_amdgcn_sched_barrier(0);
#pragma unroll
            for (int dt = 0; dt < 4; ++dt) acc[dt] = MFMA32(akc[dt], bvc, acc[dt]);
            __builtin_amdgcn_sched_barrier(0);
            bvc = bvn;
#pragma unroll
            for (int dt = 0; dt < 4; ++dt) akc[dt] = akn[dt];
        }
    }
    const int r = lane & 31, hh = lane >> 5;
    bf16* orow = dC + (size_t)item * 32768 + (size_t)(32 * wave + r) * 128;
#pragma unroll
    for (int dt = 0; dt < 4; ++dt)
#pragma unroll
        for (int g = 0; g < 4; ++g) { u32x2 o; o.x = pk2(acc[dt][4 * g], acc[dt][4 * g + 1]); o.y = pk2(acc[dt][4 * g + 2], acc[dt][4 * g + 3]); *(u32x2*)(orow + 32 * dt + 8 * g + 4 * hh) = o; }
}
__device__ __forceinline__ void scan_phase(bf16* dC, float* dn, const float* mloc, const float* bend, float* mprev, int G, int tid) {
    for (int gidx = blockIdx.x * 512 + tid; gidx < 16 * 8192; gidx += G * 512) {
        const int bh = gidx >> 13, e4 = gidx & 8191;
        bf16* base = dC + (size_t)bh * 64 * 32768 + (size_t)e4 * 4;
        float C0 = 0.f, C1 = 0.f, C2 = 0.f, C3 = 0.f, m = 0.f;
        u32x2 ld[8];
#pragma unroll
        for (int k = 0; k < 8; ++k) ld[k] = *(const u32x2*)(base + (size_t)k * 32768);
        for (int c0 = 0; c0 < 64; c0 += 8) {
            u32x2 nx[8];
#pragma unroll
            for (int k = 0; k < 8; ++k) { const int c = c0 + 8 + k; nx[k] = (u32x2){0u, 0u}; if (c < 63) nx[k] = *(const u32x2*)(base + (size_t)c * 32768); }
#pragma unroll
            for (int k = 0; k < 8; ++k) { const int c = c0 + k;
                u32x2 o; o.x = pk2(C0, C1); o.y = pk2(C2, C3); *(u32x2*)(base + (size_t)c * 32768) = o;
                if (e4 == 0) mprev[bh * 64 + c] = m;
                if (c < 63) { const float ml = mloc[bh * 64 + c], be = bend[bh * 64 + c]; const float mn = fmaxf(be + m, ml), so = __expf(be + m - mn), sn = __expf(ml - mn);
                    C0 = so * C0 + sn * pg8::bf_lo(ld[k].x); C1 = so * C1 + sn * pg8::bf_hi(ld[k].x); C2 = so * C2 + sn * pg8::bf_lo(ld[k].y); C3 = so * C3 + sn * pg8::bf_hi(ld[k].y); m = mn; } }
#pragma unroll
            for (int k = 0; k < 8; ++k) ld[k] = nx[k];
        }
        if (gidx < 16 * 128) {
            const int bh2 = gidx >> 7, d = gidx & 127; float n = 0.f, m2 = 0.f;
            for (int c = 0; c < 64; ++c) { float* p = dn + (size_t)(bh2 * 64 + c) * 128 + d; const float dv = (c < 63) ? *p : 0.f; *p = n;
                if (c < 63) { const float ml = mloc[bh2 * 64 + c], be = bend[bh2 * 64 + c]; const float mn = fmaxf(be + m2, ml); n = __expf(be + m2 - mn) * n + __expf(ml - mn) * dv; m2 = mn; } }
        }
    }
}
constexpr int OFF_Q3 = 0, OFF_K3 = 34816, OFF_V3 = 69632, OFF_F3 = 69632 + 67584;
__device__ __forceinline__ void out_item(bf16* z, const float* gates, const float* conv_w, const float* conv_b, const bf16* Cprev, const float* nprev, const float* mprev, const float* hn, int item, LAS unsigned char* L, int tid, int lane, int wave) {
    const int b = item >> 8, h = (item >> 6) & 3, c = item & 63;
    const size_t tokb = (size_t)b * SEQ, tok0 = tokb + (size_t)c * 128;
    LAS unsigned char* qimg = L + OFF_Q3; LAS unsigned char* kimg = L + OFF_K3; LAS unsigned char* vimg = L + OFF_V3;
    LAS float* lf = (LAS float*)(L + OFF_F3); LAS float* ig = lf + 128; LAS float* bc = lf + 256; LAS float* uu = lf + 384; LAS float* gm = lf + 512; LAS float* np = lf + 640; LAS float* part = lf + 768;
    const int lw = wave & 3, vw = wave >> 2, r = lane & 31, hh = lane >> 5, l = 32 * lw + r;
    const bf16* cp = Cprev + (size_t)item * 32768 + (size_t)(128 * vw + r) * 128 + 8 * hh;
    bf16x8 cpa[2][4];
#pragma unroll
    for (int ks = 0; ks < 2; ++ks)
#pragma unroll
        for (int vt = 0; vt < 4; ++vt) cpa[ks][vt] = *(const bf16x8*)(cp + vt * 4096 + 16 * ks);
    __syncthreads();
    if (wave == 0) {
        const float lf0 = gates[(tok0 + 2 * lane) * 8 + 4 + h], lf1 = gates[(tok0 + 2 * lane + 1) * 8 + 4 + h], ig0 = gates[(tok0 + 2 * lane) * 8 + h], ig1 = gates[(tok0 + 2 * lane + 1) * 8 + h];
        float b0, b1; scan_add2(lf0, lf1, lane, b0, b1);
        const float u0 = ig0 - b0, u1 = ig1 - b1; float g0, g1; scan_max2(u0, u1, lane, g0, g1);
        bc[2 * lane] = b0; bc[2 * lane + 1] = b1; uu[2 * lane] = u0; uu[2 * lane + 1] = u1; gm[2 * lane] = g0; gm[2 * lane + 1] = g1;
    } else if (wave == 1 || wave == 2) np[tid - 64] = nprev[(size_t)item * 128 + tid - 64];
    stage_conv(qimg, z, tokb, c * 128, ZQM + h * 128, conv_w + h * 128, conv_b + h * 128, 1.0f, tid);
    stage_conv(kimg, z, tokb, c * 128, ZKM + h * 128, conv_w + 512 + h * 128, conv_b + 512 + h * 128, 0.08838834764831845f, tid);
    stage_v<false>(vimg, z, tok0, h, nullptr, tid);
    __syncthreads();
    const float mp = mprev[item];
    const float b_l = bc[l], mt = fmaxf(b_l + gm[l], b_l + mp), inter = __expf(b_l + mp - mt), e0 = b_l - mt;
    bf16x8 cpb[6][4];
#pragma unroll
    for (int ks = 0; ks < 6; ++ks)
#pragma unroll
        for (int vt = 0; vt < 4; ++vt) cpb[ks][vt] = *(const bf16x8*)(cp + vt * 4096 + 16 * (ks + 2));
    f32x16 O[4];
#pragma unroll
    for (int vt = 0; vt < 4; ++vt)
#pragma unroll
        for (int i = 0; i < 16; ++i) O[vt][i] = 0.f;
    {
        bf16x8 bqc = rowread(qimg, PQ, 32 * lw, 0, lane);
#pragma unroll
        for (int ks = 0; ks < 8; ++ks) {
            bf16x8 bqn = bqc; if (ks < 7) bqn = rowread(qimg, PQ, 32 * lw, 16 * (ks + 1), lane);
            __builtin_amdgcn_sched_barrier(0);
#pragma unroll
            for (int vt = 0; vt < 4; ++vt) O[vt] = MFMA32(ks < 2 ? cpa[ks][vt] : cpb[ks - 2][vt], bqc, O[vt]);
            __builtin_amdgcn_sched_barrier(0);
            bqc = bqn;
        }
    }
#pragma unroll
    for (int vt = 0; vt < 4; ++vt)
#pragma unroll
        for (int i = 0; i < 16; ++i) O[vt][i] *= inter;
    f32x16 S[4];
#pragma unroll
    for (int st = 0; st < 4; ++st)
#pragma unroll
        for (int i = 0; i < 16; ++i) S[st][i] = 0.f;
    {
        bf16x8 bqc = rowread(qimg, PQ, 32 * lw, 0, lane), akc[4];
#pragma unroll
        for (int st = 0; st < 4; ++st) akc[st] = rowread(kimg, PQ, 32 * st, 0, lane);
#pragma unroll
        for (int ks = 0; ks < 8; ++ks) {
            bf16x8 bqn = bqc, akn[4] = {akc[0], akc[1], akc[2], akc[3]};
            if (ks < 7) { bqn = rowread(qimg, PQ, 32 * lw, 16 * (ks + 1), lane);
#pragma unroll
                for (int st = 0; st < 4; ++st) akn[st] = rowread(kimg, PQ, 32 * st, 16 * (ks + 1), lane); }
            __builtin_amdgcn_sched_barrier(0);
#pragma unroll
            for (int st = 0; st < 4; ++st) S[st] = MFMA32(akc[st], bqc, S[st]);
            __builtin_amdgcn_sched_barrier(0);
            bqc = bqn;
#pragma unroll
            for (int st = 0; st < 4; ++st) akc[st] = akn[st];
        }
    }
    float dsum = 0.f;
#pragma unroll
    for (int st = 0; st < 4; ++st) {
#pragma unroll
        for (int g = 0; g < 4; ++g) { const int s0 = 32 * st + 8 * g + 4 * hh; const f32x4 u4 = *(const LAS f32x4*)(uu + s0);
#pragma unroll
            for (int e = 0; e < 4; ++e) { const float w = (s0 + e <= l) ? __expf(e0 + u4[e]) : 0.f; const float v = S[st][4 * g + e] * w; S[st][4 * g + e] = v; dsum += v; } } }
    dsum += __shfl_xor(dsum, 32);
    bf16x8 fr[4][2];
#pragma unroll
    for (int st = 0; st < 4; ++st) { fr[st][0] = pack8(S[st], 0); fr[st][1] = pack8(S[st], 1); }
    float qn = 0.f;
#pragma unroll
    for (int d8 = 0; d8 < 8; ++d8) { const bf16x8 qf = *(const LAS bf16x8*)(qimg + l * PQ + (64 * hh + 8 * d8) * 2); const f32x4 na = *(const LAS f32x4*)(np + 64 * hh + 8 * d8), nb = *(const LAS f32x4*)(np + 64 * hh + 8 * d8 + 4);
        qn += bf2f((bf16)qf[0]) * na.x + bf2f((bf16)qf[1]) * na.y + bf2f((bf16)qf[2]) * na.z + bf2f((bf16)qf[3]) * na.w + bf2f((bf16)qf[4]) * nb.x + bf2f((bf16)qf[5]) * nb.y + bf2f((bf16)qf[6]) * nb.z + bf2f((bf16)qf[7]) * nb.w; }
    qn += __shfl_xor(qn, 32);
    const float den = dsum + inter * qn, rden = 1.0f / fmaxf(fabsf(den), __expf(-mt));
    {
        bf16x8 avc[4];
#pragma unroll
        for (int vt = 0; vt < 4; ++vt) avc[vt] = trread<true>(vimg, PV, 0, 128 * vw + 32 * vt, lane);
#pragma unroll
        for (int step = 0; step < 8; ++step) {
            bf16x8 avn[4] = {avc[0], avc[1], avc[2], avc[3]};
            if (step < 7) {
#pragma unroll
                for (int vt = 0; vt < 4; ++vt) avn[vt] = trread<true>(vimg, PV, 16 * (step + 1), 128 * vw + 32 * vt, lane); }
            __builtin_amdgcn_sched_barrier(0);
#pragma unroll
            for (int vt = 0; vt < 4; ++vt) O[vt] = MFMA32(avc[vt], fr[step >> 1][step & 1], O[vt]);
            __builtin_amdgcn_sched_barrier(0);
#pragma unroll
            for (int vt = 0; vt < 4; ++vt) avc[vt] = avn[vt];
        }
    }
    bf16* orow = z + (tok0 + l) * ZP + ZOM + h * 256;
    float ss = 0.f;
#pragma unroll
    for (int vt = 0; vt < 4; ++vt)
#pragma unroll
        for (int i = 0; i < 16; ++i) { const float v = O[vt][i] * rden; O[vt][i] = v; ss += v * v; }
    ss += __shfl_xor(ss, 32);
    if (hh == 0) part[vw * 128 + l] = ss;
    __syncthreads();
    const float rstd = 1.0f / sqrtf((part[l] + part[128 + l]) * (1.0f / 256.0f) + RMS_EPS);
#pragma unroll
    for (int vt = 0; vt < 4; ++vt)
#pragma unroll
        for (int g = 0; g < 4; ++g) { const int v0 = 128 * vw + 32 * vt + 8 * g + 4 * hh; const u32x2 ow = *(const u32x2*)(orow + v0); const f32x4 gn = *(const f32x4*)(hn + h * 256 + v0);
            const float r0 = O[vt][4 * g] * rstd * gn.x * __builtin_amdgcn_rcpf(1.0f + __expf(-pg8::bf_lo(ow.x))), r1 = O[vt][4 * g + 1] * rstd * gn.y * __builtin_amdgcn_rcpf(1.0f + __expf(-pg8::bf_hi(ow.x)));
            const float r2 = O[vt][4 * g + 2] * rstd * gn.z * __builtin_amdgcn_rcpf(1.0f + __expf(-pg8::bf_lo(ow.y))), r3 = O[vt][4 * g + 3] * rstd * gn.w * __builtin_amdgcn_rcpf(1.0f + __expf(-pg8::bf_hi(ow.y)));
            u32x2 o; o.x = pk2(r0, r1); o.y = pk2(r2, r3); *(u32x2*)(orow + v0) = o; }
}
}


namespace at {
using namespace mm;
constexpr int PK = 144;
constexpr int OFF_K = 0, OFF_V = 256 * PK;
__device__ __forceinline__ void unpack8(const u32x4 v, float (&x)[8]) { x[0] = pg8::bf_lo(v.x); x[1] = pg8::bf_hi(v.x); x[2] = pg8::bf_lo(v.y); x[3] = pg8::bf_hi(v.y); x[4] = pg8::bf_lo(v.z); x[5] = pg8::bf_hi(v.z); x[6] = pg8::bf_lo(v.w); x[7] = pg8::bf_hi(v.w); }
__device__ __forceinline__ void load8f(const float* p, float (&x)[8]) { const f32x4 a = *(const f32x4*)p, b = *(const f32x4*)(p + 4); x[0] = a.x; x[1] = a.y; x[2] = a.z; x[3] = a.w; x[4] = b.x; x[5] = b.y; x[6] = b.z; x[7] = b.w; }
__device__ __forceinline__ bf16x8 cvt8(const float (&y)[8]) { f32x8 v;
#pragma unroll
    for (int e = 0; e < 8; ++e) v[e] = y[e];
    return __builtin_bit_cast(bf16x8, __builtin_convertvector(v, bfv8)); }
__device__ __forceinline__ void attn_item(bf16* z, const float* rope_cos, const float* rope_sin, const float* sinks, int item, LAS unsigned char* L, int tid, int lane, int wave) {
    const int hk = item & 3, n = (item >> 2) & 63, b = item >> 8;
    const size_t tok0 = (size_t)b * SEQ + (size_t)n * 128;
    LAS unsigned char* kimg = L + OFF_K; LAS unsigned char* vimg = L + OFF_V;
    __syncthreads();
    for (int idx = tid; idx < 1024; idx += 512) {
        const int key = idx >> 2, c8 = (idx & 3) * 8;
        bf16x8 o1 = {0, 0, 0, 0, 0, 0, 0, 0}, o2 = {0, 0, 0, 0, 0, 0, 0, 0};
        if (n > 0 || key >= 128) {
            const bf16* zr = z + (tok0 + key - 128) * ZP + ZKA + hk * 64;
            float x1[8], x2[8], cs[8], sn[8], y1[8], y2[8];
            unpack8(*(const u32x4*)(zr + c8), x1); unpack8(*(const u32x4*)(zr + c8 + 32), x2);
            const int pos = n * 128 + key - 128;
            load8f(rope_cos + pos * 32 + c8, cs); load8f(rope_sin + pos * 32 + c8, sn);
#pragma unroll
            for (int e = 0; e < 8; ++e) { y1[e] = x1[e] * cs[e] - x2[e] * sn[e]; y2[e] = x2[e] * cs[e] + x1[e] * sn[e]; }
            o1 = cvt8(y1); o2 = cvt8(y2);
        }
        *(LAS bf16x8*)(kimg + key * PK + c8 * 2) = o1; *(LAS bf16x8*)(kimg + key * PK + (c8 + 32) * 2) = o2;
    }
    for (int idx = tid; idx < 2048; idx += 512) {
        const int key = idx >> 3, c8 = (idx & 7) * 8; u32x4 v = {0u, 0u, 0u, 0u};
        if (n > 0 || key >= 128) v = *(const u32x4*)(z + (tok0 + key - 128) * ZP + ZVA + hk * 64 + c8);
        *(LAS u32x4*)(vimg + key * PK + c8 * 2) = v;
    }
    __syncthreads();
    const int r = lane & 31, hh = lane >> 5;
#pragma unroll 1
    for (int gsel = 0; gsel < 2; ++gsel) {
        const int gi = wave + 8 * gsel, g = gi >> 2, j = gi & 3, head = hk * 4 + g;
        bf16* qrow = z + (tok0 + 32 * j + r) * ZP + ZQA + head * 64; const int pos = n * 128 + 32 * j + r;
        u32x4 raw[4];
#pragma unroll
        for (int ks = 0; ks < 4; ++ks) raw[ks] = *(const u32x4*)(qrow + 16 * ks + 8 * hh);
        bf16x8 qf[4];
#pragma unroll
        for (int k2 = 0; k2 < 2; ++k2) { float x1[8], x2[8], cs[8], sn[8], y1[8], y2[8];
            unpack8(raw[k2], x1); unpack8(raw[k2 + 2], x2); load8f(rope_cos + pos * 32 + 16 * k2 + 8 * hh, cs); load8f(rope_sin + pos * 32 + 16 * k2 + 8 * hh, sn);
#pragma unroll
            for (int e = 0; e < 8; ++e) { y1[e] = (x1[e] * cs[e] - x2[e] * sn[e]) * 0.125f; y2[e] = (x2[e] * cs[e] + x1[e] * sn[e]) * 0.125f; }
            qf[k2] = cvt8(y1); qf[k2 + 2] = cvt8(y2); }
        f32x16 S[5];
#pragma unroll
        for (int kt = 0; kt < 5; ++kt)
#pragma unroll
            for (int i = 0; i < 16; ++i) S[kt][i] = 0.f;
#pragma unroll
        for (int ks = 0; ks < 4; ++ks)
#pragma unroll
            for (int kt = 0; kt < 5; ++kt) { const bf16x8 ak = rowread(kimg, PK, 32 * (j + kt), 16 * ks, lane); S[kt] = MFMA32(ak, qf[ks], S[kt]); }
        const float sink = sinks[head]; float mx = sink;
#pragma unroll
        for (int kt = 0; kt < 5; ++kt)
#pragma unroll
            for (int i = 0; i < 16; ++i) { const int cr = (i & 3) + 8 * (i >> 2) + 4 * hh; bool ok = (kt == 0) ? (cr > r) : (kt == 4) ? (cr <= r) : true; if (n == 0 && j + kt < 4) ok = false;
                const float s = ok ? S[kt][i] : -INFINITY; S[kt][i] = s; mx = fmaxf(mx, s); }
        mx = fmaxf(mx, __shfl_xor(mx, 32));
        float sum = 0.f;
#pragma unroll
        for (int kt = 0; kt < 5; ++kt)
#pragma unroll
            for (int i = 0; i < 16; ++i) { const float p = __expf(S[kt][i] - mx); S[kt][i] = p; sum += p; }
        sum += __shfl_xor(sum, 32); sum += __expf(sink - mx);
        const float inv = 1.0f / sum;
        f32x16 O[2];
#pragma unroll
        for (int dt = 0; dt < 2; ++dt)
#pragma unroll
            for (int i = 0; i < 16; ++i) O[dt][i] = 0.f;
#pragma unroll
        for (int kt = 0; kt < 5; ++kt)
#pragma unroll
            for (int s2 = 0; s2 < 2; ++s2) { const bf16x8 pf = pack8(S[kt], s2);
#pragma unroll
                for (int dt = 0; dt < 2; ++dt) { const bf16x8 av = trread<true>(vimg, PK, 32 * (j + kt) + 16 * s2, 32 * dt, lane); O[dt] = MFMA32(av, pf, O[dt]); } }
#pragma unroll
        for (int dt = 0; dt < 2; ++dt)
#pragma unroll
            for (int g4 = 0; g4 < 4; ++g4) { u32x2 o; o.x = pk2(O[dt][4 * g4] * inv, O[dt][4 * g4 + 1] * inv); o.y = pk2(O[dt][4 * g4 + 2] * inv, O[dt][4 * g4 + 3] * inv); *(u32x2*)(qrow + 32 * dt + 8 * g4 + 4 * hh) = o; }
    }
}
}


#define XB_TMO      128
#define XB_XCNT(j)  (256  + 64 * (j))
#define XB_XSUB(j)  (1280 + 64 * (j))
#define XB_XGEN(j)  (2304 + 64 * (j))
#define XB_TOP      3328
#define XB_TOPGEN   3392
#define XCD_BAR_WORDS 3456
#define XB_SPIN_CAP (1u << 18)
__device__ __forceinline__ unsigned xb_ld(unsigned* p)              { return __hip_atomic_load(p, __ATOMIC_RELAXED, __HIP_MEMORY_SCOPE_AGENT); }
__device__ __forceinline__ unsigned xb_add(unsigned* p, unsigned v) { return __hip_atomic_fetch_add(p, v, __ATOMIC_RELAXED, __HIP_MEMORY_SCOPE_AGENT); }
__device__ __forceinline__ unsigned xb_xcc_id() { return (unsigned)__builtin_amdgcn_s_getreg((3 << 11) | 20) & 0xFu; }
#define XB_SPIN(cond, bar) do { unsigned _sp = 0; while (cond) { __builtin_amdgcn_s_sleep(1); \
    if ((++_sp & 255u) == 0u) { if (xb_ld(&(bar)[XB_TMO])) break; if (_sp > XB_SPIN_CAP) { atomicAdd(&(bar)[XB_TMO], 1u); break; } } } } while (0)
struct XcdBarrier { unsigned* bar; unsigned x; volatile LAS unsigned* st; };
__device__ __forceinline__ XcdBarrier xcd_barrier_post(unsigned* bar, volatile LAS unsigned* st) {
    XcdBarrier b; b.bar = bar; b.x = xb_xcc_id(); b.st = st;
    if (threadIdx.x == 0) (void)xb_add(&bar[XB_XCNT(b.x)], 1u);
    return b;
}
__device__ __forceinline__ void xcd_barrier_complete(unsigned* bar, unsigned x, unsigned& nloc, unsigned& nx) {
    const unsigned G = gridDim.x * gridDim.y * gridDim.z;
    unsigned sum, cnt, mine, sp = 0u;
    for (;;) {
        sum = 0u; cnt = 0u; mine = 0u;
#pragma unroll
        for (unsigned j = 0; j < 16; ++j) { const unsigned c = xb_ld(&bar[XB_XCNT(j)]); sum += c; cnt += (c > 0u) ? 1u : 0u; mine = (j == x) ? c : mine; }
        if (sum == G) break;
        __builtin_amdgcn_s_sleep(1);
        if ((++sp & 255u) == 0u) { if (xb_ld(&bar[XB_TMO])) break; if (sp > XB_SPIN_CAP) { atomicAdd(&bar[XB_TMO], 1u); break; } }
    }
    nloc = mine > 0u ? mine : 1u; nx = cnt > 0u ? cnt : 1u;
}
__device__ __forceinline__ void xcd_barrier(const XcdBarrier& b) {
    asm volatile("s_waitcnt vmcnt(0)" ::: "memory");
    __syncthreads();
    if (threadIdx.x == 0) {
        unsigned* bar = b.bar;
        __builtin_amdgcn_s_waitcnt(0);
        unsigned nloc = b.st[0], nx = b.st[1];
        if (nloc == 0u) { xcd_barrier_complete(bar, b.x, nloc, nx); b.st[0] = nloc; b.st[1] = nx; }
        const unsigned old = xb_add(&bar[XB_XSUB(b.x)], 1u);
        const unsigned gen = old / nloc;
        if (old + 1u == (gen + 1u) * nloc) {
            __builtin_amdgcn_fence(__ATOMIC_RELEASE, "agent");
            asm volatile("s_waitcnt vmcnt(0)" ::: "memory");
            const unsigned og = xb_add(&bar[XB_TOP], 1u);
            const unsigned tg = og / nx;
            if (og + 1u == (tg + 1u) * nx) xb_add(&bar[XB_TOPGEN], 1u);
            else XB_SPIN(xb_ld(&bar[XB_TOPGEN]) == tg, bar);
            __builtin_amdgcn_fence(__ATOMIC_ACQUIRE, "agent");
            xb_add(&bar[XB_XGEN(b.x)], 1u);
            asm volatile("s_waitcnt vmcnt(0)" ::: "memory");
        } else {
            XB_SPIN(xb_ld(&bar[XB_XGEN(b.x)]) == gen, bar);
            __builtin_amdgcn_fence(__ATOMIC_ACQUIRE, "agent");
            asm volatile("s_waitcnt vmcnt(0)" ::: "memory");
        }
    }
    __syncthreads();
}

__global__ void __launch_bounds__(512, 2) mega_fwd(Args args) {
    extern __shared__ __attribute__((aligned(16))) unsigned char lds[];
    cg::grid_group grid = cg::this_grid();
    const int tid = threadIdx.x, lane = tid & 63, wave = __builtin_amdgcn_readfirstlane(tid >> 6);
    const int G = gridDim.x, gw = blockIdx.x * 8 + wave, NGW = G * 8;
    unsigned char* ws = args.ws;
    const float* x = args.in[0];
    float* out = args.out;
    bf16* WA = (bf16*)(ws + WS_WA); bf16* Wgu = (bf16*)(ws + WS_WA + WA_GU); bf16* Wdn = (bf16*)(ws + WS_WA + WA_DN);
    bf16* Watt = (bf16*)(ws + WS_WP); bf16* Wml = (bf16*)(ws + WS_WP + 2 * MiB); bf16* Wout = (bf16*)(ws + WS_WP + 4 * MiB);
    float* rope_cos = (float*)(ws + WS_ROPE); float* rope_sin = rope_cos + SEQ * 32;
    float* gates = (float*)(ws + WS_GATE);
    float* dnb = (float*)(ws + WS_MISC); float* mlocb = dnb + 1024 * 128; float* bendb = mlocb + 1024; float* mprevb = bendb + 1024;
    bf16* hA = (bf16*)(ws + WS_HA); bf16* Z = (bf16*)(ws + WS_Z); bf16* HID = (bf16*)(ws + WS_Z);
    LAS float* scr = (LAS float*)((LAS unsigned char*)lds + wave * 16640);
    const int lo = args.ph_lo, hi = args.ph_hi;
#define IN(k) (lo <= (k) && (k) < hi)
    unsigned* barw = (unsigned*)(ws + WS_MISC + MiB);
    volatile LAS unsigned* bst = (volatile LAS unsigned*)((LAS unsigned char*)lds + LDS_BYTES - 16);
    if (lo == 0) {
        if (blockIdx.x == 0) for (int u = tid; u < XCD_BAR_WORDS; u += 512) barw[u] = 0u;
        if (tid < 2) bst[tid] = 0u;
    }
    XcdBarrier xbar; xbar.bar = barw; xbar.x = 0; xbar.st = bst;
#define SEAM(k) do { if (IN(k) && IN((k) + 1)) { if ((k) == 0) { grid.sync(); xbar = xcd_barrier_post(barw, bst); } else xcd_barrier(xbar); } } while (0)

    if (IN(0)) {
        convert_weight(args.in[2], FF, D, FF / 64, Wgu, 1, gw, NGW, scr, lane);
        convert_weight(args.in[3], FF, D, FF / 64, Wgu, 2, gw, NGW, scr, lane);
        convert_weight(args.in[4], D, FF, D / 64, Wdn, 0, gw, NGW, scr, lane);
        convert_weight(args.in[13], D, D, D / 64, Watt, 0, gw, NGW, scr, lane);
        convert_weight(args.in[14], D, D, D / 64, Wml, 0, gw, NGW, scr, lane);
        convert_weight(args.in[15], D, D, D / 64, Wout, 0, gw, NGW, scr, lane);
        for (int idx = blockIdx.x * 512 + tid; idx < SEQ * 32; idx += G * 512) {
            const int pos = idx >> 5, i = idx & 31;
            const float angf = (float)pos * args.inv_freq[i];
            const double ang = (double)angf;
            const double kq = rint(ang * 0.63661977236758134308);
            const double y = (ang - kq * 1.57079632679489655800) - kq * 6.123233995736766e-17;
            const double y2 = y * y;
            const double sy = y * (1.0 + y2 * (-1.0 / 6 + y2 * (1.0 / 120 + y2 * (-1.0 / 5040 + y2 * (1.0 / 362880 + y2 * (-1.0 / 39916800 + y2 * (1.0 / 6227020800.0)))))));
            const double cy = 1.0 + y2 * (-0.5 + y2 * (1.0 / 24 + y2 * (-1.0 / 720 + y2 * (1.0 / 40320 + y2 * (-1.0 / 3628800 + y2 * (1.0 / 479001600.0 + y2 * (-1.0 / 87178291200.0)))))));
            const long long qi = (long long)kq; const int qd = (int)(qi & 3);
            const double sn = qd == 0 ? sy : qd == 1 ? cy : qd == 2 ? -sy : -cy;
            const double cs = qd == 0 ? cy : qd == 1 ? -sy : qd == 2 ? -cy : sy;
            rope_cos[idx] = (float)cs; rope_sin[idx] = (float)sn;
        }
        for (int r = gw; r < T; r += NGW) { f32x4 v[4]; norm_row(x + (size_t)r * D, args.in[1], hA + (size_t)r * D, lane, v); }
    }
    SEAM(0);
    if (IN(1)) {
        pg8::Gemm g{hA, hA, Wgu, Wgu, D, D}; pg8::StaticOrder S; S.init(T, NGU, G, (int)blockIdx.x);
        pg8::EpiSwiGLU E{HID, FF};
        pg8::gemm_phase<pg8::EpiSwiGLU, pg8::StaticOrder>((PG8_LAS unsigned char*)lds, g, S, E);
    }
    SEAM(1);
    if (IN(2)) {
        pg8::Gemm g{HID, HID, Wdn, Wdn, FF, FF}; pg8::StaticOrder S; S.init(T, D, G, (int)blockIdx.x);
        pg8::EpiResid E{x, out, D, 0.5f};
        pg8::gemm_phase<pg8::EpiResid, pg8::StaticOrder>((PG8_LAS unsigned char*)lds, g, S, E);
    }
    SEAM(2);
    if (IN(3)) {
        convert_weight(args.in[6], INW, D, ZN / 64, WA, 3, gw, NGW, scr, lane);
        const float* win = args.in[6];
        f32x4 wga[16], wgb[16];
#pragma unroll
        for (int j = 0; j < 4; ++j)
#pragma unroll
            for (int e = 0; e < 4; ++e) { const int k = 256 * j + 4 * lane + e; wga[4 * j + e] = *(const f32x4*)(win + (size_t)k * INW + 4608); wgb[4 * j + e] = *(const f32x4*)(win + (size_t)k * INW + 4612); }
        for (int r = gw; r < T; r += NGW) {
            f32x4 v[4]; norm_row(out + (size_t)r * D, args.in[5], hA + (size_t)r * D, lane, v);
            float gsum[8];
#pragma unroll
            for (int e = 0; e < 8; ++e) gsum[e] = 0.f;
#pragma unroll
            for (int j = 0; j < 4; ++j)
#pragma unroll
                for (int e = 0; e < 4; ++e) { const f32x4 wa = wga[4 * j + e], wb = wgb[4 * j + e]; const float hv = v[j][e];
                    gsum[0] += hv * wa.x; gsum[1] += hv * wa.y; gsum[2] += hv * wa.z; gsum[3] += hv * wa.w; gsum[4] += hv * wb.x; gsum[5] += hv * wb.y; gsum[6] += hv * wb.z; gsum[7] += hv * wb.w; }
#pragma unroll
            for (int e = 0; e < 8; ++e) gsum[e] = wave_sum(gsum[e]);
            if (lane < 8) {
                float val = lane == 0 ? gsum[0] : lane == 1 ? gsum[1] : lane == 2 ? gsum[2] : lane == 3 ? gsum[3] : lane == 4 ? gsum[4] : lane == 5 ? gsum[5] : lane == 6 ? gsum[6] : gsum[7];
                if (lane < 4) val += args.in[7][lane];
                else { const float xx = val + args.in[8][lane - 4]; val = fminf(xx, 0.f) - log1pf(expf(-fabsf(xx))); }
                gates[(size_t)r * 8 + lane] = val;
            }
        }
    }
    SEAM(3);
    if (IN(4)) {
        pg8::Gemm g{hA, hA, WA, WA, D, D}; pg8::StaticOrder S; S.init(T, ZN, G, (int)blockIdx.x);
        pg8::EpiZG E{Z, ZP, (pg8::u32x4*)(ws + WS_GR), (pg8::u32x4*)(ws + WS_GS)};
        pg8::gemm_phase<pg8::EpiZG, pg8::StaticOrder>((PG8_LAS unsigned char*)lds, g, S, E);
    }
    SEAM(4);
    if (IN(5)) {
        for (int it = blockIdx.x; it < 1024; it += G) if ((it & 63) != 63) mm::dc_item(Z, gates, args.in[10], args.in[11], hA, dnb, mlocb, bendb, it, (LAS unsigned char*)lds, tid, lane, wave);
        for (int it = blockIdx.x; it < 1024; it += G) at::attn_item(Z, rope_cos, rope_sin, args.in[9], it, (LAS unsigned char*)lds, tid, lane, wave);
    }
    SEAM(5);
    if (IN(6)) {
        __syncthreads();
        mm::scan_phase(hA, dnb, mlocb, bendb, mprevb, G, tid);
        convert_weight(args.in[17], FF, D, FF / 64, Wgu, 1, gw, NGW, scr, lane);
        convert_weight(args.in[18], FF, D, FF / 64, Wgu, 2, gw, NGW, scr, lane);
        convert_weight(args.in[19], D, FF, D / 64, Wdn, 0, gw, NGW, scr, lane);
    }
    SEAM(6);
    if (IN(7)) {
        for (int it = blockIdx.x; it < 1024; it += G) mm::out_item(Z, gates, args.in[10], args.in[11], hA, dnb, mprevb, args.in[12], it, (LAS unsigned char*)lds, tid, lane, wave);
    }
    SEAM(7);
    if (IN(8)) {
        pg8::Gemm g{Z + ZQA, Z + ZOM, Watt, Wml, ZP, D}; pg8::PairOrder S; S.so.init(T, D, G, (int)blockIdx.x);
        pg8::EpiMix E{Z + ZQM, ZP, (const pg8::u32x4*)(ws + WS_GR), (const pg8::u32x4*)(ws + WS_GS)};
        pg8::gemm_phase<pg8::EpiMix, pg8::PairOrder>((PG8_LAS unsigned char*)lds, g, S, E);
    }
    SEAM(8);
    if (IN(9)) {
        pg8::Gemm g{Z + ZQM, Z + ZQM, Wout, Wout, ZP, D}; pg8::StaticOrder S; S.init(T, D, G, (int)blockIdx.x);
        pg8::EpiResid E{out, out, D, 1.0f};
        pg8::gemm_phase<pg8::EpiResid, pg8::StaticOrder>((PG8_LAS unsigned char*)lds, g, S, E);
    }
    SEAM(9);
    if (IN(10)) {
        for (int r = gw; r < T; r += NGW) { f32x4 v[4]; norm_row(out + (size_t)r * D, args.in[16], hA + (size_t)r * D, lane, v); }
    }
    SEAM(10);
    if (IN(11)) {
        pg8::Gemm g{hA, hA, Wgu, Wgu, D, D}; pg8::StaticOrder S; S.init(T, NGU, G, (int)blockIdx.x);
        pg8::EpiSwiGLU E{HID, FF};
        pg8::gemm_phase<pg8::EpiSwiGLU, pg8::StaticOrder>((PG8_LAS unsigned char*)lds, g, S, E);
    }
    SEAM(11);
    if (IN(12)) {
        pg8::Gemm g{HID, HID, Wdn, Wdn, FF, FF}; pg8::StaticOrder S; S.init(T, D, G, (int)blockIdx.x);
        pg8::EpiResid E{out, out, D, 0.5f};
        pg8::gemm_phase<pg8::EpiResid, pg8::StaticOrder>((PG8_LAS unsigned char*)lds, g, S, E);
    }
    SEAM(12);
    if (IN(13)) {
        const float* gain = args.in[20];
        for (int r = gw; r < T; r += NGW) {
            f32x4* xr = (f32x4*)(out + (size_t)r * D) + lane; const f32x4* gr = (const f32x4*)gain + lane;
            f32x4 v[4]; float s = 0.f;
#pragma unroll
            for (int j = 0; j < 4; ++j) { v[j] = xr[64 * j]; s += (v[j].x * v[j].x + v[j].y * v[j].y) + (v[j].z * v[j].z + v[j].w * v[j].w); }
            const float rstd = 1.0f / sqrtf(wave_sum(s) * (1.0f / D) + RMS_EPS);
#pragma unroll
            for (int j = 0; j < 4; ++j) xr[64 * j] = v[j] * rstd * gr[64 * j];
        }
    }
#undef IN
#undef SEAM
}

extern "C" void kernel_launch(void* const* d_in, const int* in_sizes, int n_in, void* d_out, int out_size, void* d_ws, size_t ws_size, hipStream_t stream) {
    static int grid = 0;
    if (grid == 0) {
        if (n_in != 21 || out_size != T * D || ws_size < WS_END) { fprintf(stderr, "kernel_launch: unexpected shapes (n_in %d out %d ws %zu)\n", n_in, out_size, ws_size); grid = -1; return; }
        int dev = 0, cus = 0, per_cu = 0;
        hipGetDevice(&dev); hipDeviceGetAttribute(&cus, hipDeviceAttributeMultiprocessorCount, dev);
        if (hipFuncSetAttribute((const void*)mega_fwd, hipFuncAttributeMaxDynamicSharedMemorySize, LDS_BYTES) != hipSuccess) { fprintf(stderr, "kernel_launch: hipFuncSetAttribute failed\n"); grid = -1; return; }
        if (hipOccupancyMaxActiveBlocksPerMultiprocessor(&per_cu, (const void*)mega_fwd, 512, LDS_BYTES) != hipSuccess || per_cu < 1) { fprintf(stderr, "kernel_launch: occupancy query failed (%d)\n", per_cu); per_cu = 1; }
        (void)hipGetLastError();
        grid = cus * per_cu;
    }
    if (grid < 0) return;
    Args a{};
    for (int i = 0; i < 21; ++i) a.in[i] = (const float*)d_in[i];
    a.out = (float*)d_out; a.ws = (unsigned char*)d_ws;
    for (int i = 0; i < 32; ++i) a.inv_freq[i] = (float)pow(10000.0, -(double)i / 32.0);
#if MK_PER_PHASE_LAUNCH
    for (int ph = 0; ph < NPHASE; ++ph) { a.ph_lo = ph; a.ph_hi = ph + 1; hipLaunchKernelGGL(mega_fwd, dim3(grid), dim3(512), LDS_BYTES, stream, a); }
#else
    a.ph_lo = 0; a.ph_hi = NPHASE;
    void* kargs[] = {&a};
    hipError_t e = hipLaunchCooperativeKernel((const void*)mega_fwd, dim3(grid), dim3(512), kargs, LDS_BYTES, stream);
    if (e != hipSuccess) fprintf(stderr, "kernel_launch: cooperative launch failed: %s (grid %d)\n", hipGetErrorString(e), grid);
#endif
}
```

```cpp
#include <hip/hip_runtime.h>
#include <hip/hip_cooperative_groups.h>
#include <cstdio>
#include <cstdint>
#include <cmath>
namespace cg = cooperative_groups;

#ifndef MK_PER_PHASE_LAUNCH
#define MK_PER_PHASE_LAUNCH 0
#endif

namespace pg8 {
#define PG8_LAS __attribute__((address_space(3)))
typedef unsigned short bf16_t;
typedef short bf16x8 __attribute__((ext_vector_type(8)));
typedef float f32x4 __attribute__((ext_vector_type(4)));
typedef unsigned u32x4 __attribute__((ext_vector_type(4)));
constexpr int BM = 256, BK = 64, HALF = 128, HTB = HALF * BK * 2, STAGE_BYTES = 8 * HTB, NXCD = 8, WGM = 8;

__host__ __device__ __forceinline__ int lds_byte(int r, int c) { const int st = (r >> 4) * 2 + (c >> 5), rr = r & 15, cc = c & 31, ob = rr * 64 + cc * 2; return st * 1024 + (ob ^ (((ob >> 9) & 1) << 5)); }
__host__ __device__ __forceinline__ void stage_rc(int b, int& R, int& C) { const int st = b / 1024, sb = b % 1024, swz = sb ^ (((sb >> 9) & 1) << 5); R = (st >> 1) * 16 + swz / 64; C = (st & 1) * 32 + (swz % 64) / 2; }
__host__ __device__ __forceinline__ int perm32(int rho) { const int n = rho >> 4, i = rho & 15; return 8 * (i >> 2) + 4 * n + (i & 3); }

struct Unit { int pm, pn, kind; };
struct Gemm { const bf16_t* A0; const bf16_t* A1; const bf16_t* B0; const bf16_t* B1; int lda, K; };

struct StaticOrder {
    int nM, nN, nwg, G, c;
    __host__ __device__ void init(int M, int N, int G_, int c_) { nM = M / BM; nN = N / BM; nwg = nM * nN; G = G_; c = c_; }
    __host__ __device__ bool next(int i, Unit& u) const {
        const long L = (long)i * G + c; if (L >= nwg) return false;
        int wgid = (int)L; { const int q = nwg / NXCD, r = nwg % NXCD, xcd = wgid % NXCD, off = wgid / NXCD; wgid = (xcd < r ? xcd * (q + 1) : r * (q + 1) + (xcd - r) * q) + off; }
        const int nig = WGM * nN, gid = wgid / nig, fm = gid * WGM, gsz = (nM - fm) < WGM ? (nM - fm) : WGM;
        u.pm = fm + ((wgid % nig) % gsz); u.pn = (wgid % nig) / gsz; u.kind = 0; return true;
    }
};
struct PairOrder {
    StaticOrder so;
    __host__ __device__ bool next(int i, Unit& u) const { if (!so.next(i >> 1, u)) return false; u.kind = i & 1; return true; }
};

__device__ __forceinline__ unsigned cvt_pk_bf16(float lo, float hi) { unsigned r; asm volatile("v_cvt_pk_bf16_f32 %0, %1, %2" : "=v"(r) : "v"(lo), "v"(hi)); return r; }
__device__ __forceinline__ float bf_lo(unsigned w) { return __uint_as_float(w << 16); }
__device__ __forceinline__ float bf_hi(unsigned w) { return __uint_as_float(w & 0xffff0000u); }
__device__ __forceinline__ float sigmoid_den(float x) { return 1.0f + __expf(-x); }


struct EpiBf16 {
    bf16_t* O; int ldc;
    __device__ __forceinline__ bool operator()(f32x4 (&acc)[2][2][4][2], const Unit& u, int wr, int wc, int fr, int fq) const {
        const int row0 = u.pm * BM + wr * 64 + fr, col0 = u.pn * BM + wc * 32 + 8 * fq;
#pragma unroll
        for (int ai = 0; ai < 2; ++ai)
#pragma unroll
            for (int m = 0; m < 4; ++m) { bf16_t* rowp = O + (size_t)(row0 + ai * HALF + m * 16) * ldc + col0;
#pragma unroll
                for (int bj = 0; bj < 2; ++bj) { const f32x4 v0 = acc[ai][bj][m][0], v1 = acc[ai][bj][m][1];
                    u32x4 w; w.x = cvt_pk_bf16(v0[0], v0[1]); w.y = cvt_pk_bf16(v0[2], v0[3]); w.z = cvt_pk_bf16(v1[0], v1[1]); w.w = cvt_pk_bf16(v1[2], v1[3]);
                    *(u32x4*)(rowp + bj * HALF) = w; } }
        return true;
    }
};
struct EpiSwiGLU {
    bf16_t* O; int ldc;
    __device__ __forceinline__ bool operator()(f32x4 (&acc)[2][2][4][2], const Unit& u, int wr, int wc, int fr, int fq) const {
        const int row0 = u.pm * BM + wr * 64 + fr, col0 = u.pn * HALF + wc * 32 + 8 * fq;
#pragma unroll
        for (int ai = 0; ai < 2; ++ai)
#pragma unroll
            for (int m = 0; m < 4; ++m) { bf16_t* rowp = O + (size_t)(row0 + ai * HALF + m * 16) * ldc + col0;
                float r[8];
#pragma unroll
                for (int n = 0; n < 2; ++n)
#pragma unroll
                    for (int e = 0; e < 4; ++e) { const float g = acc[ai][0][m][n][e], up = acc[ai][1][m][n][e]; r[4 * n + e] = g * __builtin_amdgcn_rcpf(1.0f + __expf(-g)) * up; }
                u32x4 w; w.x = cvt_pk_bf16(r[0], r[1]); w.y = cvt_pk_bf16(r[2], r[3]); w.z = cvt_pk_bf16(r[4], r[5]); w.w = cvt_pk_bf16(r[6], r[7]);
                *(u32x4*)rowp = w; }
        return true;
    }
};
struct EpiResid {
    const float* base; float* out; int ldc; float alpha;
    __device__ __forceinline__ bool operator()(f32x4 (&acc)[2][2][4][2], const Unit& u, int wr, int wc, int fr, int fq) const {
        const int row0 = u.pm * BM + wr * 64 + fr, col0 = u.pn * BM + wc * 32 + 8 * fq;
#pragma unroll
        for (int ai = 0; ai < 2; ++ai)
#pragma unroll
            for (int mh = 0; mh < 2; ++mh) {
                f32x4 bv[2][2][2];
#pragma unroll
                for (int m2 = 0; m2 < 2; ++m2) { const size_t off = (size_t)(row0 + ai * HALF + (2 * mh + m2) * 16) * ldc + col0;
#pragma unroll
                    for (int bj = 0; bj < 2; ++bj)
#pragma unroll
                        for (int n = 0; n < 2; ++n) bv[m2][bj][n] = *(const f32x4*)(base + off + bj * HALF + 4 * n); }
                __builtin_amdgcn_sched_barrier(0);
#pragma unroll
                for (int m2 = 0; m2 < 2; ++m2) { const int m = 2 * mh + m2; const size_t off = (size_t)(row0 + ai * HALF + m * 16) * ldc + col0;
#pragma unroll
                    for (int bj = 0; bj < 2; ++bj)
#pragma unroll
                        for (int n = 0; n < 2; ++n) *(f32x4*)(out + off + bj * HALF + 4 * n) = bv[m2][bj][n] + acc[ai][bj][m][n] * alpha; }
                __builtin_amdgcn_sched_barrier(0);
            }
        return true;
    }
};
struct EpiAccBf16 {
    bf16_t* Dl; int ldc; float alpha;
    __device__ __forceinline__ bool operator()(f32x4 (&acc)[2][2][4][2], const Unit& u, int wr, int wc, int fr, int fq) const {
        const int row0 = u.pm * BM + wr * 64 + fr, col0 = u.pn * BM + wc * 32 + 8 * fq;
#pragma unroll
        for (int ai = 0; ai < 2; ++ai) {
            u32x4 dv[4][2];
#pragma unroll
            for (int m = 0; m < 4; ++m)
#pragma unroll
                for (int bj = 0; bj < 2; ++bj) dv[m][bj] = *(const u32x4*)(Dl + (size_t)(row0 + ai * HALF + m * 16) * ldc + col0 + bj * HALF);
            __builtin_amdgcn_sched_barrier(0);
#pragma unroll
            for (int m = 0; m < 4; ++m)
#pragma unroll
                for (int bj = 0; bj < 2; ++bj) { const u32x4 d4 = dv[m][bj]; const f32x4 v0 = acc[ai][bj][m][0] * alpha, v1 = acc[ai][bj][m][1] * alpha;
                    u32x4 w; w.x = cvt_pk_bf16(bf_lo(d4.x) + v0[0], bf_hi(d4.x) + v0[1]); w.y = cvt_pk_bf16(bf_lo(d4.y) + v0[2], bf_hi(d4.y) + v0[3]);
                    w.z = cvt_pk_bf16(bf_lo(d4.z) + v1[0], bf_hi(d4.z) + v1[1]); w.w = cvt_pk_bf16(bf_lo(d4.w) + v1[2], bf_hi(d4.w) + v1[3]);
                    *(u32x4*)(Dl + (size_t)(row0 + ai * HALF + m * 16) * ldc + col0 + bj * HALF) = w; }
            __builtin_amdgcn_sched_barrier(0);
        }
        return true;
    }
};
struct EpiZG {
    bf16_t* O; int ldc; u32x4* GR; u32x4* GS;
    __device__ __forceinline__ bool operator()(f32x4 (&acc)[2][2][4][2], const Unit& u, int wr, int wc, int fr, int fq) const {
        if (u.pn < 18) {
            const int row0 = u.pm * BM + wr * 64 + fr, col0 = u.pn * BM + wc * 32 + 8 * fq;
#pragma unroll
            for (int ai = 0; ai < 2; ++ai)
#pragma unroll
                for (int m = 0; m < 4; ++m) { bf16_t* rowp = O + (size_t)(row0 + ai * HALF + m * 16) * ldc + col0;
#pragma unroll
                    for (int bj = 0; bj < 2; ++bj) { const f32x4 v0 = acc[ai][bj][m][0], v1 = acc[ai][bj][m][1];
                        u32x4 w; w.x = cvt_pk_bf16(v0[0], v0[1]); w.y = cvt_pk_bf16(v0[2], v0[3]); w.z = cvt_pk_bf16(v1[0], v1[1]); w.w = cvt_pk_bf16(v1[2], v1[3]);
                        *(u32x4*)(rowp + bj * HALF) = w; } }
        } else {
            const int t = u.pn - 18; const size_t base = (size_t)(u.pm * 8 + t) * 8 * 512 + threadIdx.x;
#pragma unroll
            for (int ai = 0; ai < 2; ++ai)
#pragma unroll
                for (int m = 0; m < 4; ++m) { float rho[8], sm[8];
#pragma unroll
                    for (int n = 0; n < 2; ++n)
#pragma unroll
                        for (int e = 0; e < 4; ++e) { const float da = sigmoid_den(acc[ai][0][m][n][e]), dm = sigmoid_den(acc[ai][1][m][n][e]); const float s = __builtin_amdgcn_rcpf(dm); sm[4 * n + e] = s; rho[4 * n + e] = dm * __builtin_amdgcn_rcpf(da); }
                    u32x4 wr_, ws_; wr_.x = cvt_pk_bf16(rho[0], rho[1]); wr_.y = cvt_pk_bf16(rho[2], rho[3]); wr_.z = cvt_pk_bf16(rho[4], rho[5]); wr_.w = cvt_pk_bf16(rho[6], rho[7]);
                    ws_.x = cvt_pk_bf16(sm[0], sm[1]); ws_.y = cvt_pk_bf16(sm[2], sm[3]); ws_.z = cvt_pk_bf16(sm[4], sm[5]); ws_.w = cvt_pk_bf16(sm[6], sm[7]);
                    GR[base + (size_t)(ai * 4 + m) * 512] = wr_; GS[base + (size_t)(ai * 4 + m) * 512] = ws_; }
        }
        return true;
    }
};
struct EpiMix {
    bf16_t* Y; int ldy; const u32x4* GR; const u32x4* GS;
    __device__ __forceinline__ bool operator()(f32x4 (&acc)[2][2][4][2], const Unit& u, int wr, int wc, int fr, int fq) const {
        const int row0 = u.pm * BM + wr * 64 + fr, col0 = u.pn * BM + wc * 32 + 8 * fq;
        const u32x4* G = u.kind == 0 ? GR : GS;
#pragma unroll
        for (int ai = 0; ai < 2; ++ai)
#pragma unroll
            for (int m = 0; m < 4; ++m) { const size_t off = (size_t)(row0 + ai * HALF + m * 16) * ldy + col0;
#pragma unroll
                for (int bj = 0; bj < 2; ++bj) {
                    const u32x4 gv = G[(size_t)((u.pm * 8 + 2 * u.pn + bj) * 8 + ai * 4 + m) * 512 + threadIdx.x];
                    const float f[8] = {bf_lo(gv.x), bf_hi(gv.x), bf_lo(gv.y), bf_hi(gv.y), bf_lo(gv.z), bf_hi(gv.z), bf_lo(gv.w), bf_hi(gv.w)};
                    if (u.kind == 0) {
#pragma unroll
                        for (int n = 0; n < 2; ++n)
#pragma unroll
                            for (int e = 0; e < 4; ++e) acc[ai][bj][m][n][e] *= f[4 * n + e];
                    } else {
                        float r[8];
#pragma unroll
                        for (int n = 0; n < 2; ++n)
#pragma unroll
                            for (int e = 0; e < 4; ++e) r[4 * n + e] = acc[ai][bj][m][n][e] * f[4 * n + e];
                        u32x4 w; w.x = cvt_pk_bf16(r[0], r[1]); w.y = cvt_pk_bf16(r[2], r[3]); w.z = cvt_pk_bf16(r[4], r[5]); w.w = cvt_pk_bf16(r[6], r[7]);
                        *(u32x4*)(Y + off + bj * HALF) = w;
                    }
                } }
        return u.kind != 0;
    }
};

template <class Epi, class Sched>
__device__ __forceinline__ void gemm_phase(PG8_LAS unsigned char* lds, const Gemm g, const Sched& S, const Epi& E) {
    const int tid = threadIdx.x, wid = __builtin_amdgcn_readfirstlane(tid >> 6), lane = tid & 63, wr = wid >> 2, wc = wid & 3, fr = lane & 15, fq = lane >> 4;
    const int K = g.K, nt = K / BK, lda = g.lda;
    unsigned voffA[2], voffB[2];
#pragma unroll
    for (int i = 0; i < 2; ++i) { int R, C; stage_rc(tid * 16 + i * 8192, R, C); const int Rb = (R & ~31) + perm32(R & 31);
        voffA[i] = (unsigned)(R * lda + C) * 2u; voffB[i] = (unsigned)(Rb * K + C) * 2u; }
    const size_t kstep = (size_t)(BK * 2);
    const size_t hstepA = (size_t)HALF * lda * 2, hstepB = (size_t)HALF * K * 2;
    const size_t tstepA = 2 * hstepA, tstepB = 2 * hstepB;
    const unsigned ldsw = (unsigned)wid * 1024u;
    const int aoff = lds_byte(wr * 64 + fr, fq * 8), boff = lds_byte(wc * 32 + fr, fq * 8);
#define PG8_SA(b, h) (((b) * 2 + (h)) * HTB)
#define PG8_SB(b, h) ((4 + (b) * 2 + (h)) * HTB)
#define PG8_STAGE(bufoff, gbase, voff) do { _Pragma("unroll") for (int _i = 0; _i < 2; ++_i) \
        __builtin_amdgcn_global_load_lds((const unsigned*)((const char*)(gbase) + (voff)[_i]), (PG8_LAS unsigned*)(lds + (bufoff) + ldsw + _i * 8192), 16, 0, 0); } while (0)
#define PG8_LDA(dst, b, h) do { _Pragma("unroll") for (int m = 0; m < 4; ++m) _Pragma("unroll") for (int k = 0; k < 2; ++k) dst[m][k] = *(const PG8_LAS bf16x8*)(lds + PG8_SA(b, h) + aoff + m * 2048 + k * 1024); } while (0)
#define PG8_LDB(dst, b, h) do { _Pragma("unroll") for (int n = 0; n < 2; ++n) _Pragma("unroll") for (int k = 0; k < 2; ++k) dst[n][k] = *(const PG8_LAS bf16x8*)(lds + PG8_SB(b, h) + boff + n * 2048 + k * 1024); } while (0)
#define PG8_MMA(ai, bj, At, Bt) do { __builtin_amdgcn_s_setprio(1); _Pragma("unroll") for (int m = 0; m < 4; ++m) _Pragma("unroll") for (int n = 0; n < 2; ++n) _Pragma("unroll") for (int k = 0; k < 2; ++k) \
        acc[ai][bj][m][n] = __builtin_amdgcn_mfma_f32_16x16x32_bf16(Bt[n][k], At[m][k], acc[ai][bj][m][n], 0, 0, 0); __builtin_amdgcn_s_setprio(0); } while (0)
#define PG8_WAIT_V(n) asm volatile("s_waitcnt vmcnt(" #n ")" ::: "memory")
#define PG8_WAIT_L(n) asm volatile("s_waitcnt lgkmcnt(" #n ")" ::: "memory")
#define PG8_BAR __builtin_amdgcn_s_barrier()
#define PG8_SCHED __builtin_amdgcn_sched_barrier(0)
    Unit cur, nxt; int ui = 0;
    if (!S.next(0, cur)) return;
    f32x4 acc[2][2][4][2];
#pragma unroll
    for (int a = 0; a < 2; ++a)
#pragma unroll
        for (int b = 0; b < 2; ++b)
#pragma unroll
            for (int m = 0; m < 4; ++m)
#pragma unroll
                for (int n = 0; n < 2; ++n) acc[a][b][m][n] = (f32x4){0.f, 0.f, 0.f, 0.f};
    bf16x8 At[4][2], B0[2][2], B1[2][2];
    const char* cA = (const char*)(cur.kind ? g.A1 : g.A0) + (size_t)cur.pm * tstepA; const char* cB = (const char*)(cur.kind ? g.B1 : g.B0) + (size_t)cur.pn * tstepB;
    PG8_STAGE(PG8_SB(0, 0), cB, voffB); PG8_STAGE(PG8_SB(0, 1), cB + hstepB, voffB); PG8_STAGE(PG8_SA(0, 0), cA, voffA); PG8_STAGE(PG8_SA(0, 1), cA + hstepA, voffA);
    if (wr == 1) PG8_BAR;
    PG8_WAIT_V(2); PG8_BAR;
    PG8_STAGE(PG8_SB(1, 0), cB + kstep, voffB); PG8_STAGE(PG8_SA(1, 0), cA + kstep, voffA); PG8_STAGE(PG8_SB(1, 1), cB + hstepB + kstep, voffB);
    PG8_WAIT_V(6); PG8_BAR;
    for (;;) {
        const bool has_next = S.next(ui + 1, nxt);
        const char* nA = has_next ? (const char*)(nxt.kind ? g.A1 : g.A0) + (size_t)nxt.pm * tstepA : cA; const char* nB = has_next ? (const char*)(nxt.kind ? g.B1 : g.B0) + (size_t)nxt.pn * tstepB : cB;
        for (int t = 0; t < nt; t += 2) {
            const bool last = (t == nt - 2);
            const char* a1 = cA + (size_t)(t + 1) * kstep;
            const char* a2 = last ? nA : cA + (size_t)(t + 2) * kstep; const char* b2 = last ? nB : cB + (size_t)(t + 2) * kstep;
            const char* a3 = a2 + kstep; const char* b3 = b2 + kstep;
            PG8_LDB(B0, 0, 0); PG8_LDB(B1, 0, 1); PG8_SCHED; PG8_LDA(At, 0, 0); PG8_STAGE(PG8_SA(1, 1), a1 + hstepA, voffA);
            PG8_WAIT_V(8); PG8_WAIT_L(0); PG8_BAR; PG8_MMA(0, 0, At, B0); PG8_MMA(0, 1, At, B1); PG8_BAR; PG8_SCHED;
            PG8_LDA(At, 0, 1); PG8_STAGE(PG8_SB(0, 0), b2, voffB); PG8_STAGE(PG8_SB(0, 1), b2 + hstepB, voffB); PG8_STAGE(PG8_SA(0, 0), a2, voffA);
            PG8_WAIT_V(8); PG8_WAIT_L(0); PG8_BAR; PG8_MMA(1, 0, At, B0); PG8_MMA(1, 1, At, B1); PG8_BAR; PG8_SCHED;
            PG8_LDB(B0, 1, 0); PG8_LDB(B1, 1, 1); PG8_SCHED; PG8_LDA(At, 1, 0); PG8_STAGE(PG8_SA(0, 1), a2 + hstepA, voffA);
            PG8_WAIT_V(8); PG8_WAIT_L(0); PG8_BAR; PG8_MMA(0, 0, At, B0); PG8_MMA(0, 1, At, B1); PG8_BAR; PG8_SCHED;
            PG8_LDA(At, 1, 1); PG8_STAGE(PG8_SB(1, 0), b3, voffB); PG8_STAGE(PG8_SB(1, 1), b3 + hstepB, voffB); PG8_STAGE(PG8_SA(1, 0), a3, voffA);
            PG8_WAIT_V(8); PG8_WAIT_L(0); PG8_BAR; PG8_MMA(1, 0, At, B0); PG8_MMA(1, 1, At, B1); PG8_BAR; PG8_SCHED;
        }
        if (wr == 0) PG8_BAR;
        const bool zero = E(acc, cur, wr, wc, fr, fq);
        if (!has_next) break;
        if (zero) {
#pragma unroll
            for (int a = 0; a < 2; ++a)
#pragma unroll
                for (int b = 0; b < 2; ++b)
#pragma unroll
                    for (int m = 0; m < 4; ++m)
#pragma unroll
                        for (int n = 0; n < 2; ++n) acc[a][b][m][n] = (f32x4){0.f, 0.f, 0.f, 0.f};
        }
        cur = nxt; cA = nA; cB = nB; ++ui;
        if (wr == 1) PG8_BAR;
    }
    PG8_WAIT_V(0);
    PG8_BAR;
#undef PG8_SA
#undef PG8_SB
#undef PG8_STAGE
#undef PG8_LDA
#undef PG8_LDB
#undef PG8_MMA
#undef PG8_WAIT_V
#undef PG8_WAIT_L
#undef PG8_BAR
#undef PG8_SCHED
}
}

typedef unsigned short bf16;
typedef float f32x4 __attribute__((ext_vector_type(4)));
typedef unsigned u32x4 __attribute__((ext_vector_type(4)));
typedef unsigned u32x2 __attribute__((ext_vector_type(2)));
#define LAS __attribute__((address_space(3)))

constexpr int BATCH = 4, SEQ = 8192, T = BATCH * SEQ, D = 1024, FF = 2816, NGU = 2 * FF, ZP = 4608, ZN = 6656, INW = 6664;
constexpr int ZQA = 0, ZKA = 1024, ZVA = 1280, ZQM = 1536, ZKM = 2048, ZVM = 2560, ZOM = 3584, ZGA = 4608, ZGM = 5632;
constexpr float RMS_EPS = 1e-5f;
constexpr size_t MiB = (size_t)1 << 20;
constexpr size_t WS_WA = 0, WS_WP = 17 * MiB, WS_ROPE = 23 * MiB, WS_GATE = 25 * MiB, WS_MISC = 26 * MiB, WS_HA = 28 * MiB, WS_Z = 92 * MiB, WS_GR = 380 * MiB, WS_GS = 444 * MiB, WS_END = 508 * MiB;
constexpr size_t WA_GU = 0, WA_DN = 11 * MiB;
constexpr int LDS_BYTES = 147456;
constexpr int NPHASE = 14;

struct Args {
    const float* in[21]; float* out; unsigned char* ws; float inv_freq[32]; int ph_lo, ph_hi;
};

__device__ __forceinline__ unsigned f2bf(float f) { unsigned u = __builtin_bit_cast(unsigned, f); return (u + 0x7fffu + ((u >> 16) & 1u)) >> 16; }
typedef float f32x2_t __attribute__((ext_vector_type(2)));
typedef __bf16 bf16x2_t __attribute__((ext_vector_type(2)));
__device__ __forceinline__ unsigned pk2(float lo, float hi) { return __builtin_bit_cast(unsigned, __builtin_convertvector((f32x2_t){lo, hi}, bf16x2_t)); }
__device__ __forceinline__ float bf2f(bf16 b) { return __uint_as_float((unsigned)b << 16); }
__device__ __forceinline__ float wave_sum(float v) {
#pragma unroll
    for (int o = 1; o < 64; o <<= 1) v += __shfl_xor(v, o);
    return v;
}

__device__ __forceinline__ void transpose_item(const float* W, int pitch, int src_col0, int K, bf16* WT, int dst_row0, int k0, LAS float* scr, int lane) {
    typedef float f32x2v __attribute__((ext_vector_type(2)));
#pragma unroll 8
    for (int i = 0; i < 32; ++i) { const int kk = 2 * i + (lane >> 5), cc = 2 * (lane & 31); const f32x2v v = *(const f32x2v*)(W + (size_t)(k0 + kk) * pitch + src_col0 + cc); scr[kk * 65 + cc] = v.x; scr[kk * 65 + cc + 1] = v.y; }
    asm volatile("s_waitcnt lgkmcnt(0)" ::: "memory");
    const int c = lane & 7;
#pragma unroll
    for (int j = 0; j < 8; ++j) { const int n = (lane >> 3) + 8 * j; const LAS float* s = scr + (8 * c) * 65 + n;
        u32x4 o; o.x = pk2(s[0 * 65], s[1 * 65]); o.y = pk2(s[2 * 65], s[3 * 65]); o.z = pk2(s[4 * 65], s[5 * 65]); o.w = pk2(s[6 * 65], s[7 * 65]);
        *(u32x4*)(WT + (size_t)(dst_row0 + n) * K + k0 + 8 * c) = o; }
    asm volatile("s_waitcnt lgkmcnt(0)" ::: "memory");
}
__device__ __forceinline__ void convert_weight(const float* W, int pitch, int K, int nblk, bf16* WT, int mode, int gw, int NGW, LAS float* scr, int lane) {
    const int nitems = (K / 64) * nblk;
    for (int it = gw; it < nitems; it += NGW) {
        const int kb = it / nblk, nb = it % nblk; int src = 64 * nb, dst = 64 * nb;
        if (mode == 1) dst = 256 * (src >> 7) + (src & 127);
        else if (mode == 2) dst = 256 * (src >> 7) + (src & 127) + 128;
        else if (mode == 3) { if (dst >= 4608) { const int rel = dst - 4608, t = rel >> 8, w = rel & 255; src = 4616 + ((w & 128) ? 1024 : 0) + 128 * t + (w & 127); } }
        transpose_item(W, pitch, src, K, WT, dst, 64 * kb, scr, lane);
    }
}

__device__ __forceinline__ void norm_row(const float* xrow, const float* gain, bf16* orow, int lane, f32x4 (&v)[4], const bf16* drow = nullptr) {
    const f32x4* xr = (const f32x4*)xrow + lane; const f32x4* gr = (const f32x4*)gain + lane;
    float s = 0.f;
    u32x2 dd[4] = {{0u, 0u}, {0u, 0u}, {0u, 0u}, {0u, 0u}};
    if (drow) {
#pragma unroll
        for (int j = 0; j < 4; ++j) dd[j] = ((const u32x2*)drow)[64 * j + lane]; }
#pragma unroll
    for (int j = 0; j < 4; ++j) { v[j] = xr[64 * j]; if (drow) { v[j].x += pg8::bf_lo(dd[j].x); v[j].y += pg8::bf_hi(dd[j].x); v[j].z += pg8::bf_lo(dd[j].y); v[j].w += pg8::bf_hi(dd[j].y); } s += (v[j].x * v[j].x + v[j].y * v[j].y) + (v[j].z * v[j].z + v[j].w * v[j].w); }
    const float rstd = 1.0f / sqrtf(wave_sum(s) * (1.0f / D) + RMS_EPS);
    unsigned long long* o8 = (unsigned long long*)orow + lane;
#pragma unroll
    for (int j = 0; j < 4; ++j) { const f32x4 g = gr[64 * j]; v[j] = v[j] * rstd * g;
        o8[64 * j] = (unsigned long long)pk2(v[j].x, v[j].y) | ((unsigned long long)pk2(v[j].z, v[j].w) << 32); }
}

namespace mm {
typedef short bf16x8 __attribute__((ext_vector_type(8)));
typedef short s16x4 __attribute__((ext_vector_type(4)));
typedef short v4i16_t __attribute__((ext_vector_type(4)));
typedef float f32x16 __attribute__((ext_vector_type(16)));
typedef float f32x8 __attribute__((ext_vector_type(8)));
typedef __bf16 bfv8 __attribute__((ext_vector_type(8)));
#define MFMA32(a, b, c) __builtin_amdgcn_mfma_f32_32x32x16_bf16((a), (b), (c), 0, 0, 0)
constexpr int PQ = 272, PV = 528;
__device__ __forceinline__ s16x4 vtr(const LAS unsigned char* p) { return __builtin_bit_cast(s16x4, __builtin_amdgcn_ds_read_tr16_b64_v4i16((LAS v4i16_t*)p)); }
__device__ __forceinline__ bf16x8 rowread(const LAS unsigned char* img, int pitch, int r0, int k0, int lane) { return *(const LAS bf16x8*)(img + (r0 + (lane & 31)) * pitch + (k0 + 8 * (lane >> 5)) * 2); }
template <bool PERM> __device__ __forceinline__ bf16x8 trread(const LAS unsigned char* img, int pitch, int k0, int c0, int lane) {
    const int h = lane >> 5, blk = (lane >> 4) & 1, q = (lane & 15) >> 2, p = lane & 3;
    const int rlo = PERM ? k0 + 4 * h + q : k0 + 8 * h + q, rhi = PERM ? k0 + 8 + 4 * h + q : k0 + 8 * h + 4 + q;
    const int cb = (c0 + 16 * blk + 4 * p) * 2;
    const s16x4 lo = vtr(img + rlo * pitch + cb), hi = vtr(img + rhi * pitch + cb);
    return __builtin_shufflevector(lo, hi, 0, 1, 2, 3, 4, 5, 6, 7);
}
__device__ __forceinline__ bf16x8 pack8(const f32x16& x, int s) {
    f32x8 v;
#pragma unroll
    for (int j = 0; j < 8; ++j) v[j] = x[8 * s + j];
    return __builtin_bit_cast(bf16x8, __builtin_convertvector(v, bfv8));
}
__device__ __forceinline__ void stage_conv(LAS unsigned char* img, const bf16* z, size_t tokb, int t0, int zcol0, const float* cw, const float* cbias, float scale, int tid) {
    const int cg8 = (tid & 15) * 8, lr = tid >> 4;
    float w[4][8], bb[8];
#pragma unroll
    for (int j = 0; j < 4; ++j) { const f32x4 a = *(const f32x4*)(cw + j * 1024 + cg8), b = *(const f32x4*)(cw + j * 1024 + cg8 + 4); w[j][0] = a.x; w[j][1] = a.y; w[j][2] = a.z; w[j][3] = a.w; w[j][4] = b.x; w[j][5] = b.y; w[j][6] = b.z; w[j][7] = b.w; }
    { const f32x4 a = *(const f32x4*)(cbias + cg8), b = *(const f32x4*)(cbias + cg8 + 4); bb[0] = a.x; bb[1] = a.y; bb[2] = a.z; bb[3] = a.w; bb[4] = b.x; bb[5] = b.y; bb[6] = b.z; bb[7] = b.w; }
    float r[7][8];
#pragma unroll
    for (int jj = 0; jj < 7; ++jj) { const int t = t0 + 4 * lr - 3 + jj; u32x4 v = {0u, 0u, 0u, 0u};
        if (t >= 0) v = *(const u32x4*)(z + (tokb + t) * ZP + zcol0 + cg8);
        r[jj][0] = pg8::bf_lo(v.x); r[jj][1] = pg8::bf_hi(v.x); r[jj][2] = pg8::bf_lo(v.y); r[jj][3] = pg8::bf_hi(v.y); r[jj][4] = pg8::bf_lo(v.z); r[jj][5] = pg8::bf_hi(v.z); r[jj][6] = pg8::bf_lo(v.w); r[jj][7] = pg8::bf_hi(v.w); }
#pragma unroll
    for (int i = 0; i < 4; ++i) { float y[8];
#pragma unroll
        for (int e = 0; e < 8; ++e) { float s = w[0][e] * r[i][e] + w[1][e] * r[i + 1][e] + w[2][e] * r[i + 2][e] + w[3][e] * r[i + 3][e] + bb[e]; y[e] = s * __builtin_amdgcn_rcpf(1.0f + __expf(-s)) * scale; }
        u32x4 o; o.x = pk2(y[0], y[1]); o.y = pk2(y[2], y[3]); o.z = pk2(y[4], y[5]); o.w = pk2(y[6], y[7]);
        *(LAS u32x4*)(img + (4 * lr + i) * PQ + cg8 * 2) = o; }
}
template <bool SCALE> __device__ __forceinline__ void stage_v(LAS unsigned char* img, const bf16* z, size_t tok0, int h, const LAS float* aa, int tid) {
    const int v8 = (tid & 31) * 8, l0 = tid >> 5;
#pragma unroll
    for (int i = 0; i < 8; ++i) { const int l = l0 + 16 * i; u32x4 v = *(const u32x4*)(z + (tok0 + l) * ZP + ZVM + h * 256 + v8);
        if (SCALE) { const float a = aa[l]; v.x = pk2(pg8::bf_lo(v.x) * a, pg8::bf_hi(v.x) * a); v.y = pk2(pg8::bf_lo(v.y) * a, pg8::bf_hi(v.y) * a); v.z = pk2(pg8::bf_lo(v.z) * a, pg8::bf_hi(v.z) * a); v.w = pk2(pg8::bf_lo(v.w) * a, pg8::bf_hi(v.w) * a); }
        *(LAS u32x4*)(img + l * PV + v8 * 2) = v; }
}
__device__ __forceinline__ void scan_add2(float a0, float a1, int lane, float& s0, float& s1) {
    float p = a0 + a1;
#pragma unroll
    for (int o = 1; o < 64; o <<= 1) { const float t = __shfl_up(p, o); if (lane >= o) p += t; }
    s1 = p; s0 = p - a1;
}
__device__ __forceinline__ void scan_max2(float a0, float a1, int lane, float& s0, float& s1) {
    float p = fmaxf(a0, a1);
#pragma unroll
    for (int o = 1; o < 64; o <<= 1) { const float t = __shfl_up(p, o); if (lane >= o) p = fmaxf(p, t); }
    s1 = p; const float prev = __shfl_up(p, 1); s0 = lane > 0 ? fmaxf(prev, a0) : a0;
}
constexpr int OFF_K1 = 0, OFF_V1 = 34816, OFF_F1 = 34816 + 67584;
__device__ __forceinline__ void dc_item(const bf16* z, const float* gates, const float* conv_w, const float* conv_b, bf16* dC, float* dn, float* mloc, float* bend, int item, LAS unsigned char* L, int tid, int lane, int wave) {
    const int b = item >> 8, h = (item >> 6) & 3, c = item & 63;
    const size_t tokb = (size_t)b * SEQ, tok0 = tokb + (size_t)c * 128;
    LAS unsigned char* kimg = L + OFF_K1; LAS unsigned char* vimg = L + OFF_V1; LAS float* lf = (LAS float*)(L + OFF_F1); LAS float* ig = lf + 128; LAS float* bc = lf + 256; LAS float* aa = lf + 384;
    __syncthreads();
    if (wave == 0) {
        const float lf0 = gates[(tok0 + 2 * lane) * 8 + 4 + h], lf1 = gates[(tok0 + 2 * lane + 1) * 8 + 4 + h], ig0 = gates[(tok0 + 2 * lane) * 8 + h], ig1 = gates[(tok0 + 2 * lane + 1) * 8 + h];
        float b0, b1; scan_add2(lf0, lf1, lane, b0, b1);
        const float be = __shfl(b1, 63), w0 = be - b0 + ig0, w1 = be - b1 + ig1;
        float ml = fmaxf(w0, w1);
#pragma unroll
        for (int o = 1; o < 64; o <<= 1) ml = fmaxf(ml, __shfl_xor(ml, o));
        aa[2 * lane] = __expf(w0 - ml); aa[2 * lane + 1] = __expf(w1 - ml);
        if (lane == 0) { mloc[item] = ml; bend[item] = be; }
    }
    stage_conv(kimg, z, tokb, c * 128, ZKM + h * 128, conv_w + 512 + h * 128, conv_b + 512 + h * 128, 0.08838834764831845f, tid);
    __syncthreads();
    stage_v<true>(vimg, z, tok0, h, aa, tid);
    __syncthreads();
    { const int d = tid >> 2, part = tid & 3; float s = 0.f;
#pragma unroll 4
      for (int l = part * 32; l < part * 32 + 32; ++l) s += aa[l] * bf2f(*(const LAS bf16*)(kimg + l * PQ + d * 2));
      s += __shfl_xor(s, 1); s += __shfl_xor(s, 2);
      if (part == 0) dn[(size_t)item * 128 + d] = s; }
    f32x16 acc[4];
#pragma unroll
    for (int dt = 0; dt < 4; ++dt)
#pragma unroll
        for (int i = 0; i < 16; ++i) acc[dt][i] = 0.f;
    {
        bf16x8 bvc = trread<false>(vimg, PV, 0, 32 * wave, lane), akc[4];
#pragma unroll
        for (int dt = 0; dt < 4; ++dt) akc[dt] = trread<false>(kimg, PQ, 0, 32 * dt, lane);
#pragma unroll
        for (int ks = 0; ks < 8; ++ks) {
            bf16x8 bvn = bvc, akn[4] = {akc[0], akc[1], akc[2], akc[3]};
            if (ks < 7) { bvn = trread<false>(vimg, PV, 16 * (ks + 1), 32 * wave, lane);
#pragma unroll
                for (int dt = 0; dt < 4; ++dt) akn[dt] = trread<false>(kimg, PQ, 16 * (ks + 1), 32 * dt, lane); }
            __builtin_amdgcn_sched_barrier(0);
#pragma unroll
            for (int dt = 0; dt < 4; ++dt) acc[dt] = MFMA32(akc[dt], bvc, acc[dt]);
            __builtin_amdgcn_sched_barrier(0);
            bvc = bvn;
#pragma unroll
            for (int dt = 0; dt < 4; ++dt) akc[dt] = akn[dt];
        }
    }
    const int r = lane & 31, hh = lane >> 5;
    bf16* orow = dC + (size_t)item * 32768 + (size_t)(32 * wave + r) * 128;
#pragma unroll
    for (int dt = 0; dt < 4; ++dt)
#pragma unroll
        for (int g = 0; g < 4; ++g) { u32x2 o; o.x = pk2(acc[dt][4 * g], acc[dt][4 * g + 1]); o.y = pk2(acc[dt][4 * g + 2], acc[dt][4 * g + 3]); *(u32x2*)(orow + 32 * dt + 8 * g + 4 * hh) = o; }
}
__device__ __forceinline__ void scan_phase(bf16* dC, float* dn, const float* mloc, const float* bend, float* mprev, int G, int tid) {
    for (int gidx = blockIdx.x * 512 + tid; gidx < 16 * 8192; gidx += G * 512) {
        const int bh = gidx >> 13, e4 = gidx & 8191;
        bf16* base = dC + (size_t)bh * 64 * 32768 + (size_t)e4 * 4;
        float C0 = 0.f, C1 = 0.f, C2 = 0.f, C3 = 0.f, m = 0.f;
        u32x2 ld[8];
#pragma unroll
        for (int k = 0; k < 8; ++k) ld[k] = *(const u32x2*)(base + (size_t)k * 32768);
        for (int c0 = 0; c0 < 64; c0 += 8) {
            u32x2 nx[8];
#pragma unroll
            for (int k = 0; k < 8; ++k) { const int c = c0 + 8 + k; nx[k] = (u32x2){0u, 0u}; if (c < 63) nx[k] = *(const u32x2*)(base + (size_t)c * 32768); }
#pragma unroll
            for (int k = 0; k < 8; ++k) { const int c = c0 + k;
                u32x2 o; o.x = pk2(C0, C1); o.y = pk2(C2, C3); *(u32x2*)(base + (size_t)c * 32768) = o;
                if (e4 == 0) mprev[bh * 64 + c] = m;
                if (c < 63) { const float ml = mloc[bh * 64 + c], be = bend[bh * 64 + c]; const float mn = fmaxf(be + m, ml), so = __expf(be + m - mn), sn = __expf(ml - mn);
                    C0 = so * C0 + sn * pg8::bf_lo(ld[k].x); C1 = so * C1 + sn * pg8::bf_hi(ld[k].x); C2 = so * C2 + sn * pg8::bf_lo(ld[k].y); C3 = so * C3 + sn * pg8::bf_hi(ld[k].y); m = mn; } }
#pragma unroll
            for (int k = 0; k < 8; ++k) ld[k] = nx[k];
        }
        if (gidx < 16 * 128) {
            const int bh2 = gidx >> 7, d = gidx & 127; float n = 0.f, m2 = 0.f;
            for (int c = 0; c < 64; ++c) { float* p = dn + (size_t)(bh2 * 64 + c) * 128 + d; const float dv = (c < 63) ? *p : 0.f; *p = n;
                if (c < 63) { const float ml = mloc[bh2 * 64 + c], be = bend[bh2 * 64 + c]; const float mn = fmaxf(be + m2, ml); n = __expf(be + m2 - mn) * n + __expf(ml - mn) * dv; m2 = mn; } }
        }
    }
}
constexpr int OFF_Q3 = 0, OFF_K3 = 34816, OFF_V3 = 69632, OFF_F3 = 69632 + 67584;
__device__ __forceinline__ void out_item(bf16* z, const float* gates, const float* conv_w, const float* conv_b, const bf16* Cprev, const float* nprev, const float* mprev, const float* hn, int item, LAS unsigned char* L, int tid, int lane, int wave) {
    const int b = item >> 8, h = (item >> 6) & 3, c = item & 63;
    const size_t tokb = (size_t)b * SEQ, tok0 = tokb + (size_t)c * 128;
    LAS unsigned char* qimg = L + OFF_Q3; LAS unsigned char* kimg = L + OFF_K3; LAS unsigned char* vimg = L + OFF_V3;
    LAS float* lf = (LAS float*)(L + OFF_F3); LAS float* ig = lf + 128; LAS float* bc = lf + 256; LAS float* uu = lf + 384; LAS float* gm = lf + 512; LAS float* np = lf + 640; LAS float* part = lf + 768;
    const int lw = wave & 3, vw = wave >> 2, r = lane & 31, hh = lane >> 5, l = 32 * lw + r;
    const bf16* cp = Cprev + (size_t)item * 32768 + (size_t)(128 * vw + r) * 128 + 8 * hh;
    bf16x8 cpa[2][4];
#pragma unroll
    for (int ks = 0; ks < 2; ++ks)
#pragma unroll
        for (int vt = 0; vt < 4; ++vt) cpa[ks][vt] = *(const bf16x8*)(cp + vt * 4096 + 16 * ks);
    __syncthreads();
    if (wave == 0) {
        const float lf0 = gates[(tok0 + 2 * lane) * 8 + 4 + h], lf1 = gates[(tok0 + 2 * lane + 1) * 8 + 4 + h], ig0 = gates[(tok0 + 2 * lane) * 8 + h], ig1 = gates[(tok0 + 2 * lane + 1) * 8 + h];
        float b0, b1; scan_add2(lf0, lf1, lane, b0, b1);
        const float u0 = ig0 - b0, u1 = ig1 - b1; float g0, g1; scan_max2(u0, u1, lane, g0, g1);
        bc[2 * lane] = b0; bc[2 * lane + 1] = b1; uu[2 * lane] = u0; uu[2 * lane + 1] = u1; gm[2 * lane] = g0; gm[2 * lane + 1] = g1;
    } else if (wave == 1 || wave == 2) np[tid - 64] = nprev[(size_t)item * 128 + tid - 64];
    stage_conv(qimg, z, tokb, c * 128, ZQM + h * 128, conv_w + h * 128, conv_b + h * 128, 1.0f, tid);
    stage_conv(kimg, z, tokb, c * 128, ZKM + h * 128, conv_w + 512 + h * 128, conv_b + 512 + h * 128, 0.08838834764831845f, tid);
    stage_v<false>(vimg, z, tok0, h, nullptr, tid);
    __syncthreads();
    const float mp = mprev[item];
    const float b_l = bc[l], mt = fmaxf(b_l + gm[l], b_l + mp), inter = __expf(b_l + mp - mt), e0 = b_l - mt;
    bf16x8 cpb[6][4];
#pragma unroll
    for (int ks = 0; ks < 6; ++ks)
#pragma unroll
        for (int vt = 0; vt < 4; ++vt) cpb[ks][vt] = *(const bf16x8*)(cp + vt * 4096 + 16 * (ks + 2));
    f32x16 O[4];
#pragma unroll
    for (int vt = 0; vt < 4; ++vt)
#pragma unroll
        for (int i = 0; i < 16; ++i) O[vt][i] = 0.f;
    {
        bf16x8 bqc = rowread(qimg, PQ, 32 * lw, 0, lane);
#pragma unroll
        for (int ks = 0; ks < 8; ++ks) {
            bf16x8 bqn = bqc; if (ks < 7) bqn = rowread(qimg, PQ, 32 * lw, 16 * (ks + 1), lane);
            __builtin_amdgcn_sched_barrier(0);
#pragma unroll
            for (int vt = 0; vt < 4; ++vt) O[vt] = MFMA32(ks < 2 ? cpa[ks][vt] : cpb[ks - 2][vt], bqc, O[vt]);
            __builtin_amdgcn_sched_barrier(0);
            bqc = bqn;
        }
    }
#pragma unroll
    for (int vt = 0; vt < 4; ++vt)
#pragma unroll
        for (int i = 0; i < 16; ++i) O[vt][i] *= inter;
    f32x16 S[4];
#pragma unroll
    for (int st = 0; st < 4; ++st)
#pragma unroll
        for (int i = 0; i < 16; ++i) S[st][i] = 0.f;
    {
        bf16x8 bqc = rowread(qimg, PQ, 32 * lw, 0, lane), akc[4];
#pragma unroll
        for (int st = 0; st < 4; ++st) akc[st] = rowread(kimg, PQ, 32 * st, 0, lane);
#pragma unroll
        for (int ks = 0; ks < 8; ++ks) {
            bf16x8 bqn = bqc, akn[4] = {akc[0], akc[1], akc[2], akc[3]};
            if (ks < 7) { bqn = rowread(qimg, PQ, 32 * lw, 16 * (ks + 1), lane);
#pragma unroll
                for (int st = 0; st < 4; ++st) akn[st] = rowread(kimg, PQ, 32 * st, 16 * (ks + 1), lane); }
            __builtin_amdgcn_sched_barrier(0);
#pragma unroll
            for (int st = 0; st < 4; ++st) S[st] = MFMA32(akc[st], bqc, S[st]);
            __builtin_amdgcn_sched_barrier(0);
            bqc = bqn;
#pragma unroll
            for (int st = 0; st < 4; ++st) akc[st] = akn[st];
        }
    }
    float dsum = 0.f;
#pragma unroll
    for (int st = 0; st < 4; ++st) {
#pragma unroll
        for (int g = 0; g < 4; ++g) { const int s0 = 32 * st + 8 * g + 4 * hh; const f32x4 u4 = *(const LAS f32x4*)(uu + s0);
#pragma unroll
            for (int e = 0; e < 4; ++e) { const float w = (s0 + e <= l) ? __expf(e0 + u4[e]) : 0.f; const float v = S[st][4 * g + e] * w; S[st][4 * g + e] = v; dsum += v; } } }
    dsum += __shfl_xor(dsum, 32);
    bf16x8 fr[4][2];
#pragma unroll
    for (int st = 0; st < 4; ++st) { fr[st][0] = pack8(S[st], 0); fr[st][1] = pack8(S[st], 1); }
    float qn = 0.f;
#pragma unroll
    for (int d8 = 0; d8 < 8; ++d8) { const bf16x8 qf = *(const LAS bf16x8*)(qimg + l * PQ + (64 * hh + 8 * d8) * 2); const f32x4 na = *(const LAS f32x4*)(np + 64 * hh + 8 * d8), nb = *(const LAS f32x4*)(np + 64 * hh + 8 * d8 + 4);
        qn += bf2f((bf16)qf[0]) * na.x + bf2f((bf16)qf[1]) * na.y + bf2f((bf16)qf[2]) * na.z + bf2f((bf16)qf[3]) * na.w + bf2f((bf16)qf[4]) * nb.x + bf2f((bf16)qf[5]) * nb.y + bf2f((bf16)qf[6]) * nb.z + bf2f((bf16)qf[7]) * nb.w; }
    qn += __shfl_xor(qn, 32);
    const float den = dsum + inter * qn, rden = 1.0f / fmaxf(fabsf(den), __expf(-mt));
    {
        bf16x8 avc[4];
#pragma unroll
        for (int vt = 0; vt < 4; ++vt) avc[vt] = trread<true>(vimg, PV, 0, 128 * vw + 32 * vt, lane);
#pragma unroll
        for (int step = 0; step < 8; ++step) {
            bf16x8 avn[4] = {avc[0], avc[1], avc[2], avc[3]};
            if (step < 7) {
#pragma unroll
                for (int vt = 0; vt < 4; ++vt) avn[vt] = trread<true>(vimg, PV, 16 * (step + 1), 128 * vw + 32 * vt, lane); }
            __builtin_amdgcn_sched_barrier(0);
#pragma unroll
            for (int vt = 0; vt < 4; ++vt) O[vt] = MFMA32(avc[vt], fr[step >> 1][step & 1], O[vt]);
            __builtin_amdgcn_sched_barrier(0);
#pragma unroll
            for (int vt = 0; vt < 4; ++vt) avc[vt] = avn[vt];
        }
    }
    bf16* orow = z + (tok0 + l) * ZP + ZOM + h * 256;
    float ss = 0.f;
#pragma unroll
    for (int vt = 0; vt < 4; ++vt)
#pragma unroll
        for (int i = 0; i < 16; ++i) { const float v = O[vt][i] * rden; O[vt][i] = v; ss += v * v; }
    ss += __shfl_xor(ss, 32);
    if (hh == 0) part[vw * 128 + l] = ss;
    __syncthreads();
    const float rstd = 1.0f / sqrtf((part[l] + part[128 + l]) * (1.0f / 256.0f) + RMS_EPS);
    u32x2 owp[4][4];
#pragma unroll
    for (int vt = 0; vt < 4; ++vt)
#pragma unroll
        for (int g = 0; g < 4; ++g) owp[vt][g] = *(const u32x2*)(orow + 128 * vw + 32 * vt + 8 * g + 4 * hh);
    __builtin_amdgcn_sched_barrier(0);
#pragma unroll
    for (int vt = 0; vt < 4; ++vt)
#pragma unroll
        for (int g = 0; g < 4; ++g) { const int v0 = 128 * vw + 32 * vt + 8 * g + 4 * hh; const u32x2 ow = owp[vt][g]; const f32x4 gn = *(const f32x4*)(hn + h * 256 + v0);
            const float r0 = O[vt][4 * g] * rstd * gn.x * __builtin_amdgcn_rcpf(1.0f + __expf(-pg8::bf_lo(ow.x))), r1 = O[vt][4 * g + 1] * rstd * gn.y * __builtin_amdgcn_rcpf(1.0f + __expf(-pg8::bf_hi(ow.x)));
            const float r2 = O[vt][4 * g + 2] * rstd * gn.z * __builtin_amdgcn_rcpf(1.0f + __expf(-pg8::bf_lo(ow.y))), r3 = O[vt][4 * g + 3] * rstd * gn.w * __builtin_amdgcn_rcpf(1.0f + __expf(-pg8::bf_hi(ow.y)));
            u32x2 o; o.x = pk2(r0, r1); o.y = pk2(r2, r3); *(u32x2*)(orow + v0) = o; }
}
}


namespace at {
using namespace mm;
constexpr int PK = 144;
constexpr int OFF_K = 0, OFF_V = 256 * PK;
__device__ __forceinline__ void unpack8(const u32x4 v, float (&x)[8]) { x[0] = pg8::bf_lo(v.x); x[1] = pg8::bf_hi(v.x); x[2] = pg8::bf_lo(v.y); x[3] = pg8::bf_hi(v.y); x[4] = pg8::bf_lo(v.z); x[5] = pg8::bf_hi(v.z); x[6] = pg8::bf_lo(v.w); x[7] = pg8::bf_hi(v.w); }
__device__ __forceinline__ void load8f(const float* p, float (&x)[8]) { const f32x4 a = *(const f32x4*)p, b = *(const f32x4*)(p + 4); x[0] = a.x; x[1] = a.y; x[2] = a.z; x[3] = a.w; x[4] = b.x; x[5] = b.y; x[6] = b.z; x[7] = b.w; }
__device__ __forceinline__ bf16x8 cvt8(const float (&y)[8]) { f32x8 v;
#pragma unroll
    for (int e = 0; e < 8; ++e) v[e] = y[e];
    return __builtin_bit_cast(bf16x8, __builtin_convertvector(v, bfv8)); }
__device__ __forceinline__ void attn_item(bf16* z, const float* rope_cos, const float* rope_sin, const float* sinks, int item, LAS unsigned char* L, int tid, int lane, int wave) {
    const int hk = item & 3, n = (item >> 2) & 63, b = item >> 8;
    const size_t tok0 = (size_t)b * SEQ + (size_t)n * 128;
    LAS unsigned char* kimg = L + OFF_K; LAS unsigned char* vimg = L + OFF_V;
    __syncthreads();
    for (int idx = tid; idx < 1024; idx += 512) {
        const int key = idx >> 2, c8 = (idx & 3) * 8;
        bf16x8 o1 = {0, 0, 0, 0, 0, 0, 0, 0}, o2 = {0, 0, 0, 0, 0, 0, 0, 0};
        if (n > 0 || key >= 128) {
            const bf16* zr = z + (tok0 + key - 128) * ZP + ZKA + hk * 64;
            float x1[8], x2[8], cs[8], sn[8], y1[8], y2[8];
            unpack8(*(const u32x4*)(zr + c8), x1); unpack8(*(const u32x4*)(zr + c8 + 32), x2);
            const int pos = n * 128 + key - 128;
            load8f(rope_cos + pos * 32 + c8, cs); load8f(rope_sin + pos * 32 + c8, sn);
#pragma unroll
            for (int e = 0; e < 8; ++e) { y1[e] = x1[e] * cs[e] - x2[e] * sn[e]; y2[e] = x2[e] * cs[e] + x1[e] * sn[e]; }
            o1 = cvt8(y1); o2 = cvt8(y2);
        }
        *(LAS bf16x8*)(kimg + key * PK + c8 * 2) = o1; *(LAS bf16x8*)(kimg + key * PK + (c8 + 32) * 2) = o2;
    }
    for (int idx = tid; idx < 2048; idx += 512) {
        const int key = idx >> 3, c8 = (idx & 7) * 8; u32x4 v = {0u, 0u, 0u, 0u};
        if (n > 0 || key >= 128) v = *(const u32x4*)(z + (tok0 + key - 128) * ZP + ZVA + hk * 64 + c8);
        *(LAS u32x4*)(vimg + key * PK + c8 * 2) = v;
    }
    __syncthreads();
    const int r = lane & 31, hh = lane >> 5;
#pragma unroll 1
    for (int gsel = 0; gsel < 2; ++gsel) {
        const int gi = wave + 8 * gsel, g = gi >> 2, j = gi & 3, head = hk * 4 + g;
        bf16* qrow = z + (tok0 + 32 * j + r) * ZP + ZQA + head * 64; const int pos = n * 128 + 32 * j + r;
        u32x4 raw[4];
#pragma unroll
        for (int ks = 0; ks < 4; ++ks) raw[ks] = *(const u32x4*)(qrow + 16 * ks + 8 * hh);
        bf16x8 qf[4];
#pragma unroll
        for (int k2 = 0; k2 < 2; ++k2) { float x1[8], x2[8], cs[8], sn[8], y1[8], y2[8];
            unpack8(raw[k2], x1); unpack8(raw[k2 + 2], x2); load8f(rope_cos + pos * 32 + 16 * k2 + 8 * hh, cs); load8f(rope_sin + pos * 32 + 16 * k2 + 8 * hh, sn);
#pragma unroll
            for (int e = 0; e < 8; ++e) { y1[e] = (x1[e] * cs[e] - x2[e] * sn[e]) * 0.125f; y2[e] = (x2[e] * cs[e] + x1[e] * sn[e]) * 0.125f; }
            qf[k2] = cvt8(y1); qf[k2 + 2] = cvt8(y2); }
        f32x16 S[5];
#pragma unroll
        for (int kt = 0; kt < 5; ++kt)
#pragma unroll
            for (int i = 0; i < 16; ++i) S[kt][i] = 0.f;
#pragma unroll
        for (int ks = 0; ks < 4; ++ks)
#pragma unroll
            for (int kt = 0; kt < 5; ++kt) { const bf16x8 ak = rowread(kimg, PK, 32 * (j + kt), 16 * ks, lane); S[kt] = MFMA32(ak, qf[ks], S[kt]); }
        const float sink = sinks[head]; float mx = sink;
#pragma unroll
        for (int kt = 0; kt < 5; ++kt)
#pragma unroll
            for (int i = 0; i < 16; ++i) { const int cr = (i & 3) + 8 * (i >> 2) + 4 * hh; bool ok = (kt == 0) ? (cr > r) : (kt == 4) ? (cr <= r) : true; if (n == 0 && j + kt < 4) ok = false;
                const float s = ok ? S[kt][i] : -INFINITY; S[kt][i] = s; mx = fmaxf(mx, s); }
        mx = fmaxf(mx, __shfl_xor(mx, 32));
        float sum = 0.f;
#pragma unroll
        for (int kt = 0; kt < 5; ++kt)
#pragma unroll
            for (int i = 0; i < 16; ++i) { const float p = __expf(S[kt][i] - mx); S[kt][i] = p; sum += p; }
        sum += __shfl_xor(sum, 32); sum += __expf(sink - mx);
        const float inv = 1.0f / sum;
        f32x16 O[2];
#pragma unroll
        for (int dt = 0; dt < 2; ++dt)
#pragma unroll
            for (int i = 0; i < 16; ++i) O[dt][i] = 0.f;
#pragma unroll
        for (int kt = 0; kt < 5; ++kt)
#pragma unroll
            for (int s2 = 0; s2 < 2; ++s2) { const bf16x8 pf = pack8(S[kt], s2);
#pragma unroll
                for (int dt = 0; dt < 2; ++dt) { const bf16x8 av = trread<true>(vimg, PK, 32 * (j + kt) + 16 * s2, 32 * dt, lane); O[dt] = MFMA32(av, pf, O[dt]); } }
#pragma unroll
        for (int dt = 0; dt < 2; ++dt)
#pragma unroll
            for (int g4 = 0; g4 < 4; ++g4) { u32x2 o; o.x = pk2(O[dt][4 * g4] * inv, O[dt][4 * g4 + 1] * inv); o.y = pk2(O[dt][4 * g4 + 2] * inv, O[dt][4 * g4 + 3] * inv); *(u32x2*)(qrow + 32 * dt + 8 * g4 + 4 * hh) = o; }
    }
}
}


#define XB_TMO      128
#define XB_XCNT(j)  (256  + 64 * (j))
#define XB_XSUB(j)  (1280 + 64 * (j))
#define XB_XGEN(j)  (2304 + 64 * (j))
#define XB_TOP      3328
#define XB_TOPGEN   3392
#define XCD_BAR_WORDS 3456
#define XB_SPIN_CAP (1u << 18)
__device__ __forceinline__ unsigned xb_ld(unsigned* p)              { return __hip_atomic_load(p, __ATOMIC_RELAXED, __HIP_MEMORY_SCOPE_AGENT); }
__device__ __forceinline__ unsigned xb_add(unsigned* p, unsigned v) { return __hip_atomic_fetch_add(p, v, __ATOMIC_RELAXED, __HIP_MEMORY_SCOPE_AGENT); }
__device__ __forceinline__ unsigned xb_xcc_id() { return (unsigned)__builtin_amdgcn_s_getreg((3 << 11) | 20) & 0xFu; }
#define XB_SPIN(cond, bar) do { unsigned _sp = 0; while (cond) { __builtin_amdgcn_s_sleep(1); \
    if ((++_sp & 255u) == 0u) { if (xb_ld(&(bar)[XB_TMO])) break; if (_sp > XB_SPIN_CAP) { atomicAdd(&(bar)[XB_TMO], 1u); break; } } } } while (0)
struct XcdBarrier { unsigned* bar; unsigned x; volatile LAS unsigned* st; };
__device__ __forceinline__ XcdBarrier xcd_barrier_post(unsigned* bar, volatile LAS unsigned* st) {
    XcdBarrier b; b.bar = bar; b.x = xb_xcc_id(); b.st = st;
    if (threadIdx.x == 0) (void)xb_add(&bar[XB_XCNT(b.x)], 1u);
    return b;
}
__device__ __forceinline__ void xcd_barrier_complete(unsigned* bar, unsigned x, unsigned& nloc, unsigned& nx) {
    const unsigned G = gridDim.x * gridDim.y * gridDim.z;
    unsigned sum, cnt, mine, sp = 0u;
    for (;;) {
        sum = 0u; cnt = 0u; mine = 0u;
#pragma unroll
        for (unsigned j = 0; j < 16; ++j) { const unsigned c = xb_ld(&bar[XB_XCNT(j)]); sum += c; cnt += (c > 0u) ? 1u : 0u; mine = (j == x) ? c : mine; }
        if (sum == G) break;
        __builtin_amdgcn_s_sleep(1);
        if ((++sp & 255u) == 0u) { if (xb_ld(&bar[XB_TMO])) break; if (sp > XB_SPIN_CAP) { atomicAdd(&bar[XB_TMO], 1u); break; } }
    }
    nloc = mine > 0u ? mine : 1u; nx = cnt > 0u ? cnt : 1u;
}
__device__ __forceinline__ void xcd_barrier(const XcdBarrier& b) {
    asm volatile("s_waitcnt vmcnt(0)" ::: "memory");
    __syncthreads();
    if (threadIdx.x == 0) {
        unsigned* bar = b.bar;
        __builtin_amdgcn_s_waitcnt(0);
        unsigned nloc = b.st[0], nx = b.st[1];
        if (nloc == 0u) { xcd_barrier_complete(bar, b.x, nloc, nx); b.st[0] = nloc; b.st[1] = nx; }
        const unsigned old = xb_add(&bar[XB_XSUB(b.x)], 1u);
        const unsigned gen = old / nloc;
        if (old + 1u == (gen + 1u) * nloc) {
            __builtin_amdgcn_fence(__ATOMIC_RELEASE, "agent");
            asm volatile("s_waitcnt vmcnt(0)" ::: "memory");
            const unsigned og = xb_add(&bar[XB_TOP], 1u);
            const unsigned tg = og / nx;
            if (og + 1u == (tg + 1u) * nx) xb_add(&bar[XB_TOPGEN], 1u);
            else XB_SPIN(xb_ld(&bar[XB_TOPGEN]) == tg, bar);
            __builtin_amdgcn_fence(__ATOMIC_ACQUIRE, "agent");
            xb_add(&bar[XB_XGEN(b.x)], 1u);
            asm volatile("s_waitcnt vmcnt(0)" ::: "memory");
        } else {
            XB_SPIN(xb_ld(&bar[XB_XGEN(b.x)]) == gen, bar);
            __builtin_amdgcn_fence(__ATOMIC_ACQUIRE, "agent");
            asm volatile("s_waitcnt vmcnt(0)" ::: "memory");
        }
    }
    __syncthreads();
}

__global__ void __launch_bounds__(512, 2) mega_fwd(Args args) {
    extern __shared__ __attribute__((aligned(16))) unsigned char lds[];
    cg::grid_group grid = cg::this_grid();
    const int tid = threadIdx.x, lane = tid & 63, wave = __builtin_amdgcn_readfirstlane(tid >> 6);
    const int G = gridDim.x, gw = blockIdx.x * 8 + wave, NGW = G * 8;
    unsigned char* ws = args.ws;
    const float* x = args.in[0];
    float* out = args.out;
    bf16* WA = (bf16*)(ws + WS_WA); bf16* Wgu = (bf16*)(ws + WS_WA + WA_GU); bf16* Wdn = (bf16*)(ws + WS_WA + WA_DN);
    bf16* Watt = (bf16*)(ws + WS_WP); bf16* Wml = (bf16*)(ws + WS_WP + 2 * MiB); bf16* Wout = (bf16*)(ws + WS_WP + 4 * MiB);
    float* rope_cos = (float*)(ws + WS_ROPE); float* rope_sin = rope_cos + SEQ * 32;
    float* gates = (float*)(ws + WS_GATE);
    float* dnb = (float*)(ws + WS_MISC); float* mlocb = dnb + 1024 * 128; float* bendb = mlocb + 1024; float* mprevb = bendb + 1024;
    bf16* hA = (bf16*)(ws + WS_HA); bf16* Z = (bf16*)(ws + WS_Z); bf16* HID = (bf16*)(ws + WS_Z); bf16* DL = (bf16*)(ws + WS_GR);
    LAS float* scr = (LAS float*)((LAS unsigned char*)lds + wave * 16640);
    const int lo = args.ph_lo, hi = args.ph_hi;
#define IN(k) (lo <= (k) && (k) < hi)
    unsigned* barw = (unsigned*)(ws + WS_MISC + MiB);
    volatile LAS unsigned* bst = (volatile LAS unsigned*)((LAS unsigned char*)lds + LDS_BYTES - 16);
    if (lo == 0) {
        if (blockIdx.x == 0) for (int u = tid; u < XCD_BAR_WORDS; u += 512) barw[u] = 0u;
        if (tid < 2) bst[tid] = 0u;
    }
    XcdBarrier xbar; xbar.bar = barw; xbar.x = 0; xbar.st = bst;
#define SEAM(k) do { if (IN(k) && IN((k) + 1)) { if ((k) == 0) { grid.sync(); xbar = xcd_barrier_post(barw, bst); } else xcd_barrier(xbar); } } while (0)

    if (IN(0)) {
        convert_weight(args.in[2], FF, D, FF / 64, Wgu, 1, gw, NGW, scr, lane);
        convert_weight(args.in[3], FF, D, FF / 64, Wgu, 2, gw, NGW, scr, lane);
        convert_weight(args.in[4], D, FF, D / 64, Wdn, 0, gw, NGW, scr, lane);
        convert_weight(args.in[13], D, D, D / 64, Watt, 0, gw, NGW, scr, lane);
        convert_weight(args.in[14], D, D, D / 64, Wml, 0, gw, NGW, scr, lane);
        convert_weight(args.in[15], D, D, D / 64, Wout, 0, gw, NGW, scr, lane);
        for (int idx = blockIdx.x * 512 + tid; idx < SEQ * 32; idx += G * 512) {
            const int pos = idx >> 5, i = idx & 31;
            const float angf = (float)pos * args.inv_freq[i];
            const double ang = (double)angf;
            const double kq = rint(ang * 0.63661977236758134308);
            const double y = (ang - kq * 1.57079632679489655800) - kq * 6.123233995736766e-17;
            const double y2 = y * y;
            const double sy = y * (1.0 + y2 * (-1.0 / 6 + y2 * (1.0 / 120 + y2 * (-1.0 / 5040 + y2 * (1.0 / 362880 + y2 * (-1.0 / 39916800 + y2 * (1.0 / 6227020800.0)))))));
            const double cy = 1.0 + y2 * (-0.5 + y2 * (1.0 / 24 + y2 * (-1.0 / 720 + y2 * (1.0 / 40320 + y2 * (-1.0 / 3628800 + y2 * (1.0 / 479001600.0 + y2 * (-1.0 / 87178291200.0)))))));
            const long long qi = (long long)kq; const int qd = (int)(qi & 3);
            const double sn = qd == 0 ? sy : qd == 1 ? cy : qd == 2 ? -sy : -cy;
            const double cs = qd == 0 ? cy : qd == 1 ? -sy : qd == 2 ? -cy : sy;
            rope_cos[idx] = (float)cs; rope_sin[idx] = (float)sn;
        }
        for (int r = gw; r < T; r += NGW) { f32x4 v[4]; norm_row(x + (size_t)r * D, args.in[1], hA + (size_t)r * D, lane, v); }
    }
    SEAM(0);
    if (IN(1)) {
        pg8::Gemm g{hA, hA, Wgu, Wgu, D, D}; pg8::StaticOrder S; S.init(T, NGU, G, (int)blockIdx.x);
        pg8::EpiSwiGLU E{HID, FF};
        pg8::gemm_phase<pg8::EpiSwiGLU, pg8::StaticOrder>((PG8_LAS unsigned char*)lds, g, S, E);
    }
    SEAM(1);
    if (IN(2)) {
        pg8::Gemm g{HID, HID, Wdn, Wdn, FF, FF}; pg8::StaticOrder S; S.init(T, D, G, (int)blockIdx.x);
        pg8::EpiResid E{x, out, D, 0.5f};
        pg8::gemm_phase<pg8::EpiResid, pg8::StaticOrder>((PG8_LAS unsigned char*)lds, g, S, E);
    }
    SEAM(2);
    if (IN(3)) {
        convert_weight(args.in[6], INW, D, ZN / 64, WA, 3, gw, NGW, scr, lane);
        const float* win = args.in[6];
        f32x4 wga[16], wgb[16];
#pragma unroll
        for (int j = 0; j < 4; ++j)
#pragma unroll
            for (int e = 0; e < 4; ++e) { const int k = 256 * j + 4 * lane + e; wga[4 * j + e] = *(const f32x4*)(win + (size_t)k * INW + 4608); wgb[4 * j + e] = *(const f32x4*)(win + (size_t)k * INW + 4612); }
        for (int r = gw; r < T; r += NGW) {
            f32x4 v[4]; norm_row(out + (size_t)r * D, args.in[5], hA + (size_t)r * D, lane, v);
            float gsum[8];
#pragma unroll
            for (int e = 0; e < 8; ++e) gsum[e] = 0.f;
#pragma unroll
            for (int j = 0; j < 4; ++j)
#pragma unroll
                for (int e = 0; e < 4; ++e) { const f32x4 wa = wga[4 * j + e], wb = wgb[4 * j + e]; const float hv = v[j][e];
                    gsum[0] += hv * wa.x; gsum[1] += hv * wa.y; gsum[2] += hv * wa.z; gsum[3] += hv * wa.w; gsum[4] += hv * wb.x; gsum[5] += hv * wb.y; gsum[6] += hv * wb.z; gsum[7] += hv * wb.w; }
#pragma unroll
            for (int e = 0; e < 8; ++e) gsum[e] = wave_sum(gsum[e]);
            if (lane < 8) {
                float val = lane == 0 ? gsum[0] : lane == 1 ? gsum[1] : lane == 2 ? gsum[2] : lane == 3 ? gsum[3] : lane == 4 ? gsum[4] : lane == 5 ? gsum[5] : lane == 6 ? gsum[6] : gsum[7];
                if (lane < 4) val += args.in[7][lane];
                else { const float xx = val + args.in[8][lane - 4]; val = fminf(xx, 0.f) - log1pf(expf(-fabsf(xx))); }
                gates[(size_t)r * 8 + lane] = val;
            }
        }
    }
    SEAM(3);
    if (IN(4)) {
        pg8::Gemm g{hA, hA, WA, WA, D, D}; pg8::StaticOrder S; S.init(T, ZN, G, (int)blockIdx.x);
        pg8::EpiZG E{Z, ZP, (pg8::u32x4*)(ws + WS_GR), (pg8::u32x4*)(ws + WS_GS)};
        pg8::gemm_phase<pg8::EpiZG, pg8::StaticOrder>((PG8_LAS unsigned char*)lds, g, S, E);
    }
    SEAM(4);
    if (IN(5)) {
        for (int it = blockIdx.x; it < 1024; it += G) if ((it & 63) != 63) mm::dc_item(Z, gates, args.in[10], args.in[11], hA, dnb, mlocb, bendb, it, (LAS unsigned char*)lds, tid, lane, wave);
        for (int it = blockIdx.x; it < 1024; it += G) at::attn_item(Z, rope_cos, rope_sin, args.in[9], it, (LAS unsigned char*)lds, tid, lane, wave);
    }
    SEAM(5);
    if (IN(6)) {
        __syncthreads();
        mm::scan_phase(hA, dnb, mlocb, bendb, mprevb, G, tid);
        convert_weight(args.in[17], FF, D, FF / 64, Wgu, 1, gw, NGW, scr, lane);
        convert_weight(args.in[18], FF, D, FF / 64, Wgu, 2, gw, NGW, scr, lane);
        convert_weight(args.in[19], D, FF, D / 64, Wdn, 0, gw, NGW, scr, lane);
    }
    SEAM(6);
    if (IN(7)) {
        for (int it = blockIdx.x; it < 1024; it += G) mm::out_item(Z, gates, args.in[10], args.in[11], hA, dnb, mprevb, args.in[12], it, (LAS unsigned char*)lds, tid, lane, wave);
    }
    SEAM(7);
    if (IN(8)) {
        pg8::Gemm g{Z + ZQA, Z + ZOM, Watt, Wml, ZP, D}; pg8::PairOrder S; S.so.init(T, D, G, (int)blockIdx.x);
        pg8::EpiMix E{Z + ZQM, ZP, (const pg8::u32x4*)(ws + WS_GR), (const pg8::u32x4*)(ws + WS_GS)};
        pg8::gemm_phase<pg8::EpiMix, pg8::PairOrder>((PG8_LAS unsigned char*)lds, g, S, E);
    }
    SEAM(8);
    if (IN(9)) {
        pg8::Gemm g{Z + ZQM, Z + ZQM, Wout, Wout, ZP, D}; pg8::StaticOrder S; S.init(T, D, G, (int)blockIdx.x);
        pg8::EpiBf16 E{DL, D};
        pg8::gemm_phase<pg8::EpiBf16, pg8::StaticOrder>((PG8_LAS unsigned char*)lds, g, S, E);
    }
    SEAM(9);
    if (IN(10)) {
        for (int r = gw; r < T; r += NGW) { f32x4 v[4]; norm_row(out + (size_t)r * D, args.in[16], hA + (size_t)r * D, lane, v, DL + (size_t)r * D); }
    }
    SEAM(10);
    if (IN(11)) {
        pg8::Gemm g{hA, hA, Wgu, Wgu, D, D}; pg8::StaticOrder S; S.init(T, NGU, G, (int)blockIdx.x);
        pg8::EpiSwiGLU E{HID, FF};
        pg8::gemm_phase<pg8::EpiSwiGLU, pg8::StaticOrder>((PG8_LAS unsigned char*)lds, g, S, E);
    }
    SEAM(11);
    if (IN(12)) {
        pg8::Gemm g{HID, HID, Wdn, Wdn, FF, FF}; pg8::StaticOrder S; S.init(T, D, G, (int)blockIdx.x);
        pg8::EpiAccBf16 E{DL, D, 0.5f};
        pg8::gemm_phase<pg8::EpiAccBf16, pg8::StaticOrder>((PG8_LAS unsigned char*)lds, g, S, E);
    }
    SEAM(12);
    if (IN(13)) {
        const float* gain = args.in[20];
        for (int r = gw; r < T; r += NGW) {
            f32x4* xr = (f32x4*)(out + (size_t)r * D) + lane; const f32x4* gr = (const f32x4*)gain + lane;
            f32x4 v[4]; float s = 0.f;
#pragma unroll
            for (int j = 0; j < 4; ++j) { v[j] = xr[64 * j]; const u32x2 dd = ((const u32x2*)(DL + (size_t)r * D))[64 * j + lane]; v[j].x += pg8::bf_lo(dd.x); v[j].y += pg8::bf_hi(dd.x); v[j].z += pg8::bf_lo(dd.y); v[j].w += pg8::bf_hi(dd.y);
                s += (v[j].x * v[j].x + v[j].y * v[j].y) + (v[j].z * v[j].z + v[j].w * v[j].w); }
            const float rstd = 1.0f / sqrtf(wave_sum(s) * (1.0f / D) + RMS_EPS);
#pragma unroll
            for (int j = 0; j < 4; ++j) xr[64 * j] = v[j] * rstd * gr[64 * j];
        }
    }
#undef IN
#undef SEAM
}

extern "C" void kernel_launch(void* const* d_in, const int* in_sizes, int n_in, void* d_out, int out_size, void* d_ws, size_t ws_size, hipStream_t stream) {
    static int grid = 0;
    if (grid == 0) {
        if (n_in != 21 || out_size != T * D || ws_size < WS_END) { fprintf(stderr, "kernel_launch: unexpected shapes (n_in %d out %d ws %zu)\n", n_in, out_size, ws_size); grid = -1; return; }
        int dev = 0, cus = 0, per_cu = 0;
        hipGetDevice(&dev); hipDeviceGetAttribute(&cus, hipDeviceAttributeMultiprocessorCount, dev);
        if (hipFuncSetAttribute((const void*)mega_fwd, hipFuncAttributeMaxDynamicSharedMemorySize, LDS_BYTES) != hipSuccess) { fprintf(stderr, "kernel_launch: hipFuncSetAttribute failed\n"); grid = -1; return; }
        if (hipOccupancyMaxActiveBlocksPerMultiprocessor(&per_cu, (const void*)mega_fwd, 512, LDS_BYTES) != hipSuccess || per_cu < 1) { fprintf(stderr, "kernel_launch: occupancy query failed (%d)\n", per_cu); per_cu = 1; }
        (void)hipGetLastError();
        grid = cus * per_cu;
    }
    if (grid < 0) return;
    Args a{};
    for (int i = 0; i < 21; ++i) a.in[i] = (const float*)d_in[i];
    a.out = (float*)d_out; a.ws = (unsigned char*)d_ws;
    for (int i = 0; i < 32; ++i) a.inv_freq[i] = (float)pow(10000.0, -(double)i / 32.0);
#if MK_PER_PHASE_LAUNCH
    for (int ph = 0; ph < NPHASE; ++ph) { a.ph_lo = ph; a.ph_hi = ph + 1; hipLaunchKernelGGL(mega_fwd, dim3(grid), dim3(512), LDS_BYTES, stream, a); }
#else
    a.ph_lo = 0; a.ph_hi = NPHASE;
    void* kargs[] = {&a};
    hipError_t e = hipLaunchCooperativeKernel((const void*)mega_fwd, dim3(grid), dim3(512), kargs, LDS_BYTES, stream);
    if (e != hipSuccess) fprintf(stderr, "kernel_launch: cooperative launch failed: %s (grid %d)\n", hipGetErrorString(e), grid);
#endif
}
```
